# Optimizing an MI355X kernel written in HIP

```python
import math
import jax, jax.numpy as jnp
from jax import lax
import numpy as np

D_MODEL = 2048
BATCH = 8
SEQ = 2048
DEPTH = 2

HEAD_DIM = 128
N_HEADS_A = 4
N_HEADS_B = 4
N_HEADS_D = 4
DIFF_DIM = HEAD_DIM // 2
CONV_CH = 512
CONV_K = 3
IDX_HEADS = 4
IDX_DIM = 64
TOPK_MAX = 256
MIX_W = 512
N_BRANCH = 4
D_FF = 4 * D_MODEL
N_BUCKETS = 32
MAX_DIST = 128
Q_BLOCK = 128
EPS = 1e-6
NEG = -1e30
IDX_SCALE = (IDX_DIM ** -0.5) * (IDX_HEADS ** -0.5)

IN_SIZES = (
    N_HEADS_A * HEAD_DIM, N_HEADS_A * HEAD_DIM, N_HEADS_A * HEAD_DIM,
    IDX_HEADS * IDX_DIM, IDX_DIM, IDX_HEADS,
    N_HEADS_B * HEAD_DIM, N_HEADS_B * HEAD_DIM, N_HEADS_B * HEAD_DIM,
    CONV_CH, CONV_CH, CONV_CH,
    N_HEADS_D * HEAD_DIM, N_HEADS_D * HEAD_DIM, N_HEADS_D * HEAD_DIM,
    N_HEADS_D,
)
D_IN = sum(IN_SIZES)

kernel_name = "hybrid_gated_dsa_diff_conv_fox"


def _split_points():
    pts, acc = [], 0
    for s in IN_SIZES[:-1]:
        acc += s
        pts.append(acc)
    return pts


def rmsnorm(x, g):
    xf = x.astype(jnp.float32)
    y = xf * lax.rsqrt(jnp.mean(xf * xf, axis=-1, keepdims=True) + EPS)
    return (y * g.astype(jnp.float32)).astype(x.dtype)


def t5_bucket(rel):
    n = jnp.maximum(rel, 0)
    max_exact = N_BUCKETS // 2
    nf = jnp.maximum(n, 1).astype(jnp.float32)
    large = max_exact + (jnp.log(nf / max_exact) / math.log(MAX_DIST / max_exact)
                         * (N_BUCKETS - max_exact)).astype(jnp.int32)
    large = jnp.minimum(large, N_BUCKETS - 1)
    return jnp.where(n < max_exact, n, large)


def merge_blocks(o):
    nb, b, q, h, d = o.shape
    return jnp.moveaxis(o, 0, 1).reshape(b, nb * q, h, d)


def dsa_attention(q, k, v, iq, ik, iw, bias_tab, k_top):
    S = q.shape[1]
    hd = q.shape[-1]
    scale = hd ** -0.5
    kpos = jnp.arange(S)

    def block(i):
        t0 = i * Q_BLOCK
        qb = lax.dynamic_slice_in_dim(q, t0, Q_BLOCK, 1)
        iqb = lax.dynamic_slice_in_dim(iq, t0, Q_BLOCK, 1)
        iwb = lax.dynamic_slice_in_dim(iw, t0, Q_BLOCK, 1)
        qpos = t0 + jnp.arange(Q_BLOCK)
        causal = kpos[None, :] <= qpos[:, None]
        dots = jnp.einsum('bqhd,bsd->bqhs', iqb, ik).astype(jnp.float32)
        score = jnp.einsum('bqh,bqhs->bqs', iwb.astype(jnp.float32) * IDX_SCALE, jax.nn.relu(dots))
        score = jnp.where(causal[None], score, NEG)
        _, idx = lax.top_k(score, k_top)
        k_sel = jax.vmap(lambda kk, ii: kk[ii])(k, idx)
        v_sel = jax.vmap(lambda vv, ii: vv[ii])(v, idx)
        logits = jnp.einsum('bqhd,bqkhd->bhqk', qb, k_sel).astype(jnp.float32) * scale
        rel = qpos[None, :, None] - idx
        bias = bias_tab[t5_bucket(rel)].astype(jnp.float32)
        logits = logits + jnp.transpose(bias, (0, 3, 1, 2))
        logits = jnp.where((rel >= 0)[:, None], logits, NEG)
        p = jax.nn.softmax(logits, axis=-1).astype(v.dtype)
        return jnp.einsum('bhqk,bqkhd->bqhd', p, v_sel)

    return merge_blocks(lax.map(block, jnp.arange(S // Q_BLOCK)))


def diff_attention(q, k, v, lam_val, lam_init, g_subln, bias_tab):
    S = q.shape[1]
    scale = DIFF_DIM ** -0.5
    kpos = jnp.arange(S)

    def block(i):
        t0 = i * Q_BLOCK
        qb = lax.dynamic_slice_in_dim(q, t0, Q_BLOCK, 1)
        qpos = t0 + jnp.arange(Q_BLOCK)
        rel = qpos[:, None] - kpos[None, :]
        bias = jnp.transpose(bias_tab[t5_bucket(rel)], (2, 0, 1)).astype(jnp.float32)
        logits = jnp.einsum('bqhcd,bshcd->bchqs', qb, k).astype(jnp.float32) * scale + bias
        logits = jnp.where((rel >= 0)[None, None, None], logits, NEG)
        p = jax.nn.softmax(logits, axis=-1)
        attn = (p[:, 0] - lam_val * p[:, 1]).astype(v.dtype)
        return jnp.einsum('bhqs,bshd->bqhd', attn, v)

    o = merge_blocks(lax.map(block, jnp.arange(S // Q_BLOCK)))
    return rmsnorm(o, g_subln) * (1.0 - lam_init)


def short_conv(bg, cg, xin, conv_w):
    u = cg * xin
    y = lax.conv_general_dilated(
        u, conv_w[:, None, :], window_strides=(1,), padding=[(CONV_K - 1, 0)],
        dimension_numbers=('NWC', 'WIO', 'NWC'), feature_group_count=CONV_CH)
    return bg * y


def forgetting_attention(q, k, v, f_logit):
    S = q.shape[1]
    scale = q.shape[-1] ** -0.5
    kpos = jnp.arange(S)
    F = jnp.cumsum(jax.nn.log_sigmoid(f_logit.astype(jnp.float32)), axis=1)
    Fk = jnp.transpose(F, (0, 2, 1))

    def block(i):
        t0 = i * Q_BLOCK
        qb = lax.dynamic_slice_in_dim(q, t0, Q_BLOCK, 1)
        Fq = lax.dynamic_slice_in_dim(Fk, t0, Q_BLOCK, 2)
        qpos = t0 + jnp.arange(Q_BLOCK)
        causal = kpos[None, :] <= qpos[:, None]
        logits = (jnp.einsum('bqhd,bshd->bhqs', qb, k).astype(jnp.float32) * scale
                  + Fq[..., None] - Fk[:, :, None, :])
        logits = jnp.where(causal[None, None], logits, NEG)
        p = jax.nn.softmax(logits, axis=-1).astype(v.dtype)
        return jnp.einsum('bhqs,bshd->bqhd', p, v)

    return merge_blocks(lax.map(block, jnp.arange(S // Q_BLOCK)))


def setup_inputs(seed: int = 0) -> dict:
    key = jax.random.key(seed)
    ks = jax.random.split(key, 24)
    n = lambda k, shape, s: jax.random.normal(k, shape, jnp.float32) * s
    D = D_MODEL
    return {
        "x": n(ks[0], (BATCH, SEQ, D), 1.0),
        "c": n(ks[1], (BATCH, D), 1.0),
        "w_ada": n(ks[2], (DEPTH, D, 6 * D), 0.5 * D ** -0.5),
        "b_ada": n(ks[3], (DEPTH, 6 * D), 0.02),
        "g_norm1": 1.0 + n(ks[4], (DEPTH, D), 0.05),
        "w_in": n(ks[5], (DEPTH, D, D_IN), D ** -0.5),
        "b_f": 2.0 + n(ks[6], (DEPTH, N_HEADS_D), 0.1),
        "conv_w": n(ks[7], (DEPTH, CONV_K, CONV_CH), CONV_K ** -0.5),
        "lam": n(ks[8], (DEPTH, 4, DIFF_DIM), 0.1),
        "g_subln": 1.0 + n(ks[9], (DEPTH, HEAD_DIM), 0.05),
        "rel_bias": n(ks[10], (N_BUCKETS, N_HEADS_A + N_HEADS_B), 0.5),
        "w_gate": n(ks[11], (DEPTH, D, N_BRANCH * D), D ** -0.5),
        "b_gate": n(ks[12], (DEPTH, N_BRANCH * D), 0.02),
        "w_branch": n(ks[13], (DEPTH, N_BRANCH, MIX_W, D), MIX_W ** -0.5),
        "w_o": n(ks[14], (DEPTH, D, D), D ** -0.5),
        "g_norm2": 1.0 + n(ks[15], (DEPTH, D), 0.05),
        "w_ff1": n(ks[16], (DEPTH, D, D_FF), D ** -0.5),
        "w_ff2": n(ks[17], (DEPTH, D_FF, D), D_FF ** -0.5),
        "g_final": 1.0 + n(ks[18], (D,), 0.05),
    }


def reference(x, c, w_ada, b_ada, g_norm1, w_in, b_f, conv_w, lam, g_subln, rel_bias,
              w_gate, b_gate, w_branch, w_o, g_norm2, w_ff1, w_ff2, g_final):
    Bn, S, D = x.shape
    k_top = min(TOPK_MAX, S // 4)
    c_act = jax.nn.silu(c)
    bias_a = rel_bias[:, :N_HEADS_A]
    bias_b = rel_bias[:, N_HEADS_A:]
    heads = lambda t, nh: t.reshape(Bn, S, nh, -1)
    for l in range(DEPTH):
        mod = (c_act @ w_ada[l] + b_ada[l])[:, None, :]
        sh1, sc1, gt1, sh2, sc2, gt2 = jnp.split(mod, 6, axis=-1)
        h = rmsnorm(x, g_norm1[l]) * (1.0 + sc1) + sh1
        (qa, ka, va, iq, ik, iw, qb, kb, vb, bg, cg, xin, qd, kd, vd, fd) = jnp.split(
            h @ w_in[l], _split_points(), axis=-1)
        y_a = dsa_attention(heads(qa, N_HEADS_A), heads(ka, N_HEADS_A), heads(va, N_HEADS_A),
                            heads(iq, IDX_HEADS), ik, iw, bias_a, k_top)
        lam_init = 0.8 - 0.6 * math.exp(-0.3 * l)
        lq = lam[l].astype(jnp.float32)
        lam_val = jnp.exp(jnp.sum(lq[0] * lq[1])) - jnp.exp(jnp.sum(lq[2] * lq[3])) + lam_init
        y_b = diff_attention(qb.reshape(Bn, S, N_HEADS_B, 2, DIFF_DIM),
                             kb.reshape(Bn, S, N_HEADS_B, 2, DIFF_DIM),
                             heads(vb, N_HEADS_B), lam_val, lam_init, g_subln[l], bias_b)
        y_c = short_conv(bg, cg, xin, conv_w[l])
        y_d = forgetting_attention(heads(qd, N_HEADS_D), heads(kd, N_HEADS_D), heads(vd, N_HEADS_D),
                                   fd + b_f[l])
        branches = jnp.stack([y_a.reshape(Bn, S, MIX_W), y_b.reshape(Bn, S, MIX_W),
                              y_c, y_d.reshape(Bn, S, MIX_W)], axis=2)
        gates = jax.nn.sigmoid(h @ w_gate[l] + b_gate[l]).reshape(Bn, S, N_BRANCH, D)
        merged = jnp.einsum('bsgd,bsgd->bsd', gates,
                            jnp.einsum('bsgk,gkd->bsgd', branches, w_branch[l]))
        x = x + gt1 * (merged @ w_o[l])
        h2 = rmsnorm(x, g_norm2[l]) * (1.0 + sc2) + sh2
        x = x + gt2 * (jnp.square(jax.nn.relu(h2 @ w_ff1[l])) @ w_ff2[l])
    return rmsnorm(x, g_final)
```

```cpp
#include <hip/hip_runtime.h>
#include <cstdio>
#include <cstdint>

#ifndef MK_ONE_LAUNCH
#define MK_ONE_LAUNCH 1
#endif

#define DI __device__ __forceinline__
#define LAS __attribute__((address_space(3)))
#define GAS __attribute__((address_space(1)))

namespace pg8 {
#define PG8_LAS __attribute__((address_space(3)))
typedef unsigned short bf16_t;
typedef short bf16x8 __attribute__((ext_vector_type(8)));
typedef float f32x4 __attribute__((ext_vector_type(4)));
typedef float f32x2 __attribute__((ext_vector_type(2)));
typedef unsigned u32x4 __attribute__((ext_vector_type(4)));
typedef unsigned u32x2 __attribute__((ext_vector_type(2)));
constexpr int BM = 256, BK = 64, HALF = 128, HTB = HALF * BK * 2  , STAGE_BYTES = 8 * HTB, NXCD = 8, WGM = 8;

__host__ __device__ __forceinline__ int lds_byte(int r, int c) { const int st = (r >> 4) * 2 + (c >> 5), rr = r & 15, cc = c & 31, ob = rr * 64 + cc * 2; return st * 1024 + (ob ^ (((ob >> 9) & 1) << 5)); }
__host__ __device__ __forceinline__ void stage_rc(int b, int& R, int& C) { const int st = b / 1024, sb = b % 1024, swz = sb ^ (((sb >> 9) & 1) << 5); R = (st >> 1) * 16 + swz / 64; C = (st & 1) * 32 + (swz % 64) / 2; }
__host__ __device__ __forceinline__ int perm32(int rho) { const int n = rho >> 4, i = rho & 15; return 8 * (i >> 2) + 4 * n + (i & 3); }

struct Unit { int pm, pn; };
struct Gemm { const bf16_t* A; const bf16_t* Bt; int M, N, K, lda, ldb, agdiv, agoff; };

struct StaticOrder {
    int nM, nN, nwg, G, c;
    __host__ __device__ void init(int M, int N, int G_, int c_) { nM = M / BM; nN = N / BM; nwg = nM * nN; G = G_; c = c_; }
    __host__ __device__ bool next(int i, Unit& u) const {
        const long L = (long)i * G + c; if (L >= nwg) return false;
        int wgid = (int)L; { const int q = nwg / NXCD, r = nwg % NXCD, xcd = wgid % NXCD, off = wgid / NXCD; wgid = (xcd < r ? xcd * (q + 1) : r * (q + 1) + (xcd - r) * q) + off; }
        const int nig = WGM * nN, gid = wgid / nig, fm = gid * WGM, gsz = (nM - fm) < WGM ? (nM - fm) : WGM;
        u.pm = fm + ((wgid % nig) % gsz); u.pn = (wgid % nig) / gsz; return true;
    }
    __device__ __forceinline__ void a_ready(const Unit&) const {}
    __device__ __forceinline__ void done(const Unit&) const {}
};

__device__ __forceinline__ unsigned cvt_pk_bf16(float lo, float hi) { unsigned r; asm volatile("v_cvt_pk_bf16_f32 %0, %1, %2" : "=v"(r) : "v"(lo), "v"(hi)); return r; }

template <int ACT> struct EpiBf16 {
    static constexpr bool PERM = true, AFTER_DRAIN = false;
    bf16_t* O; int ldc;
    __device__ __forceinline__ void operator()(const f32x4 (&acc)[2][2][4][2], const Unit& u, int wr, int wc, int fr, int fq) const {
        const int row0 = u.pm * BM + wr * 64 + fr; const int col0 = u.pn * BM + wc * 32 + 8 * fq;
#pragma unroll
        for (int ai = 0; ai < 2; ++ai)
#pragma unroll
            for (int m = 0; m < 4; ++m) { bf16_t* rowp = O + (size_t)(row0 + ai * HALF + m * 16) * ldc + col0;
#pragma unroll
                for (int bj = 0; bj < 2; ++bj) { f32x4 v0 = acc[ai][bj][m][0], v1 = acc[ai][bj][m][1];
                    if (ACT == 2) {
#pragma unroll
                        for (int j = 0; j < 4; ++j) { const float a = fmaxf(v0[j], 0.f), b = fmaxf(v1[j], 0.f); v0[j] = a * a; v1[j] = b * b; } }
                    u32x4 w; w.x = cvt_pk_bf16(v0[0], v0[1]); w.y = cvt_pk_bf16(v0[2], v0[3]); w.z = cvt_pk_bf16(v1[0], v1[1]); w.w = cvt_pk_bf16(v1[2], v1[3]);
                    *(u32x4*)(rowp + bj * HALF) = w; } }
    }
};
struct EpiResid {
    static constexpr bool PERM = false, AFTER_DRAIN = false;
    const float* xin; float* xout; const float* gate; int gstride;
    __device__ __forceinline__ void operator()(const f32x4 (&acc)[2][2][4][2], const Unit& u, int wr, int wc, int fr, int fq) const {
        const int b = u.pm >> 3; const int col0 = u.pn * BM + wc * 32 + 4 * fq;
        f32x4 gv[2][2];
#pragma unroll
        for (int bj = 0; bj < 2; ++bj)
#pragma unroll
            for (int n = 0; n < 2; ++n) gv[bj][n] = *(const f32x4*)(gate + (size_t)b * gstride + col0 + bj * HALF + n * 16);
#pragma unroll
        for (int ai = 0; ai < 2; ++ai)
#pragma unroll
            for (int m = 0; m < 4; ++m) { const size_t off = (size_t)(u.pm * BM + ai * HALF + wr * 64 + m * 16 + fr) * 2048 + col0;
#pragma unroll
                for (int bj = 0; bj < 2; ++bj)
#pragma unroll
                    for (int n = 0; n < 2; ++n) { const f32x4 x = *(const f32x4*)(xin + off + bj * HALF + n * 16);
                        *(f32x4*)(xout + off + bj * HALF + n * 16) = x + gv[bj][n] * acc[ai][bj][m][n]; }
                if (m & 1) asm volatile("" ::: "memory"); }
    }
};
struct EpiGate {
    static constexpr bool PERM = false, AFTER_DRAIN = false;
    const bf16_t* P; const float* bgate; bf16_t* O;
    __device__ __forceinline__ void operator()(const f32x4 (&acc)[2][2][4][2], const Unit& u, int wr, int wc, int fr, int fq) const {
        const int d0 = u.pn * 64 + wc * 16 + 4 * fq;
        f32x4 bv[2][2];
#pragma unroll
        for (int bj = 0; bj < 2; ++bj)
#pragma unroll
            for (int n = 0; n < 2; ++n) bv[bj][n] = *(const f32x4*)(bgate + (2 * bj + n) * 2048 + d0);
#pragma unroll
        for (int ai = 0; ai < 2; ++ai)
#pragma unroll
            for (int m = 0; m < 4; ++m) { const size_t row = (size_t)(u.pm * BM + ai * HALF + wr * 64 + m * 16 + fr);
                f32x4 s = (f32x4){0.f, 0.f, 0.f, 0.f};
#pragma unroll
                for (int bj = 0; bj < 2; ++bj)
#pragma unroll
                    for (int n = 0; n < 2; ++n) { const u32x2 pw = *(const u32x2*)(P + row * 8192 + (2 * bj + n) * 2048 + d0);
                        const f32x4 pv = (f32x4){__uint_as_float(pw.x << 16), __uint_as_float(pw.x & 0xffff0000u), __uint_as_float(pw.y << 16), __uint_as_float(pw.y & 0xffff0000u)};
                        const f32x4 x = acc[ai][bj][m][n] + bv[bj][n];
#pragma unroll
                        for (int j = 0; j < 4; ++j) { const float sg = __builtin_amdgcn_rcpf(1.f + __builtin_amdgcn_exp2f(-1.4426950408889634f * x[j])); s[j] += sg * pv[j]; } }
                u32x2 w; w.x = cvt_pk_bf16(s[0], s[1]); w.y = cvt_pk_bf16(s[2], s[3]);
                *(u32x2*)(O + row * 2048 + d0) = w;
                if (m & 1) asm volatile("" ::: "memory"); }
    }
};

template <class Epi, class Sched, bool ALIGN_EPI = false, bool SP2 = false>
__device__ __forceinline__ void gemm_phase(PG8_LAS unsigned char* lds, const Gemm g, const Sched& S, const Epi& E) {
    int tid_l = threadIdx.x; asm volatile("" : "+v"(tid_l));
    const int tid = tid_l, wid = __builtin_amdgcn_readfirstlane(tid >> 6), lane = tid & 63, wr = wid >> 2, wc = wid & 3, fr = lane & 15, fq = lane >> 4;
    const int K = g.K, nt = K / BK;
    unsigned voffA[2], voffB[2];
#pragma unroll
    for (int i = 0; i < 2; ++i) { int R, C; stage_rc(tid * 16 + i * 8192, R, C); const int Rb = Epi::PERM ? ((R & ~31) + perm32(R & 31)) : R;
        voffA[i] = (unsigned)(R * g.lda + C) * 2u; voffB[i] = (unsigned)(Rb * g.ldb + C) * 2u; }
    const size_t kstep = (size_t)(BK * 2);
    const size_t hstepA = (size_t)HALF * g.lda * 2, hstepB = (size_t)HALF * g.ldb * 2;
    const size_t tstepA = 2 * hstepA, tstepB = 2 * hstepB;
    const unsigned ldsw = (unsigned)wid * 1024u;
    const int aoff = lds_byte(wr * 64 + fr, fq * 8), boff = lds_byte(wc * 32 + fr, fq * 8);
#define PG8_SA(b, h) (((b) * 2 + (h)) * HTB)
#define PG8_SB(b, h) ((4 + (b) * 2 + (h)) * HTB)
#define PG8_STAGE(bufoff, gbase, voff) do { _Pragma("unroll") for (int _i = 0; _i < 2; ++_i) \
        __builtin_amdgcn_global_load_lds((const unsigned*)((const char*)(gbase) + (voff)[_i]), (PG8_LAS unsigned*)(lds + (bufoff) + ldsw + _i * 8192), 16, 0, 0); } while (0)
#define PG8_LDA(dst, b, h) do { _Pragma("unroll") for (int m = 0; m < 4; ++m) _Pragma("unroll") for (int k = 0; k < 2; ++k) dst[m][k] = *(const PG8_LAS bf16x8*)(lds + PG8_SA(b, h) + aoff + m * 2048 + k * 1024); } while (0)
#define PG8_LDB(dst, b, h) do { _Pragma("unroll") for (int n = 0; n < 2; ++n) _Pragma("unroll") for (int k = 0; k < 2; ++k) dst[n][k] = *(const PG8_LAS bf16x8*)(lds + PG8_SB(b, h) + boff + n * 2048 + k * 1024); } while (0)
#define PG8_MMA(ai, bj, At, Bt) do { __builtin_amdgcn_s_setprio(1); _Pragma("unroll") for (int m = 0; m < 4; ++m) _Pragma("unroll") for (int n = 0; n < 2; ++n) _Pragma("unroll") for (int k = 0; k < 2; ++k) \
        acc[ai][bj][m][n] = __builtin_amdgcn_mfma_f32_16x16x32_bf16(Bt[n][k], At[m][k], acc[ai][bj][m][n], 0, 0, 0); __builtin_amdgcn_s_setprio(0); } while (0)
#define PG8_WAIT_V(n) asm volatile("s_waitcnt vmcnt(" #n ")" ::: "memory")
#define PG8_WAIT_L(n) asm volatile("s_waitcnt lgkmcnt(" #n ")" ::: "memory")
#define PG8_BAR __builtin_amdgcn_s_barrier()
#define PG8_SCHED __builtin_amdgcn_sched_barrier(0)
    Unit cur, nxt; int ui = 0;
    if (!S.next(0, cur)) return;
    f32x4 acc[2][2][4][2];
#pragma unroll
    for (int a = 0; a < 2; ++a)
#pragma unroll
        for (int b = 0; b < 2; ++b)
#pragma unroll
            for (int m = 0; m < 4; ++m)
#pragma unroll
                for (int n = 0; n < 2; ++n) acc[a][b][m][n] = (f32x4){0.f, 0.f, 0.f, 0.f};
    bf16x8 At[4][2], B0[2][2], B1[2][2];
    const char* cA = (const char*)g.A + (size_t)cur.pm * tstepA + (size_t)(cur.pn / g.agdiv) * (size_t)g.agoff * 2; const char* cB = (const char*)g.Bt + (size_t)cur.pn * tstepB;
    S.a_ready(cur);
    if constexpr (SP2) {
        PG8_STAGE(PG8_SB(0, 0), cB, voffB); PG8_STAGE(PG8_SB(0, 1), cB + hstepB, voffB); PG8_STAGE(PG8_SA(0, 0), cA, voffA); PG8_STAGE(PG8_SA(0, 1), cA + hstepA, voffA);
        if (wr == 1) PG8_BAR;
        PG8_WAIT_V(2); PG8_BAR;
        PG8_STAGE(PG8_SB(1, 0), cB + kstep, voffB); PG8_STAGE(PG8_SA(1, 0), cA + kstep, voffA); PG8_STAGE(PG8_SB(1, 1), cB + hstepB + kstep, voffB);
        PG8_WAIT_V(6); PG8_BAR;
    } else {
        PG8_STAGE(PG8_SB(0, 0), cB, voffB); PG8_STAGE(PG8_SA(0, 0), cA, voffA); PG8_STAGE(PG8_SB(0, 1), cB + hstepB, voffB); PG8_STAGE(PG8_SA(0, 1), cA + hstepA, voffA);
        if (wr == 1) PG8_BAR;
        PG8_WAIT_V(4); PG8_BAR;
        PG8_STAGE(PG8_SB(1, 0), cB + kstep, voffB); PG8_STAGE(PG8_SA(1, 0), cA + kstep, voffA); PG8_STAGE(PG8_SB(1, 1), cB + hstepB + kstep, voffB);
        PG8_WAIT_V(6); PG8_BAR;
    }
    for (;;) {
        const bool has_next = S.next(ui + 1, nxt);
        const char* nA = has_next ? (const char*)g.A + (size_t)nxt.pm * tstepA + (size_t)(nxt.pn / g.agdiv) * (size_t)g.agoff * 2 : cA; const char* nB = has_next ? (const char*)g.Bt + (size_t)nxt.pn * tstepB : cB;
        for (int t = 0; t < nt; t += 2) {
            const bool last = (t == nt - 2);
            const char* a1 = cA + (size_t)(t + 1) * kstep;
            const char* a2 = last ? nA : cA + (size_t)(t + 2) * kstep; const char* b2 = last ? nB : cB + (size_t)(t + 2) * kstep;
            const char* a3 = a2 + kstep; const char* b3 = b2 + kstep;
            if (last && has_next) S.a_ready(nxt);
            if constexpr (SP2) {
            PG8_LDB(B0, 0, 0); PG8_LDB(B1, 0, 1); PG8_SCHED; PG8_LDA(At, 0, 0); PG8_STAGE(PG8_SA(1, 1), a1 + hstepA, voffA);
            PG8_WAIT_V(8); PG8_WAIT_L(0); PG8_BAR; PG8_MMA(0, 0, At, B0); PG8_MMA(0, 1, At, B1); PG8_BAR; PG8_SCHED;
            PG8_LDA(At, 0, 1); PG8_STAGE(PG8_SB(0, 0), b2, voffB); PG8_STAGE(PG8_SB(0, 1), b2 + hstepB, voffB); PG8_STAGE(PG8_SA(0, 0), a2, voffA);
            PG8_WAIT_V(8); PG8_WAIT_L(0); PG8_BAR; PG8_MMA(1, 0, At, B0); PG8_MMA(1, 1, At, B1); PG8_BAR; PG8_SCHED;
            PG8_LDB(B0, 1, 0); PG8_LDB(B1, 1, 1); PG8_SCHED; PG8_LDA(At, 1, 0); PG8_STAGE(PG8_SA(0, 1), a2 + hstepA, voffA);
            PG8_WAIT_V(8); PG8_WAIT_L(0); PG8_BAR; PG8_MMA(0, 0, At, B0); PG8_MMA(0, 1, At, B1); PG8_BAR; PG8_SCHED;
            PG8_LDA(At, 1, 1); PG8_STAGE(PG8_SB(1, 0), b3, voffB); PG8_STAGE(PG8_SB(1, 1), b3 + hstepB, voffB); PG8_STAGE(PG8_SA(1, 0), a3, voffA);
            PG8_WAIT_V(8); PG8_WAIT_L(0); PG8_BAR; PG8_MMA(1, 0, At, B0); PG8_MMA(1, 1, At, B1); PG8_BAR; PG8_SCHED;
            } else {
            PG8_LDB(B0, 0, 0); PG8_SCHED; PG8_LDA(At, 0, 0); PG8_STAGE(PG8_SA(1, 1), a1 + hstepA, voffA);
            PG8_WAIT_L(8); PG8_BAR; PG8_WAIT_L(0); PG8_MMA(0, 0, At, B0); PG8_BAR; PG8_SCHED;
            PG8_LDB(B1, 0, 1); PG8_STAGE(PG8_SB(0, 0), b2, voffB);
            PG8_BAR; PG8_WAIT_L(0); PG8_MMA(0, 1, At, B1); PG8_BAR;
            PG8_LDA(At, 0, 1); PG8_STAGE(PG8_SA(0, 0), a2, voffA);
            PG8_BAR; PG8_WAIT_L(0); PG8_MMA(1, 0, At, B0); PG8_BAR; PG8_SCHED;
            PG8_STAGE(PG8_SB(0, 1), b2 + hstepB, voffB);
            PG8_WAIT_V(6); PG8_BAR; PG8_MMA(1, 1, At, B1); PG8_BAR;
            PG8_LDB(B0, 1, 0); PG8_SCHED; PG8_LDA(At, 1, 0); PG8_STAGE(PG8_SA(0, 1), a2 + hstepA, voffA);
            PG8_WAIT_L(8); PG8_BAR; PG8_WAIT_L(0); PG8_MMA(0, 0, At, B0); PG8_BAR; PG8_SCHED;
            PG8_LDB(B1, 1, 1); PG8_STAGE(PG8_SB(1, 0), b3, voffB);
            PG8_BAR; PG8_WAIT_L(0); PG8_MMA(0, 1, At, B1); PG8_BAR;
            PG8_LDA(At, 1, 1); PG8_STAGE(PG8_SA(1, 0), a3, voffA);
            PG8_BAR; PG8_WAIT_L(0); PG8_MMA(1, 0, At, B0); PG8_BAR; PG8_SCHED;
            PG8_STAGE(PG8_SB(1, 1), b3 + hstepB, voffB);
            PG8_WAIT_V(6); PG8_BAR; PG8_MMA(1, 1, At, B1); PG8_BAR;
            }
        }
        if constexpr (ALIGN_EPI) { if (wr == 0) PG8_BAR; }
        if constexpr (!Epi::AFTER_DRAIN) { E(acc, cur, wr, wc, fr, fq); S.done(cur); }
        if (!has_next) break;
#pragma unroll
        for (int a = 0; a < 2; ++a)
#pragma unroll
            for (int b = 0; b < 2; ++b)
#pragma unroll
                for (int m = 0; m < 4; ++m)
#pragma unroll
                    for (int n = 0; n < 2; ++n) acc[a][b][m][n] = (f32x4){0.f, 0.f, 0.f, 0.f};
        cur = nxt; cA = nA; cB = nB; ++ui;
        if constexpr (ALIGN_EPI) { if (wr == 1) PG8_BAR; }
    }
    PG8_WAIT_V(0);
    if constexpr (!ALIGN_EPI) { if (wr == 0) PG8_BAR; }
    PG8_BAR;
    if constexpr (Epi::AFTER_DRAIN) { E.fused(acc, cur, wr, wc, fr, fq, lds, wid, lane); S.done(cur); }
#undef PG8_SA
#undef PG8_SB
#undef PG8_STAGE
#undef PG8_LDA
#undef PG8_LDB
#undef PG8_MMA
#undef PG8_WAIT_V
#undef PG8_WAIT_L
#undef PG8_BAR
#undef PG8_SCHED
}
}

constexpr int NB = 8, SEQ = 2048, DM = 2048, M_TOK = NB * SEQ, DFF = 8192, NLAYER = 2;
constexpr int LDQ = 6656;
constexpr int C_QA = 0, C_KA = 512, C_VA = 1024, C_QB = 1536, C_KB = 2048, C_VB = 2560, C_QD = 3072, C_KD = 3584, C_VD = 4096,
              C_BG = 4608, C_CG = 5120, C_XIN = 5632, C_IQ = 6144, C_IK = 6400, C_IW = 6464, C_FD = 6468, C_END = 6472;
constexpr float LOG2E = 1.4426950408889634f;
constexpr float IDX_SCALE = 0.0625f;
constexpr float RMS_EPS = 1e-6f;

typedef unsigned short bf16_t;
typedef short bf16x8 __attribute__((ext_vector_type(8)));
typedef short s16x4 __attribute__((ext_vector_type(4)));
typedef float f32x16 __attribute__((ext_vector_type(16)));
typedef float f32x4 __attribute__((ext_vector_type(4)));
typedef float f32x2 __attribute__((ext_vector_type(2)));
typedef unsigned u32x4 __attribute__((ext_vector_type(4)));
typedef unsigned u32x2 __attribute__((ext_vector_type(2)));

DI float bf2f(bf16_t v) { return __uint_as_float((unsigned)v << 16); }
DI unsigned cvtpk(float lo, float hi) { unsigned r; asm volatile("v_cvt_pk_bf16_f32 %0, %1, %2" : "=v"(r) : "v"(lo), "v"(hi)); return r; }
DI float wave_sum(float v) {
#pragma unroll
    for (int o = 1; o < 64; o <<= 1) v += __shfl_xor(v, o);
    return v;
}

namespace att {
constexpr int SHM_V = 16384, SHM_K = 16384;
constexpr int OFF_V = 0, OFF_K = 2 * SHM_V, OFF_WS = OFF_K + 2 * SHM_K, OFF_TAB = OFF_WS + 8 * 64 * 4, OFF_FK = OFF_TAB + 512, LDS_END = OFF_FK + 8192;
#define KSWZ(row, colB) ((row) * 256 + ((colB) ^ (((row) & 7) << 4)))
#define SBAR() __builtin_amdgcn_sched_barrier(0)
DI int v_st(int k, int c) { const int kk = (k & ~0xC) | ((k & 4) << 1) | ((k & 8) >> 1); return ((kk >> 3) * 4 + (c >> 5)) * 512 + ((kk & 7) * 32 + (c & 31)) * 2; }
DI int v_rd_base(int lane) { return ((lane & 3) << 3) | (((lane >> 2) & 3) << 6) | (((lane >> 4) & 1) << 5) | (((lane >> 5) & 1) << 8); }
constexpr int v_rd_off(int d0, int ks, int half) { return d0 * 512 + ks * 4096 + half * 2048; }
DI int crow(int r, int hi) { return (r & 3) + 8 * (r >> 2) + 4 * hi; }

template <int KB, int D0LO, int D0HI>
DI void qkt(f32x16& p0, f32x16& p1, LAS const char* K_lds, int r32, int hi, const bf16x8* qr) {
#pragma unroll
    for (int r = 0; r < 16; ++r) { p0[r] = 0.f; p1[r] = 0.f; }
    LAS const char* kb[4];
#pragma unroll
    for (int dd = 0; dd < 4; ++dd) kb[dd] = K_lds + KB * SHM_K + KSWZ(r32, (dd * 16 + hi * 8) * 2);
#pragma unroll
    for (int d0 = D0LO; d0 < D0HI; ++d0) { LAS const char* a = kb[d0 & 3] + (d0 >> 2) * 128;
        const bf16x8 b0 = *(LAS const bf16x8*)a;
        const bf16x8 b1 = *(LAS const bf16x8*)(a + 32 * 256);
        p0 = __builtin_amdgcn_mfma_f32_32x32x16_bf16(b0, qr[d0 - D0LO], p0, 0, 0, 0);
        p1 = __builtin_amdgcn_mfma_f32_32x32x16_bf16(b1, qr[d0 - D0LO], p1, 0, 0, 0); }
}
template <int VB>
DI void pv_tile(f32x16* o, int vb0, bf16x8 pa0, bf16x8 pa1, bf16x8 pa2, bf16x8 pa3) {
#define TRRD(dst, off) asm volatile("ds_read_b64_tr_b16 %0, %1 offset:%2" : "=&v"(dst) : "v"(vb0), "i"(off) : "memory")
#define PV_D0(d0) do { s16x4 l0, l1, l2, l3, h0, h1, h2, h3; constexpr int b_ = VB * SHM_V + v_rd_off(d0, 0, 0);     \
        TRRD(l0, b_); TRRD(h0, b_ + 2048); TRRD(l1, b_ + 4096); TRRD(h1, b_ + 6144); TRRD(l2, b_ + 8192); TRRD(h2, b_ + 10240); TRRD(l3, b_ + 12288); TRRD(h3, b_ + 14336); \
        asm volatile("s_waitcnt lgkmcnt(0)" ::: "memory"); SBAR();   \
        o[d0] = __builtin_amdgcn_mfma_f32_32x32x16_bf16(pa0, (bf16x8){l0[0], l0[1], l0[2], l0[3], h0[0], h0[1], h0[2], h0[3]}, o[d0], 0, 0, 0);   \
        o[d0] = __builtin_amdgcn_mfma_f32_32x32x16_bf16(pa1, (bf16x8){l1[0], l1[1], l1[2], l1[3], h1[0], h1[1], h1[2], h1[3]}, o[d0], 0, 0, 0);   \
        o[d0] = __builtin_amdgcn_mfma_f32_32x32x16_bf16(pa2, (bf16x8){l2[0], l2[1], l2[2], l2[3], h2[0], h2[1], h2[2], h2[3]}, o[d0], 0, 0, 0);   \
        o[d0] = __builtin_amdgcn_mfma_f32_32x32x16_bf16(pa3, (bf16x8){l3[0], l3[1], l3[2], l3[3], h3[0], h3[1], h3[2], h3[3]}, o[d0], 0, 0, 0); } while (0)
    PV_D0(0); PV_D0(1); PV_D0(2); PV_D0(3);
#undef PV_D0
#undef TRRD
}
DI int t5_bucket(int n) {
    if (n < 16) return n;
    int b = 16;
    b += (n >= 19); b += (n >= 21); b += (n >= 24); b += (n >= 27); b += (n >= 31); b += (n >= 35); b += (n >= 40); b += (n >= 46);
    b += (n >= 52); b += (n >= 59); b += (n >= 67); b += (n >= 77); b += (n >= 87); b += (n >= 99); b += (n >= 113);
    return b;
}

struct UnitArgs {
    const bf16_t* Qp; const bf16_t* Kp; const bf16_t* Vp; bf16_t* Op; int q0;
    const unsigned long long* maskp;
    const float* fcum;
    const float* relb; int relcol;
    float lam, post;
    const float* gsub;
    float* stash;
};

template <int MODE>
DI void attn_unit(LAS char* lds, const UnitArgs& A) {
    int tid_l = threadIdx.x; asm volatile("" : "+v"(tid_l));
    const int tid = tid_l, wid = __builtin_amdgcn_readfirstlane(tid >> 6), lane = tid & 63, r32 = lane & 31, hi = lane >> 5;
    const int q0 = A.q0, NT = (q0 + 256) / 64;
    LAS char* V_lds = lds + OFF_V; LAS char* K_lds = lds + OFF_K;
    LAS float* wsf = (LAS float*)(lds + OFF_WS) + wid * 64; LAS float* li_l = wsf; LAS float* al_l = wsf + 32;
    LAS float* tab = (LAS float*)(lds + OFF_TAB); LAS float* fk = (LAS float*)(lds + OFF_FK);
    const int qlo = q0 + wid * 32, qpos = qlo + r32;
    const int sr = tid >> 4, sc = (tid & 15) * 8;
    const int vst0 = v_st(sr, sc), vst1 = v_st(32 + sr, sc), kws = KSWZ(sr, sc * 2);
    const int vb0 = (int)(unsigned)(uintptr_t)V_lds + v_rd_base(lane);
    if (MODE == 0 || MODE == 1) { if (tid < 128) { const int bk = t5_bucket(tid); tab[tid] = (A.relb[bk * 8 + A.relcol] - A.relb[31 * 8 + A.relcol]) * LOG2E; } }
    float fqv = 0.f;
    if (MODE == 2) { for (int i = tid; i < q0 + 256; i += 512) fk[i] = A.fcum[i]; fqv = A.fcum[qpos]; }
    constexpr int NPASS = (MODE == 1) ? 2 : 1, NQ = (MODE == 1) ? 4 : 8;
#pragma unroll 1
    for (int pass = 0; pass < NPASS; ++pass) {
        bf16x8 qr[NQ];
#pragma unroll
        for (int d = 0; d < NQ; ++d) qr[d] = *(const bf16x8*)(A.Qp + (size_t)(qpos) * LDQ + (MODE == 1 ? pass * 64 : 0) + d * 16 + hi * 8);
        bf16x8 st_k0, st_k1, st_v0, st_v1;
#define SLOAD(k0) do { st_v0 = *(const bf16x8*)(A.Vp + (size_t)((k0) + sr) * LDQ + sc); st_v1 = *(const bf16x8*)(A.Vp + (size_t)((k0) + 32 + sr) * LDQ + sc); \
                       st_k0 = *(const bf16x8*)(A.Kp + (size_t)((k0) + sr) * LDQ + sc); st_k1 = *(const bf16x8*)(A.Kp + (size_t)((k0) + 32 + sr) * LDQ + sc); } while (0)
#define SWRITE(bf) do { *(LAS bf16x8*)(V_lds + (bf) * SHM_V + vst0) = st_v0; *(LAS bf16x8*)(V_lds + (bf) * SHM_V + vst1) = st_v1; \
                        *(LAS bf16x8*)(K_lds + (bf) * SHM_K + kws) = st_k0; *(LAS bf16x8*)(K_lds + (bf) * SHM_K + kws + 32 * 256) = st_k1; } while (0)
        SLOAD(0); SWRITE(0);
        __syncthreads();
        float m_reg = -1e30f, l_reg = 0.f; f32x16 o[4];
#pragma unroll
        for (int d = 0; d < 4; ++d)
#pragma unroll
            for (int r = 0; r < 16; ++r) o[d][r] = 0.f;
        f32x16 p0, p1; bf16x8 pa0, pa1, pa2, pa3;
#define STEP(t, KB) do { const int t_ = (t); const bool more_ = (t_ + 1 < NT); const int kbase = t_ * 64; \
        if (more_) SLOAD(kbase + 64); \
        unsigned long long mw_ = 0ull; if (MODE == 0) mw_ = A.maskp[(size_t)qpos * 32 + t_]; \
        if (MODE == 1) { if (pass == 0) qkt<KB, 0, 4>(p0, p1, K_lds, r32, hi, qr); else qkt<KB, 4, 8>(p0, p1, K_lds, r32, hi, qr); } \
        else qkt<KB, 0, 8>(p0, p1, K_lds, r32, hi, qr); \
        if (MODE == 0 || MODE == 1) { if (kbase + 63 + 113 > qlo) { const int dq_ = qpos - kbase - 4 * hi; \
            _Pragma("unroll") for (int r = 0; r < 16; ++r) { const int c_ = (r & 3) + 8 * (r >> 2); int i0 = dq_ - c_, i1 = dq_ - c_ - 32; \
                i0 = i0 < 0 ? 0 : (i0 > 127 ? 127 : i0); i1 = i1 < 0 ? 0 : (i1 > 127 ? 127 : i1); p0[r] += tab[i0]; p1[r] += tab[i1]; } } } \
        if (MODE == 2) { _Pragma("unroll") for (int g = 0; g < 4; ++g) { const f32x4 f0 = *(LAS const f32x4*)(fk + kbase + 8 * g + 4 * hi), f1 = *(LAS const f32x4*)(fk + kbase + 32 + 8 * g + 4 * hi); \
                _Pragma("unroll") for (int j = 0; j < 4; ++j) { p0[4 * g + j] += fqv - f0[j]; p1[4 * g + j] += fqv - f1[j]; } } } \
        if (kbase + 63 > qlo) { const int dq_ = qpos - kbase - 4 * hi; const float NEG_ = -__builtin_inff(); \
            _Pragma("unroll") for (int r = 0; r < 16; ++r) { const int c_ = (r & 3) + 8 * (r >> 2); if (dq_ - c_ < 0) p0[r] = NEG_; if (dq_ - c_ - 32 < 0) p1[r] = NEG_; } } \
        if (MODE == 0) { const unsigned wl_ = (unsigned)mw_ >> (4 * hi), wh_ = (unsigned)(mw_ >> 32) >> (4 * hi); const float NEG_ = -__builtin_inff(); \
            _Pragma("unroll") for (int r = 0; r < 16; ++r) { const int c_ = (r & 3) + 8 * (r >> 2); if (!((wl_ >> c_) & 1u)) p0[r] = NEG_; if (!((wh_ >> c_) & 1u)) p1[r] = NEG_; } } \
        float pmax_ = p0[0]; _Pragma("unroll") for (int r = 1; r < 16; ++r) pmax_ = fmaxf(pmax_, p0[r]); _Pragma("unroll") for (int r = 0; r < 16; ++r) pmax_ = fmaxf(pmax_, p1[r]); \
        { auto rr = __builtin_amdgcn_permlane32_swap(__float_as_uint(pmax_), __float_as_uint(pmax_), false, false); pmax_ = fmaxf(__uint_as_float(rr[0]), __uint_as_float(rr[1])); } \
        const float mn_ = fmaxf(m_reg, pmax_); const float alpha_ = __builtin_amdgcn_exp2f(m_reg - mn_); m_reg = mn_; \
        float ps_ = 0.f; \
        _Pragma("unroll") for (int r = 0; r < 16; ++r) { p0[r] = __builtin_amdgcn_exp2f(p0[r] - mn_); ps_ += p0[r]; } \
        _Pragma("unroll") for (int r = 0; r < 16; ++r) { p1[r] = __builtin_amdgcn_exp2f(p1[r] - mn_); ps_ += p1[r]; } \
        { auto rr = __builtin_amdgcn_permlane32_swap(__float_as_uint(ps_), __float_as_uint(ps_), false, false); ps_ = __uint_as_float(rr[0]) + __uint_as_float(rr[1]); } \
        l_reg = l_reg * alpha_ + ps_; \
        PK4(p0, 0, pa0); PK4(p0, 8, pa1); PK4(p1, 0, pa2); PK4(p1, 8, pa3); \
        if (__any(alpha_ < 1.f)) { if (hi == 0) al_l[r32] = alpha_; asm volatile("s_waitcnt lgkmcnt(0)" ::: "memory"); \
            _Pragma("unroll") for (int d_ = 0; d_ < 4; ++d_) _Pragma("unroll") for (int r = 0; r < 16; ++r) o[d_][r] *= al_l[crow(r, hi)]; } \
        SBAR(); pv_tile<KB>(o, vb0, pa0, pa1, pa2, pa3); \
        if (more_) { asm volatile("s_waitcnt vmcnt(0)" ::: "memory"); SWRITE((KB) ^ 1); } \
        __syncthreads(); } while (0)
#define PK4(P, B_, OUT) do { unsigned a0 = cvtpk(P[B_+0], P[B_+1]), a1 = cvtpk(P[B_+2], P[B_+3]);                          \
        unsigned b0 = cvtpk(P[B_+4], P[B_+5]), b1 = cvtpk(P[B_+6], P[B_+7]);                                             \
        auto r0 = __builtin_amdgcn_permlane32_swap(a0, b0, false, false); auto r1 = __builtin_amdgcn_permlane32_swap(a1, b1, false, false); \
        u32x4 w = {r0[0], r1[0], r0[1], r1[1]}; OUT = __builtin_bit_cast(bf16x8, w); } while (0)
#pragma unroll 1
        for (int t = 0; t < NT; t += 2) { STEP(t, 0); STEP(t + 1, 1); }
#undef STEP
#undef PK4
#undef SLOAD
#undef SWRITE
        if (hi == 0) li_l[r32] = l_reg; asm volatile("s_waitcnt lgkmcnt(0)" ::: "memory");
        float rli[16];
#pragma unroll
        for (int r = 0; r < 16; ++r) rli[r] = __builtin_amdgcn_rcpf(li_l[crow(r, hi)]);
        bf16_t* Ow = A.Op + (size_t)(qlo) * 2048; asm volatile("" : "+v"(Ow));
        if (MODE != 1) {
#pragma unroll
            for (int r = 0; r < 16; ++r) { const int orow = crow(r, hi);
#pragma unroll
                for (int d0 = 0; d0 < 4; ++d0) { const float v = o[d0][r] * rli[r]; const float vn = __shfl_xor(v, 1);
                    if ((r32 & 1) == 0) *(unsigned*)(Ow + (size_t)orow * 2048 + d0 * 32 + r32) = cvtpk(v, vn); } }
        } else if (pass == 0) {
#pragma unroll
            for (int d0 = 0; d0 < 4; ++d0)
#pragma unroll
                for (int r = 0; r < 16; r += 4) *(f32x4*)(A.stash + tid * 64 + d0 * 16 + r) = (f32x4){o[d0][r] * rli[r], o[d0][r + 1] * rli[r + 1], o[d0][r + 2] * rli[r + 2], o[d0][r + 3] * rli[r + 3]};
        } else {
            float ss[16];
#pragma unroll
            for (int d0 = 0; d0 < 4; ++d0)
#pragma unroll
                for (int r = 0; r < 16; r += 4) { const f32x4 sv = *(const f32x4*)(A.stash + tid * 64 + d0 * 16 + r);
#pragma unroll
                    for (int j = 0; j < 4; ++j) o[d0][r + j] = sv[j] - A.lam * (o[d0][r + j] * rli[r + j]); }
#pragma unroll
            for (int r = 0; r < 16; ++r) { float s = 0.f;
#pragma unroll
                for (int d0 = 0; d0 < 4; ++d0) { const float v = o[d0][r]; s += v * v; }
                s += __shfl_xor(s, 1); s += __shfl_xor(s, 2); s += __shfl_xor(s, 4); s += __shfl_xor(s, 8); s += __shfl_xor(s, 16);
                ss[r] = __builtin_amdgcn_rsqf(s * (1.f / 128.f) + RMS_EPS) * A.post;
                if ((r & 3) == 3) asm volatile("" ::: "memory"); }
#pragma unroll
            for (int d0 = 0; d0 < 4; ++d0) { const float gs = A.gsub[d0 * 32 + r32];
#pragma unroll
                for (int r = 0; r < 16; ++r) { const int orow = crow(r, hi); const float v = o[d0][r] * ss[r] * gs; const float vn = __shfl_xor(v, 1);
                    if ((r32 & 1) == 0) *(unsigned*)(Ow + (size_t)orow * 2048 + d0 * 32 + r32) = cvtpk(v, vn); } }
        }
        __syncthreads();
    }
}
#undef SBAR
}

#define XB_TMO      128
#define XB_XCNT(j)  (256  + 64 * (j))
#define XB_XSUB(j)  (1280 + 64 * (j))
#define XB_XGEN(j)  (2304 + 64 * (j))
#define XB_TOP      3328
#define XB_TOPGEN   3392
#define XCD_BAR_WORDS 3456
#define XB_SPIN_CAP (1u << 20)

__device__ __forceinline__ unsigned xb_ld(unsigned* p)              { return __hip_atomic_load(p, __ATOMIC_RELAXED, __HIP_MEMORY_SCOPE_AGENT); }
__device__ __forceinline__ unsigned xb_add(unsigned* p, unsigned v) { return __hip_atomic_fetch_add(p, v, __ATOMIC_RELAXED, __HIP_MEMORY_SCOPE_AGENT); }
__device__ __forceinline__ unsigned xb_xcc_id() { return (unsigned)__builtin_amdgcn_s_getreg((3 << 11) | 20) & 0xFu; }
#define XB_SPIN(cond, bar) do { unsigned _sp = 0; while (cond) { __builtin_amdgcn_s_sleep(1); \
    if ((++_sp & 255u) == 0u) { if (xb_ld(&(bar)[XB_TMO])) break; if (_sp > XB_SPIN_CAP) { atomicAdd(&(bar)[XB_TMO], 1u); break; } } } } while (0)

struct XcdBarrier {
    unsigned* bar; unsigned x;
    volatile LAS unsigned* st;
};

__device__ __forceinline__ XcdBarrier xcd_barrier_post(unsigned* bar, volatile LAS unsigned* st) {
    XcdBarrier b; b.bar = bar; b.x = xb_xcc_id(); b.st = st;
    if (threadIdx.x == 0) (void)xb_add(&bar[XB_XCNT(b.x)], 1u);
    return b;
}
__device__ __forceinline__ void xcd_barrier_complete(unsigned* bar, unsigned x, unsigned& nloc, unsigned& nx) {
    const unsigned G = gridDim.x * gridDim.y * gridDim.z;
    unsigned sum, cnt, mine, sp = 0u;
    for (;;) {
        sum = 0u; cnt = 0u; mine = 0u;
#pragma unroll
        for (unsigned j = 0; j < 16; ++j) { const unsigned c = xb_ld(&bar[XB_XCNT(j)]); sum += c; cnt += (c > 0u) ? 1u : 0u; mine = (j == x) ? c : mine; }
        if (sum == G) break;
        __builtin_amdgcn_s_sleep(1);
        if ((++sp & 255u) == 0u) { if (xb_ld(&bar[XB_TMO])) break; if (sp > XB_SPIN_CAP) { atomicAdd(&bar[XB_TMO], 1u); break; } }
    }
    nloc = mine > 0u ? mine : 1u; nx = cnt > 0u ? cnt : 1u;
}

__device__ __forceinline__ void xcd_barrier(const XcdBarrier& b) {
    asm volatile("s_waitcnt vmcnt(0)" ::: "memory");
    __syncthreads();
    if (threadIdx.x == 0) {
        unsigned* bar = b.bar; asm volatile("" : "+s"(bar));
        __builtin_amdgcn_s_waitcnt(0);
        unsigned nloc = b.st[0], nx = b.st[1];
        if (nloc == 0u) { xcd_barrier_complete(bar, b.x, nloc, nx); b.st[0] = nloc; b.st[1] = nx; }
        const unsigned old = xb_add(&bar[XB_XSUB(b.x)], 1u);
        const unsigned gen = old / nloc;
        if (old + 1u == (gen + 1u) * nloc) {
            __builtin_amdgcn_fence(__ATOMIC_RELEASE, "agent");
            asm volatile("s_waitcnt vmcnt(0)" ::: "memory");
            const unsigned og = xb_add(&bar[XB_TOP], 1u);
            const unsigned tg = og / nx;
            if (og + 1u == (tg + 1u) * nx) xb_add(&bar[XB_TOPGEN], 1u);
            else XB_SPIN(xb_ld(&bar[XB_TOPGEN]) == tg, bar);
            __builtin_amdgcn_fence(__ATOMIC_ACQUIRE, "agent");
            xb_add(&bar[XB_XGEN(b.x)], 1u);
            asm volatile("s_waitcnt vmcnt(0)" ::: "memory");
        } else {
            XB_SPIN(xb_ld(&bar[XB_XGEN(b.x)]) == gen, bar);
            __builtin_amdgcn_fence(__ATOMIC_ACQUIRE, "agent");
            asm volatile("s_waitcnt vmcnt(0)" ::: "memory");
        }
    }
    __syncthreads();
}
#define RLX_AGENT __ATOMIC_RELAXED, __HIP_MEMORY_SCOPE_AGENT
#define LDS_WAIT() asm volatile("s_waitcnt lgkmcnt(0)" ::: "memory")
DI unsigned f2bf(float f) { unsigned u = __builtin_bit_cast(unsigned, f); return (u + 0x7fffu + ((u >> 16) & 1u)) >> 16; }
DI unsigned pk2(float lo, float hi) { return f2bf(lo) | (f2bf(hi) << 16); }

struct MapPlain { DI int src(int n) const { return n; } DI float scale(int) const { return 1.f; } };
struct MapWin {
    DI int src(int n) const {
        if (n < 1536) return n;
        if (n < 3072) return 1860 + (n - 1536);
        if (n < 4608) return 4932 + (n - 3072);
        if (n < 6144) return 3396 + (n - 4608);
        if (n < 6400) return 1536 + (n - 6144);
        if (n < 6464) return 1792 + (n - 6400);
        if (n < 6468) return 1856 + (n - 6464);
        if (n < 6472) return 6468 + (n - 6468);
        return -1;
    }
    DI float scale(int n) const {
        if (n < 512) return 0.08838834764831845f * LOG2E;
        if (n >= 1536 && n < 2048) return 0.125f * LOG2E;
        if (n >= 3072 && n < 3584) return 0.08838834764831845f * LOG2E;
        return 1.f;
    }
};
struct MapGate {
    DI int src(int n) const { const int pn = n >> 8, c = n & 255; const int g = 2 * (c >> 7) + ((c >> 4) & 1), dl = 16 * ((c >> 5) & 3) + (c & 15); return g * 2048 + 64 * pn + dl; }
    DI float scale(int) const { return 1.f; }
};
template <class Map>
DI void transpose_item(const float* W, int K, int Nsrc, int nblk  , bf16_t* WT, const Map& map, LAS float* scr, int item, int lane) {
    const int kb = item / nblk, nb = item % nblk, k0 = 64 * kb, n0 = 32 * nb;
    const int nd = n0 + (lane & 31); const int s = map.src(nd); const float scl = map.scale(nd);
#pragma unroll 8
    for (int i = 0; i < 32; ++i) { const int kk = 2 * i + (lane >> 5); scr[kk * 33 + (lane & 31)] = (s >= 0) ? W[(size_t)(k0 + kk) * Nsrc + s] * scl : 0.f; }
    LDS_WAIT(); asm volatile("" ::: "memory");
    const int c = lane & 7;
#pragma unroll
    for (int j = 0; j < 4; ++j) { const int n = (lane >> 3) + 8 * j; const LAS float* sp = scr + (8 * c) * 33 + n;
        u32x4 o; o.x = pk2(sp[0 * 33], sp[1 * 33]); o.y = pk2(sp[2 * 33], sp[3 * 33]); o.z = pk2(sp[4 * 33], sp[5 * 33]); o.w = pk2(sp[6 * 33], sp[7 * 33]);
        *(u32x4*)(WT + (size_t)(n0 + n) * K + k0 + 8 * c) = o; }
    LDS_WAIT(); asm volatile("" ::: "memory");
}
DI void mod_partial_item(const float* c, const float* wada, float* modp, int item, int lane) {
    const int kc = item & 15, nb = (item >> 4) % 48, l = item / (16 * 48);
    const int k0 = kc * 128, n0 = nb * 256 + 4 * lane;
    const float* Wl = wada + (size_t)l * 2048 * 12288;
    f32x4 acc[8];
#pragma unroll
    for (int b = 0; b < 8; ++b) acc[b] = (f32x4){0.f, 0.f, 0.f, 0.f};
#pragma unroll 1
    for (int sub = 0; sub < 2; ++sub) {
        float cb[8];
#pragma unroll
        for (int b = 0; b < 8; ++b) { const float x = c[b * 2048 + k0 + 64 * sub + lane]; cb[b] = x / (1.f + __expf(-x)); }
#pragma unroll 8
        for (int kk = 0; kk < 64; ++kk) { const f32x4 w = *(const f32x4*)(Wl + (size_t)(k0 + 64 * sub + kk) * 12288 + n0);
#pragma unroll
            for (int b = 0; b < 8; ++b) { const float s = __builtin_bit_cast(float, __builtin_amdgcn_readlane(__builtin_bit_cast(int, cb[b]), kk)); acc[b] += s * w; } }
    }
#pragma unroll
    for (int b = 0; b < 8; ++b) *(f32x4*)(modp + ((size_t)(kc * 2 + l) * 8 + b) * 12288 + n0) = acc[b];
}
DI void norm_row(const float* xrow, bf16_t* orow, const f32x4 (&Av)[8], const f32x4 (&Bv)[8], int lane) {
    const f32x4* xr = (const f32x4*)xrow + lane;
    f32x4 v[8]; float s = 0.f;
#pragma unroll
    for (int j = 0; j < 8; ++j) { v[j] = xr[64 * j]; s += (v[j][0] * v[j][0] + v[j][1] * v[j][1]) + (v[j][2] * v[j][2] + v[j][3] * v[j][3]); }
    const float rstd = 1.f / sqrtf(wave_sum(s) * (1.f / 2048.f) + RMS_EPS);
    u32x2* o8 = (u32x2*)orow + lane;
#pragma unroll
    for (int j = 0; j < 8; ++j) { const f32x4 h = v[j] * rstd * Av[j] + Bv[j]; u32x2 w; w.x = cvtpk(h[0], h[1]); w.y = cvtpk(h[2], h[3]); o8[64 * j] = w; }
}
DI void final_row(float* xrow, const f32x4 (&Gv)[8], int lane) {
    f32x4* xr = (f32x4*)xrow + lane;
    f32x4 v[8]; float s = 0.f;
#pragma unroll
    for (int j = 0; j < 8; ++j) { v[j] = xr[64 * j]; s += (v[j][0] * v[j][0] + v[j][1] * v[j][1]) + (v[j][2] * v[j][2] + v[j][3] * v[j][3]); }
    const float rstd = 1.f / sqrtf(wave_sum(s) * (1.f / 2048.f) + RMS_EPS);
#pragma unroll
    for (int j = 0; j < 8; ++j) xr[64 * j] = v[j] * rstd * Gv[j];
}
DI void conv_task(const bf16_t* qkv, const float* cw, bf16_t* br, int row0, int lane) {
    const int ch = lane * 8;
    float w0[8], w1[8], w2[8];
#pragma unroll
    for (int j = 0; j < 8; ++j) { w0[j] = cw[ch + j]; w1[j] = cw[512 + ch + j]; w2[j] = cw[1024 + ch + j]; }
    float up2[8], up1[8];
    const bf16_t* rp = qkv + (size_t)row0 * LDQ + ch;
    auto load_u = [&](const bf16_t* r, float (&u)[8]) {
        const bf16x8 cg = *(const bf16x8*)(r + C_CG), xi = *(const bf16x8*)(r + C_XIN);
#pragma unroll
        for (int j = 0; j < 8; ++j) u[j] = bf2f((bf16_t)cg[j]) * bf2f((bf16_t)xi[j]);
    };
    if ((row0 & (SEQ - 1)) == 0) {
#pragma unroll
        for (int j = 0; j < 8; ++j) { up2[j] = 0.f; up1[j] = 0.f; }
    } else { load_u(rp - 2 * LDQ, up2); load_u(rp - LDQ, up1); }
    bf16_t* op = br + (size_t)row0 * 2048 + 1024 + ch;
#pragma unroll
    for (int i = 0; i < 8; ++i) { float u[8]; load_u(rp, u);
        const bf16x8 bg = *(const bf16x8*)(rp + C_BG);
        rp += LDQ; asm volatile("" : "+v"(rp));
        float y[8];
#pragma unroll
        for (int j = 0; j < 8; ++j) y[j] = bf2f((bf16_t)bg[j]) * (w0[j] * up2[j] + w1[j] * up1[j] + w2[j] * u[j]);
        u32x4 o; o.x = cvtpk(y[0], y[1]); o.y = cvtpk(y[2], y[3]); o.z = cvtpk(y[4], y[5]); o.w = cvtpk(y[6], y[7]);
        *(u32x4*)op = o; op += 2048; asm volatile("" : "+v"(op));
#pragma unroll
        for (int j = 0; j < 8; ++j) { up2[j] = up1[j]; up1[j] = u[j]; } }
}
DI void fcum_task(const bf16_t* qkvb  , float bf_h, int h, float* out  , int lane) {
    const bf16_t* p0 = qkvb + (size_t)(32 * lane) * LDQ + C_FD + h;
    float run = 0.f;
    { const bf16_t* p = p0;
#pragma unroll 1
      for (int i = 0; i < 32; ++i) { const float x = bf2f(*p) + bf_h; p += LDQ; run += fminf(x, 0.f) - log1pf(expf(-fabsf(x))); } }
    float incl = run;
#pragma unroll
    for (int o = 1; o < 64; o <<= 1) { const float y = __shfl_up(incl, o); if (lane >= o) incl += y; }
    float acc = incl - run;
    { const bf16_t* p = p0; float* op = out + 32 * lane;
#pragma unroll 1
      for (int i = 0; i < 32; ++i) { const float x = bf2f(*p) + bf_h; p += LDQ; acc += fminf(x, 0.f) - log1pf(expf(-fabsf(x))); op[i] = acc * LOG2E; } }
}
DI int rowsum16(int x) { x += __shfl_xor(x, 8); x += __shfl_xor(x, 4); x += __shfl_xor(x, 2); x += __shfl_xor(x, 1); return x; }
DI void select_task(const bf16_t* qkvb  , unsigned long long* mrow  , int t0, LAS unsigned long long* wl, int lane_in) {
    int lane = lane_in; asm volatile("" : "+v"(lane));
    const int fr = lane & 15, fq = lane >> 4, t = t0 + fq;
    const int nch = __builtin_amdgcn_readfirstlane((t0 + 3) / 512 + 1);
    const bf16_t* ap = qkvb + (size_t)(t0 + (fr >> 2)) * LDQ + C_IQ + (fr & 3) * 64 + fq * 8;
    const bf16x8 a0 = *(const bf16x8*)ap, a1 = *(const bf16x8*)(ap + 32);
    float w[4]; { const u32x2 ww = *(const u32x2*)(qkvb + (size_t)t * LDQ + C_IW);
        w[0] = __uint_as_float(ww.x << 16) * IDX_SCALE; w[1] = __uint_as_float(ww.x & 0xffff0000u) * IDX_SCALE; w[2] = __uint_as_float(ww.y << 16) * IDX_SCALE; w[3] = __uint_as_float(ww.y & 0xffff0000u) * IDX_SCALE; }
    unsigned u[128];
    const int tf = t - fr;
    const char* kbase = (const char*)qkvb + C_IK * 2;
    unsigned voff = (unsigned)(fr * LDQ + fq * 8) * 2u;
#pragma unroll
    for (int c = 0; c < 4; ++c) {
        if (c < nch) {
#pragma unroll
            for (int ii = 0; ii < 32; ++ii) { const int i = c * 32 + ii;
                const bf16x8 b0 = *(const bf16x8*)(kbase + voff), b1 = *(const bf16x8*)(kbase + voff + 64);
                voff += 16 * LDQ * 2; asm volatile("" : "+v"(voff));
                f32x4 acc = (f32x4){0.f, 0.f, 0.f, 0.f};
                acc = __builtin_amdgcn_mfma_f32_16x16x32_bf16(a0, b0, acc, 0, 0, 0);
                acc = __builtin_amdgcn_mfma_f32_16x16x32_bf16(a1, b1, acc, 0, 0, 0);
                const float sc = ((w[0] * fmaxf(acc[0], 0.f) + w[1] * fmaxf(acc[1], 0.f)) + w[2] * fmaxf(acc[2], 0.f)) + w[3] * fmaxf(acc[3], 0.f);
                unsigned bits = __float_as_uint(sc); if (bits == 0x80000000u) bits = 0u;
                const unsigned key = (bits & 0x80000000u) ? ~bits : (bits | 0x80000000u);
                u[i] = (16 * i <= tf) ? key : 0u; }
        } else {
#pragma unroll
            for (int ii = 0; ii < 32; ++ii) u[c * 32 + ii] = 0u;
        }
    }
#define CNT_GE(cnt, x, c) asm("v_cmp_ge_u32 vcc, %1, %2\n\tv_addc_co_u32 %0, vcc, 0, %0, vcc" : "+v"(cnt) : "v"(x), "v"(c) : "vcc")
#define CNT_GT(cnt, x, c) asm("v_cmp_gt_u32 vcc, %1, %2\n\tv_addc_co_u32 %0, vcc, 0, %0, vcc" : "+v"(cnt) : "v"(x), "v"(c) : "vcc")
#define FOR_CHUNKS(BODY) _Pragma("unroll") for (int c_ = 0; c_ < 4; ++c_) { if (c_ < nch) { _Pragma("unroll") for (int ii_ = 0; ii_ < 32; ++ii_) { const int i = c_ * 32 + ii_; BODY; } } }
    unsigned T = 0u;
#pragma unroll 1
    for (int bit = 31; bit >= 0; --bit) { const unsigned c = T | (1u << bit); int cnt = 0;
        FOR_CHUNKS(CNT_GE(cnt, u[i], c));
        cnt = rowsum16(cnt); if (cnt >= 256) T = c; }
    int cgt = 0, cge = 0;
    FOR_CHUNKS(CNT_GT(cgt, u[i], T); CNT_GE(cge, u[i], T));
    cgt = rowsum16(cgt); cge = rowsum16(cge);
    const int need = 256 - cgt; const bool tie = (cge - cgt) > need;
    int X0 = 4095;
    if (__any(tie)) { int x = 0; const unsigned notT = ~T;
#pragma unroll 1
        for (int bit = 10; bit >= 0; --bit) { const int c = x | (1 << bit); int g = 0; const int cf = c - fr;
            FOR_CHUNKS(unsigned tmp;
                asm("v_cmp_lt_i32 vcc, %6, %3\n\tv_cndmask_b32 %1, %4, %2, vcc\n\tv_cmp_eq_u32 vcc, %1, %5\n\tv_addc_co_u32 %0, vcc, 0, %0, vcc"
                    : "+v"(g), "=&v"(tmp) : "v"(u[i]), "v"(cf), "v"(notT), "v"(T), "n"(16 * i) : "vcc"));
            g = rowsum16(g); if (g < need) x = c; }
        if (tie) X0 = x; }
#undef CNT_GE
#undef CNT_GT
    const int xf = X0 - fr;
    FOR_CHUNKS(const bool sel = (u[i] > T) || (u[i] == T && 16 * i <= xf);
        const unsigned long long bal = __ballot(sel); if (lane == 0) wl[i] = bal;
        if ((i & 3) == 3) asm volatile("" ::: "memory"));
#undef FOR_CHUNKS
    LDS_WAIT(); asm volatile("" ::: "memory");
#pragma unroll
    for (int half = 0; half < 2; ++half) { const int j = fr + 16 * half; unsigned long long word = 0ull;
        if (j < nch * 8) {
#pragma unroll
            for (int i4 = 0; i4 < 4; ++i4) word |= ((wl[4 * j + i4] >> (16 * fq)) & 0xFFFFull) << (16 * i4); }
        mrow[(size_t)t * 32 + j] = word; }
    LDS_WAIT(); asm volatile("" ::: "memory");
}
DI void select_causal_task(unsigned long long* mrow, int t0, int lane) {
    const int fr = lane & 15, fq = lane >> 4, t = t0 + fq;
#pragma unroll
    for (int half = 0; half < 2; ++half) { const int j = fr + 16 * half; const int n = t - 64 * j + 1;
        const unsigned long long word = n >= 64 ? ~0ull : (n <= 0 ? 0ull : ((1ull << n) - 1ull));
        mrow[(size_t)t * 32 + j] = word; }
}
DI void select_any(const bf16_t* qkvb, unsigned long long* mrow, int t0, LAS unsigned long long* wl, int lane) {
    if (t0 + 3 < 256) select_causal_task(mrow, t0, lane);
    else select_task(qkvb, mrow, t0, wl, lane);
}

constexpr size_t MiB = 1u << 20;
constexpr size_t WS_CTL = 0, CTL_ZERO_BYTES = 1 * MiB;
constexpr size_t WS_MODF = 1 * MiB;
constexpr size_t WS_MODP = 2 * MiB;
constexpr size_t WS_FCUM = 14 * MiB;
constexpr size_t WS_MASK = 15 * MiB;
constexpr size_t WS_STASH = 20 * MiB;
constexpr size_t WS_W = 52 * MiB;
constexpr size_t OW_IN = 0, OW_G = 26 * MiB, OW_B = 58 * MiB, OW_O = 66 * MiB, OW_1 = 74 * MiB, OW_2 = 106 * MiB, LW_BYTES = 138 * MiB;
constexpr size_t WS_H = WS_W + 2 * LW_BYTES;
constexpr size_t WS_BR = WS_H + 64 * MiB;
constexpr size_t WS_R1 = WS_BR + 64 * MiB;
constexpr size_t WS_END = WS_R1 + 256 * MiB;
constexpr int CW_BAR = 4096;
constexpr int CW_QUEUE = 16384;

constexpr int RING_OFF = 0, RING_BYTES = 131072;
constexpr int LDSCTL_OFF = RING_BYTES, MISC_OFF = LDSCTL_OFF + 320;
constexpr int LDS_BYTES = 147456;
static_assert(att::LDS_END <= RING_BYTES, "attention scratch inside the ring region");


constexpr int NWAVES = 8;
constexpr int N_PHASES = 23;
struct Args { const float* in[19]; float* out; unsigned char* ws; int ph_lo, ph_hi; };

typedef __attribute__((address_space(4))) const unsigned char* kargp_t;
DI kargp_t karg_base() { kargp_t kp = (kargp_t)__builtin_amdgcn_kernarg_segment_ptr(); asm volatile("" : "+s"(kp)); return kp; }
typedef const float* cfptr_t; typedef float* fptr_t; typedef unsigned char* ucptr_t;
DI const float* karg_in(int i) { return *(const __attribute__((address_space(4))) cfptr_t*)(karg_base() + 8 * i); }
DI float* karg_out() { return *(const __attribute__((address_space(4))) fptr_t*)(karg_base() + 8 * 19); }
DI unsigned char* karg_ws() { return *(const __attribute__((address_space(4))) ucptr_t*)(karg_base() + 8 * 20); }
#define ARG_IN(i) karg_in(i)

template <int MODE>
DI void attn_queue(LAS unsigned char* lds, volatile LAS unsigned* MISC, int qidx, int l, int tid, int lane) {
    unsigned char* ws = karg_ws();
    unsigned* qhead = (unsigned*)(ws + WS_CTL) + CW_QUEUE + 64 * qidx;
    bf16_t* QKV = (bf16_t*)(ws + WS_R1); bf16_t* BR = (bf16_t*)(ws + WS_BR);
    float lamv = 0.f, post = 0.f;
    if (MODE == 1) { const float* lq = ARG_IN(8) + l * 256; const float a = wave_sum(lq[lane] * lq[64 + lane]), b = wave_sum(lq[128 + lane] * lq[192 + lane]);
        const float lam_init = 0.8f - 0.6f * expf(-0.3f * (float)l); lamv = expf(a) - expf(b) + lam_init; post = 1.f - lam_init; }
    for (;;) {
        if (tid == 0) MISC[0] = __hip_atomic_fetch_add(qhead, 1u, RLX_AGENT);
        __syncthreads();
        const unsigned u = MISC[0];
        __syncthreads();
        if (u >= 256u) break;
        const int qb = 7 - (int)(u >> 5), bh = (int)(u & 31u), b = bh >> 2, h = bh & 3;
        att::UnitArgs A;
        const size_t rowb = (size_t)b * SEQ;
        const int cq = MODE == 0 ? C_QA : (MODE == 1 ? C_QB : C_QD), ck = MODE == 0 ? C_KA : (MODE == 1 ? C_KB : C_KD), cv = MODE == 0 ? C_VA : (MODE == 1 ? C_VB : C_VD);
        const int oc = MODE == 0 ? 0 : (MODE == 1 ? 512 : 1536);
        A.Qp = QKV + rowb * LDQ + cq + h * 128; A.Kp = QKV + rowb * LDQ + ck + h * 128; A.Vp = QKV + rowb * LDQ + cv + h * 128;
        A.Op = BR + rowb * 2048 + oc + h * 128; A.q0 = qb * 256;
        A.maskp = (const unsigned long long*)(ws + WS_MASK) + rowb * 32;
        A.fcum = (const float*)(ws + WS_FCUM) + (size_t)(b * 4 + h) * SEQ;
        A.relb = ARG_IN(10); A.relcol = (MODE == 1 ? 4 : 0) + h;
        A.lam = lamv; A.post = post; A.gsub = ARG_IN(9) + l * 128;
        A.stash = (float*)(ws + WS_STASH) + (size_t)blockIdx.x * 64 * 512;
        att::attn_unit<MODE>((LAS char*)lds, A);
    }
}

#define IN(k) (lo <= (k) && (k) < hi)
#define SEAM(k) do { if (IN((k) + 1)) xcd_barrier(bar); } while (0)
#define PH_PTRS int tid_p = threadIdx.x; asm volatile("" : "+v"(tid_p)); const int tid = tid_p, lane = tid & 63; (void)lane; unsigned char* ws = karg_ws(); float* xbuf = karg_out(); float* modf = (float*)(ws + WS_MODF); float* modp = (float*)(ws + WS_MODP); \
    bf16_t* Hb = (bf16_t*)(ws + WS_H); bf16_t* BR = (bf16_t*)(ws + WS_BR); bf16_t* R1 = (bf16_t*)(ws + WS_R1); \
    (void)xbuf; (void)modf; (void)modp; (void)Hb; (void)BR; (void)R1
#define PH_LAYER PH_PTRS; unsigned char* wl_ = ws + WS_W + (size_t)l * LW_BYTES; const float* modl = modf + (size_t)l * 8 * 12288; (void)wl_; (void)modl
template <int l, int LO, int HI>
DI void layer_phases(LAS unsigned char* lds, volatile LAS unsigned* MISC, const XcdBarrier& bar, int wave, int G, int bx, int gw, int NGW) {
    constexpr int lo = LO, hi = HI;
        const int pb = 2 + 10 * l;
        if (IN(pb + 0)) { PH_LAYER;
            const float* xs = (l == 0) ? ARG_IN(0) : (const float*)xbuf; const float* g1 = ARG_IN(4) + l * 2048;
            for (int rb = gw; rb < M_TOK / 8; rb += NGW) { const int b = (rb * 8) / SEQ; f32x4 Av[8], Bv[8];
#pragma unroll
                for (int j = 0; j < 8; ++j) { const int c = 4 * lane + 256 * j; const f32x4 g = *(const f32x4*)(g1 + c), sc = *(const f32x4*)(modl + b * 12288 + 2048 + c); Av[j] = g * (sc + 1.f); Bv[j] = *(const f32x4*)(modl + b * 12288 + c); }
#pragma unroll 1
                for (int i = 0; i < 8; ++i) norm_row(xs + (size_t)(rb * 8 + i) * 2048, Hb + (size_t)(rb * 8 + i) * 2048, Av, Bv, lane); }
            SEAM(pb + 0);
        }
        if (IN(pb + 1)) { PH_LAYER;
            pg8::Gemm g{Hb, (const bf16_t*)(wl_ + OW_IN), M_TOK, LDQ, 2048, 2048, 2048, 1 << 30, 0}; pg8::StaticOrder S; S.init(M_TOK, LDQ, G, bx);
            pg8::EpiBf16<0> E{R1, LDQ};

#ifndef NO_G1
            pg8::gemm_phase<pg8::EpiBf16<0>, pg8::StaticOrder, true, true>(lds + RING_OFF, g, S, E);
#endif
            SEAM(pb + 1);
        }
        if (IN(pb + 2)) { PH_LAYER;
            LAS unsigned long long* wlq = (LAS unsigned long long*)(lds + RING_OFF) + wave * 128;
            unsigned long long* mask = (unsigned long long*)(ws + WS_MASK);
            for (int k = gw; k < 2048; k += NGW) {
#pragma unroll 1
                for (int pass = 0; pass < 2; ++pass) { const int kk = pass ? 4095 - k : k; const int b = kk & 7, t0 = (kk >> 3) * 4;
#ifndef NO_SELECT
                    select_any(R1 + (size_t)b * SEQ * LDQ, mask + (size_t)b * SEQ * 32, t0, wlq, lane);
#endif
                } }
#ifndef NO_CONV
            for (int rb = gw; rb < M_TOK / 8; rb += NGW) conv_task(R1, ARG_IN(7) + l * 1536, BR, rb * 8, lane);
#endif
#ifndef NO_FCUM
            for (int k = gw; k < 32; k += NGW) { const int b = k >> 2, h = k & 3; fcum_task(R1 + (size_t)b * SEQ * LDQ, ARG_IN(6)[l * 4 + h], h, (float*)(ws + WS_FCUM) + (size_t)k * SEQ, lane); }
#endif
            SEAM(pb + 2);
        }
        if (IN(pb + 3)) { PH_LAYER;
#ifndef NO_ATT1
            attn_queue<1>(lds + RING_OFF, MISC, 3 * l + 0, l, tid, lane);
#endif
#ifndef NO_ATT0
            attn_queue<0>(lds + RING_OFF, MISC, 3 * l + 1, l, tid, lane);
#endif
#ifndef NO_ATT2
            attn_queue<2>(lds + RING_OFF, MISC, 3 * l + 2, l, tid, lane);
#endif
            SEAM(pb + 3);
        }
        if (IN(pb + 4)) { PH_LAYER;
            pg8::Gemm g{BR, (const bf16_t*)(wl_ + OW_B), M_TOK, 8192, 512, 2048, 512, 8, 512}; pg8::StaticOrder S; S.init(M_TOK, 8192, G, bx);
            pg8::EpiBf16<0> E{R1, 8192};

#ifndef NO_G2
            pg8::gemm_phase<pg8::EpiBf16<0>, pg8::StaticOrder, true, true>(lds + RING_OFF, g, S, E);
#endif
            SEAM(pb + 4);
        }
        if (IN(pb + 5)) { PH_LAYER;
            pg8::Gemm g{Hb, (const bf16_t*)(wl_ + OW_G), M_TOK, 8192, 2048, 2048, 2048, 1 << 30, 0}; pg8::StaticOrder S; S.init(M_TOK, 8192, G, bx);
            pg8::EpiGate E{R1, ARG_IN(12) + l * 8192, BR};

#ifndef NO_G3
            pg8::gemm_phase<pg8::EpiGate, pg8::StaticOrder, true, true>(lds + RING_OFF, g, S, E);
#endif

            SEAM(pb + 5);
        }
        if (IN(pb + 6)) { PH_LAYER;
            pg8::Gemm g{BR, (const bf16_t*)(wl_ + OW_O), M_TOK, 2048, 2048, 2048, 2048, 1 << 30, 0}; pg8::StaticOrder S; S.init(M_TOK, 2048, G, bx);
            pg8::EpiResid E{(l == 0) ? ARG_IN(0) : (const float*)xbuf, xbuf, modl + 4096, 12288};

#ifndef NO_G4
            pg8::gemm_phase<pg8::EpiResid, pg8::StaticOrder, true, true>(lds + RING_OFF, g, S, E);
#endif
            SEAM(pb + 6);
        }
        if (IN(pb + 7)) { PH_LAYER;
            const float* g2 = ARG_IN(15) + l * 2048;
            for (int rb = gw; rb < M_TOK / 8; rb += NGW) { const int b = (rb * 8) / SEQ; f32x4 Av[8], Bv[8];
#pragma unroll
                for (int j = 0; j < 8; ++j) { const int c = 4 * lane + 256 * j; const f32x4 g = *(const f32x4*)(g2 + c), sc = *(const f32x4*)(modl + b * 12288 + 8192 + c); Av[j] = g * (sc + 1.f); Bv[j] = *(const f32x4*)(modl + b * 12288 + 6144 + c); }
#pragma unroll 1
                for (int i = 0; i < 8; ++i) norm_row(xbuf + (size_t)(rb * 8 + i) * 2048, Hb + (size_t)(rb * 8 + i) * 2048, Av, Bv, lane); }
            SEAM(pb + 7);
        }
        if (IN(pb + 8)) { PH_LAYER;
            pg8::Gemm g{Hb, (const bf16_t*)(wl_ + OW_1), M_TOK, 8192, 2048, 2048, 2048, 1 << 30, 0}; pg8::StaticOrder S; S.init(M_TOK, 8192, G, bx);
            pg8::EpiBf16<2> E{R1, 8192};

#ifndef NO_G5
            pg8::gemm_phase<pg8::EpiBf16<2>, pg8::StaticOrder, true, true>(lds + RING_OFF, g, S, E);
#endif

            SEAM(pb + 8);
        }
        if (IN(pb + 9)) { PH_LAYER;
            pg8::Gemm g{R1, (const bf16_t*)(wl_ + OW_2), M_TOK, 2048, 8192, 8192, 8192, 1 << 30, 0}; pg8::StaticOrder S; S.init(M_TOK, 2048, G, bx);
            pg8::EpiResid E{xbuf, xbuf, modl + 10240, 12288};

#ifndef NO_G6
            pg8::gemm_phase<pg8::EpiResid, pg8::StaticOrder, true, true>(lds + RING_OFF, g, S, E);
#endif
            SEAM(pb + 9);
        }
}

template <int LO, int HI>
__global__ void __launch_bounds__(NWAVES * 64, 2) mk_fwd(Args args) {
    extern __shared__ __attribute__((aligned(16))) unsigned char lds_raw[];
    LAS unsigned char* lds = (LAS unsigned char*)lds_raw;
    volatile LAS unsigned* MISC = (volatile LAS unsigned*)(lds + MISC_OFF);
    const int tid0 = threadIdx.x, wave = __builtin_amdgcn_readfirstlane(tid0 >> 6);
    const int G = gridDim.x; const int bx = blockIdx.x; const int vcu = (G % 8 == 0) ? (bx % 8) * (G / 8) + bx / 8 : bx;
    const int gw = vcu * NWAVES + wave, NGW = G * NWAVES;
    for (int u = tid0; u < (LDS_BYTES - LDSCTL_OFF) / 4; u += NWAVES * 64) ((LAS unsigned*)(lds + LDSCTL_OFF))[u] = 0u;
    __syncthreads();
    constexpr int lo = LO, hi = HI; (void)args;
    XcdBarrier bar; bar.bar = (unsigned*)(karg_ws() + WS_CTL) + CW_BAR; bar.x = 0; bar.st = nullptr;
    if constexpr (hi - lo > 1) bar = xcd_barrier_post((unsigned*)(karg_ws() + WS_CTL) + CW_BAR, MISC + 8);

    if (IN(0)) { PH_PTRS;
        LAS float* scr = (LAS float*)(lds + RING_OFF + wave * 16384);
        constexpr int I_IN = 32 * 208, I_G = 32 * 256, I_B = 4 * 8 * 64, I_O = 32 * 64, I_1 = 32 * 256, I_2 = 128 * 64, I_L = I_IN + I_G + I_B + I_O + I_1 + I_2;
        for (int it = gw; it < 2 * I_L; it += NGW) {
            const int l = it / I_L; int r = it % I_L;
            unsigned char* wl_ = ws + WS_W + (size_t)l * LW_BYTES;
            if (r < I_IN) { transpose_item(ARG_IN(5) + (size_t)l * 2048 * 6472, 2048, 6472, 208, (bf16_t*)(wl_ + OW_IN), MapWin(), scr, r, lane); continue; } r -= I_IN;
            if (r < I_G) { transpose_item(ARG_IN(11) + (size_t)l * 2048 * 8192, 2048, 8192, 256, (bf16_t*)(wl_ + OW_G), MapGate(), scr, r, lane); continue; } r -= I_G;
            const float* W; int K, Ns, nblk; bf16_t* WT;
            if (r < I_B) { const int g = r / 512; r -= g * 512; W = ARG_IN(13) + (size_t)(l * 4 + g) * 512 * 2048; K = 512; Ns = 2048; nblk = 64; WT = (bf16_t*)(wl_ + OW_B) + (size_t)g * 2048 * 512; }
            else { r -= I_B;
                if (r < I_O) { W = ARG_IN(14) + (size_t)l * 2048 * 2048; K = 2048; Ns = 2048; nblk = 64; WT = (bf16_t*)(wl_ + OW_O); }
                else { r -= I_O;
                    if (r < I_1) { W = ARG_IN(16) + (size_t)l * 2048 * 8192; K = 2048; Ns = 8192; nblk = 256; WT = (bf16_t*)(wl_ + OW_1); }
                    else { r -= I_1; W = ARG_IN(17) + (size_t)l * 8192 * 2048; K = 8192; Ns = 2048; nblk = 64; WT = (bf16_t*)(wl_ + OW_2); } } }
            transpose_item(W, K, Ns, nblk, WT, MapPlain(), scr, r, lane);
        }
        for (int it = gw; it < 2 * 48 * 16; it += NGW) mod_partial_item(ARG_IN(1), ARG_IN(2), modp, it, lane);
        SEAM(0);
    }
    if (IN(1)) { PH_PTRS;
        for (int i = bx * 512 + tid; i < 2 * 8 * 12288; i += G * 512) { const int n = i % 12288, l = i / (8 * 12288);
            float s = ARG_IN(3)[l * 12288 + n];
#pragma unroll
            for (int kc = 0; kc < 16; ++kc) s += modp[(size_t)kc * (2 * 8 * 12288) + i];
            modf[i] = s; }
        SEAM(1);
    }
    constexpr int L_LO = (LO <= 2) ? 0 : (LO - 2) / 10, L_HI = (HI >= 22) ? NLAYER : (HI - 2 + 9) / 10;
    if constexpr (L_LO <= 0 && 0 < L_HI) layer_phases<0, LO, HI>(lds, MISC, bar, wave, G, bx, gw, NGW);
    if constexpr (L_LO <= 1 && 1 < L_HI) layer_phases<1, LO, HI>(lds, MISC, bar, wave, G, bx, gw, NGW);
    if (IN(22)) { PH_PTRS;
        f32x4 Gv[8];
#pragma unroll
        for (int j = 0; j < 8; ++j) Gv[j] = *(const f32x4*)(ARG_IN(18) + 4 * lane + 256 * j);
        for (int rb = gw; rb < M_TOK / 8; rb += NGW) {
#pragma unroll 1
            for (int i = 0; i < 8; ++i) final_row(xbuf + (size_t)(rb * 8 + i) * 2048, Gv, lane); }
    }
}

#if !MK_ONE_LAUNCH
template <int P> static void set_attr_from() { if constexpr (P < N_PHASES) { (void)hipFuncSetAttribute((const void*)mk_fwd<P, P + 1>, hipFuncAttributeMaxDynamicSharedMemorySize, LDS_BYTES); set_attr_from<P + 1>(); } }
template <int P> static void launch_from(int grid, hipStream_t stream, Args a) {
    if constexpr (P < N_PHASES) { a.ph_lo = P; a.ph_hi = P + 1; hipLaunchKernelGGL((mk_fwd<P, P + 1>), dim3(grid), dim3(NWAVES * 64), LDS_BYTES, stream, a); launch_from<P + 1>(grid, stream, a); } }
#endif
extern "C" void kernel_launch(void* const* d_in, const int* in_sizes, int n_in, void* d_out, int out_size, void* d_ws, size_t ws_size, hipStream_t stream) {
    static int grid = 0;
    if (grid == 0) {
        if (n_in != 19 || in_sizes[0] != M_TOK * DM || out_size != M_TOK * DM || ws_size < WS_END) {
            fprintf(stderr, "kernel_launch: shape / workspace mismatch (n_in %d, in0 %d, out %d, ws %zu, need %zu); nothing launched\n", n_in, n_in > 0 ? in_sizes[0] : -1, out_size, ws_size, (size_t)WS_END); grid = -1; return; }
        int dev = 0, cus = 0, per_cu = 0;
        if (hipGetDevice(&dev) != hipSuccess || hipDeviceGetAttribute(&cus, hipDeviceAttributeMultiprocessorCount, dev) != hipSuccess) { fprintf(stderr, "kernel_launch: device query failed\n"); grid = -1; return; }
#if MK_ONE_LAUNCH
        if (hipFuncSetAttribute((const void*)mk_fwd<0, N_PHASES>, hipFuncAttributeMaxDynamicSharedMemorySize, LDS_BYTES) != hipSuccess) { fprintf(stderr, "kernel_launch: hipFuncSetAttribute failed\n"); grid = -1; return; }
        if (hipOccupancyMaxActiveBlocksPerMultiprocessor(&per_cu, (const void*)mk_fwd<0, N_PHASES>, NWAVES * 64, LDS_BYTES) != hipSuccess || per_cu < 1) fprintf(stderr, "kernel_launch: occupancy query reports %d workgroups per CU\n", per_cu);
#else
        set_attr_from<0>();
#endif
        (void)hipGetLastError();
        grid = cus;
    }
    if (grid < 0) return;
    if (hipMemsetAsync((char*)d_ws + WS_CTL, 0, CTL_ZERO_BYTES, stream) != hipSuccess) { fprintf(stderr, "kernel_launch: memset failed\n"); return; }
    Args a{};
    for (int i = 0; i < 19; ++i) a.in[i] = (const float*)d_in[i];
    a.out = (float*)d_out; a.ws = (unsigned char*)d_ws;
#if MK_ONE_LAUNCH
    a.ph_lo = 0; a.ph_hi = N_PHASES;
    hipLaunchKernelGGL((mk_fwd<0, N_PHASES>), dim3(grid), dim3(NWAVES * 64), LDS_BYTES, stream, a);
#else
    launch_from<0>(grid, stream, a);
#endif
    const hipError_t le = hipPeekAtLastError();
    if (le != hipSuccess) fprintf(stderr, "kernel_launch: launch failed: %s\n", hipGetErrorName(le));
}
```

```cpp
#include <hip/hip_runtime.h>
#include <cstdio>
#include <cstdint>

#ifndef MK_ONE_LAUNCH
#define MK_ONE_LAUNCH 1
#endif

#define DI __device__ __forceinline__
#define LAS __attribute__((address_space(3)))
#define GAS __attribute__((address_space(1)))

namespace pg8 {
#define PG8_LAS __attribute__((address_space(3)))
typedef unsigned short bf16_t;
typedef short bf16x8 __attribute__((ext_vector_type(8)));
typedef float f32x4 __attribute__((ext_vector_type(4)));
typedef float f32x2 __attribute__((ext_vector_type(2)));
typedef unsigned u32x4 __attribute__((ext_vector_type(4)));
typedef unsigned u32x2 __attribute__((ext_vector_type(2)));
constexpr int BM = 256, BK = 64, HALF = 128, HTB = HALF * BK * 2  , STAGE_BYTES = 8 * HTB, NXCD = 8, WGM = 8;

__host__ __device__ __forceinline__ int lds_byte(int r, int c) { const int st = (r >> 4) * 2 + (c >> 5), rr = r & 15, cc = c & 31, ob = rr * 64 + cc * 2; return st * 1024 + (ob ^ (((ob >> 9) & 1) << 5)); }
__host__ __device__ __forceinline__ void stage_rc(int b, int& R, int& C) { const int st = b / 1024, sb = b % 1024, swz = sb ^ (((sb >> 9) & 1) << 5); R = (st >> 1) * 16 + swz / 64; C = (st & 1) * 32 + (swz % 64) / 2; }
__host__ __device__ __forceinline__ int perm32(int rho) { const int n = rho >> 4, i = rho & 15; return 8 * (i >> 2) + 4 * n + (i & 3); }

struct Unit { int pm, pn; };
struct Gemm { const bf16_t* A; const bf16_t* Bt; int M, N, K, lda, ldb, agdiv, agoff; };

struct StaticOrder {
    int nM, nN, nwg, G, c;
    __host__ __device__ void init(int M, int N, int G_, int c_) { nM = M / BM; nN = N / BM; nwg = nM * nN; G = G_; c = c_; }
    __host__ __device__ bool next(int i, Unit& u) const {
        const long L = (long)i * G + c; if (L >= nwg) return false;
        int wgid = (int)L; { const int q = nwg / NXCD, r = nwg % NXCD, xcd = wgid % NXCD, off = wgid / NXCD; wgid = (xcd < r ? xcd * (q + 1) : r * (q + 1) + (xcd - r) * q) + off; }
        const int nig = WGM * nN, gid = wgid / nig, fm = gid * WGM, gsz = (nM - fm) < WGM ? (nM - fm) : WGM;
        u.pm = fm + ((wgid % nig) % gsz); u.pn = (wgid % nig) / gsz; return true;
    }
    __device__ __forceinline__ void a_ready(const Unit&) const {}
    __device__ __forceinline__ void done(const Unit&) const {}
};

__device__ __forceinline__ unsigned cvt_pk_bf16(float lo, float hi) { unsigned r; asm volatile("v_cvt_pk_bf16_f32 %0, %1, %2" : "=v"(r) : "v"(lo), "v"(hi)); return r; }

template <int ACT> struct EpiBf16 {
    static constexpr bool PERM = true, AFTER_DRAIN = false;
    bf16_t* O; int ldc;
    __device__ __forceinline__ void operator()(const f32x4 (&acc)[2][2][4][2], const Unit& u, int wr, int wc, int fr, int fq) const {
        const int row0 = u.pm * BM + wr * 64 + fr; const int col0 = u.pn * BM + wc * 32 + 8 * fq;
#pragma unroll
        for (int ai = 0; ai < 2; ++ai)
#pragma unroll
            for (int m = 0; m < 4; ++m) { bf16_t* rowp = O + (size_t)(row0 + ai * HALF + m * 16) * ldc + col0;
#pragma unroll
                for (int bj = 0; bj < 2; ++bj) { f32x4 v0 = acc[ai][bj][m][0], v1 = acc[ai][bj][m][1];
                    if (ACT == 2) {
#pragma unroll
                        for (int j = 0; j < 4; ++j) { const float a = fmaxf(v0[j], 0.f), b = fmaxf(v1[j], 0.f); v0[j] = a * a; v1[j] = b * b; } }
                    u32x4 w; w.x = cvt_pk_bf16(v0[0], v0[1]); w.y = cvt_pk_bf16(v0[2], v0[3]); w.z = cvt_pk_bf16(v1[0], v1[1]); w.w = cvt_pk_bf16(v1[2], v1[3]);
                    *(u32x4*)(rowp + bj * HALF) = w; } }
    }
};
struct EpiNull {
    static constexpr bool PERM = true, AFTER_DRAIN = false;
    float* sink;
    __device__ __forceinline__ void operator()(const f32x4 (&acc)[2][2][4][2], const Unit& u, int wr, int wc, int fr, int fq) const {
        f32x4 s = (f32x4){0.f, 0.f, 0.f, 0.f};
#pragma unroll
        for (int ai = 0; ai < 2; ++ai)
#pragma unroll
            for (int bj = 0; bj < 2; ++bj)
#pragma unroll
                for (int m = 0; m < 4; ++m)
#pragma unroll
                    for (int n = 0; n < 2; ++n) s += acc[ai][bj][m][n];
        if (s[0] + s[1] + s[2] + s[3] == 1.2345678e33f) sink[u.pm] = s[0];
    }
};
struct EpiResid {
    static constexpr bool PERM = false, AFTER_DRAIN = false;
    const float* xin; float* xout; const float* gate; int gstride;
    __device__ __forceinline__ void operator()(const f32x4 (&acc)[2][2][4][2], const Unit& u, int wr, int wc, int fr, int fq) const {
        const int b = u.pm >> 3; const int col0 = u.pn * BM + wc * 32 + 4 * fq;
        f32x4 gv[2][2];
#pragma unroll
        for (int bj = 0; bj < 2; ++bj)
#pragma unroll
            for (int n = 0; n < 2; ++n) gv[bj][n] = *(const f32x4*)(gate + (size_t)b * gstride + col0 + bj * HALF + n * 16);
#pragma unroll
        for (int ai = 0; ai < 2; ++ai)
#pragma unroll
            for (int m = 0; m < 4; ++m) { const size_t off = (size_t)(u.pm * BM + ai * HALF + wr * 64 + m * 16 + fr) * 2048 + col0;
#pragma unroll
                for (int bj = 0; bj < 2; ++bj)
#pragma unroll
                    for (int n = 0; n < 2; ++n) { const f32x4 x = *(const f32x4*)(xin + off + bj * HALF + n * 16);
                        *(f32x4*)(xout + off + bj * HALF + n * 16) = x + gv[bj][n] * acc[ai][bj][m][n]; }
                if (m & 1) asm volatile("" ::: "memory"); }
    }
};
struct EpiGate {
    static constexpr bool PERM = false, AFTER_DRAIN = false;
    const bf16_t* P; const float* bgate; bf16_t* O;
    __device__ __forceinline__ void operator()(const f32x4 (&acc)[2][2][4][2], const Unit& u, int wr, int wc, int fr, int fq) const {
        const int d0 = u.pn * 64 + wc * 16 + 4 * fq;
        f32x4 bv[2][2];
#pragma unroll
        for (int bj = 0; bj < 2; ++bj)
#pragma unroll
            for (int n = 0; n < 2; ++n) bv[bj][n] = *(const f32x4*)(bgate + (2 * bj + n) * 2048 + d0);
#pragma unroll
        for (int ai = 0; ai < 2; ++ai)
#pragma unroll
            for (int m = 0; m < 4; ++m) { const size_t row = (size_t)(u.pm * BM + ai * HALF + wr * 64 + m * 16 + fr);
                f32x4 s = (f32x4){0.f, 0.f, 0.f, 0.f};
#pragma unroll
                for (int bj = 0; bj < 2; ++bj)
#pragma unroll
                    for (int n = 0; n < 2; ++n) { const u32x2 pw = *(const u32x2*)(P + row * 8192 + (2 * bj + n) * 2048 + d0);
                        const f32x4 pv = (f32x4){__uint_as_float(pw.x << 16), __uint_as_float(pw.x & 0xffff0000u), __uint_as_float(pw.y << 16), __uint_as_float(pw.y & 0xffff0000u)};
                        const f32x4 x = acc[ai][bj][m][n] + bv[bj][n];
#pragma unroll
                        for (int j = 0; j < 4; ++j) { const float sg = __builtin_amdgcn_rcpf(1.f + __builtin_amdgcn_exp2f(-1.4426950408889634f * x[j])); s[j] += sg * pv[j]; } }
                u32x2 w; w.x = cvt_pk_bf16(s[0], s[1]); w.y = cvt_pk_bf16(s[2], s[3]);
                *(u32x2*)(O + row * 2048 + d0) = w;
                if (m & 1) asm volatile("" ::: "memory"); }
    }
};

template <class Epi, class Sched, bool ALIGN_EPI = false, bool SP2 = false>
__device__ __forceinline__ void gemm_phase(PG8_LAS unsigned char* lds, const Gemm g, const Sched& S, const Epi& E) {
    int tid_l = threadIdx.x; asm volatile("" : "+v"(tid_l));
    const int tid = tid_l, wid = __builtin_amdgcn_readfirstlane(tid >> 6), lane = tid & 63, wr = wid >> 2, wc = wid & 3, fr = lane & 15, fq = lane >> 4;
    const int K = g.K, nt = K / BK;
    unsigned voffA[2], voffB[2];
#pragma unroll
    for (int i = 0; i < 2; ++i) { int R, C; stage_rc(tid * 16 + i * 8192, R, C); const int Rb = Epi::PERM ? ((R & ~31) + perm32(R & 31)) : R;
        voffA[i] = (unsigned)(R * g.lda + C) * 2u; voffB[i] = (unsigned)(Rb * g.ldb + C) * 2u; }
    const size_t kstep = (size_t)(BK * 2);
    const size_t hstepA = (size_t)HALF * g.lda * 2, hstepB = (size_t)HALF * g.ldb * 2;
    const size_t tstepA = 2 * hstepA, tstepB = 2 * hstepB;
    const unsigned ldsw = (unsigned)wid * 1024u;
    const int aoff = lds_byte(wr * 64 + fr, fq * 8), boff = lds_byte(wc * 32 + fr, fq * 8);
#define PG8_SA(b, h) (((b) * 2 + (h)) * HTB)
#define PG8_SB(b, h) ((4 + (b) * 2 + (h)) * HTB)
#define PG8_STAGE(bufoff, gbase, voff) do { _Pragma("unroll") for (int _i = 0; _i < 2; ++_i) \
        __builtin_amdgcn_global_load_lds((const unsigned*)((const char*)(gbase) + (voff)[_i]), (PG8_LAS unsigned*)(lds + (bufoff) + ldsw + _i * 8192), 16, 0, 0); } while (0)
#define PG8_LDA(dst, b, h) do { _Pragma("unroll") for (int m = 0; m < 4; ++m) _Pragma("unroll") for (int k = 0; k < 2; ++k) dst[m][k] = *(const PG8_LAS bf16x8*)(lds + PG8_SA(b, h) + aoff + m * 2048 + k * 1024); } while (0)
#define PG8_LDB(dst, b, h) do { _Pragma("unroll") for (int n = 0; n < 2; ++n) _Pragma("unroll") for (int k = 0; k < 2; ++k) dst[n][k] = *(const PG8_LAS bf16x8*)(lds + PG8_SB(b, h) + boff + n * 2048 + k * 1024); } while (0)
#define PG8_MMA(ai, bj, At, Bt) do { __builtin_amdgcn_s_setprio(1); _Pragma("unroll") for (int m = 0; m < 4; ++m) _Pragma("unroll") for (int n = 0; n < 2; ++n) _Pragma("unroll") for (int k = 0; k < 2; ++k) \
        acc[ai][bj][m][n] = __builtin_amdgcn_mfma_f32_16x16x32_bf16(Bt[n][k], At[m][k], acc[ai][bj][m][n], 0, 0, 0); __builtin_amdgcn_s_setprio(0); } while (0)
#define PG8_WAIT_V(n) asm volatile("s_waitcnt vmcnt(" #n ")" ::: "memory")
#define PG8_WAIT_L(n) asm volatile("s_waitcnt lgkmcnt(" #n ")" ::: "memory")
#define PG8_BAR __builtin_amdgcn_s_barrier()
#define PG8_SCHED __builtin_amdgcn_sched_barrier(0)
    Unit cur, nxt; int ui = 0;
    if (!S.next(0, cur)) return;
    f32x4 acc[2][2][4][2];
#pragma unroll
    for (int a = 0; a < 2; ++a)
#pragma unroll
        for (int b = 0; b < 2; ++b)
#pragma unroll
            for (int m = 0; m < 4; ++m)
#pragma unroll
                for (int n = 0; n < 2; ++n) acc[a][b][m][n] = (f32x4){0.f, 0.f, 0.f, 0.f};
    bf16x8 At[4][2], B0[2][2], B1[2][2];
    const char* cA = (const char*)g.A + (size_t)cur.pm * tstepA + (size_t)(cur.pn / g.agdiv) * (size_t)g.agoff * 2; const char* cB = (const char*)g.Bt + (size_t)cur.pn * tstepB;
    S.a_ready(cur);
    if constexpr (SP2) {
        PG8_STAGE(PG8_SB(0, 0), cB, voffB); PG8_STAGE(PG8_SB(0, 1), cB + hstepB, voffB); PG8_STAGE(PG8_SA(0, 0), cA, voffA); PG8_STAGE(PG8_SA(0, 1), cA + hstepA, voffA);
        if (wr == 1) PG8_BAR;
        PG8_WAIT_V(2); PG8_BAR;
        PG8_STAGE(PG8_SB(1, 0), cB + kstep, voffB); PG8_STAGE(PG8_SA(1, 0), cA + kstep, voffA); PG8_STAGE(PG8_SB(1, 1), cB + hstepB + kstep, voffB);
        PG8_WAIT_V(6); PG8_BAR;
    } else {
        PG8_STAGE(PG8_SB(0, 0), cB, voffB); PG8_STAGE(PG8_SA(0, 0), cA, voffA); PG8_STAGE(PG8_SB(0, 1), cB + hstepB, voffB); PG8_STAGE(PG8_SA(0, 1), cA + hstepA, voffA);
        if (wr == 1) PG8_BAR;
        PG8_WAIT_V(4); PG8_BAR;
        PG8_STAGE(PG8_SB(1, 0), cB + kstep, voffB); PG8_STAGE(PG8_SA(1, 0), cA + kstep, voffA); PG8_STAGE(PG8_SB(1, 1), cB + hstepB + kstep, voffB);
        PG8_WAIT_V(6); PG8_BAR;
    }
    for (;;) {
        const bool has_next = S.next(ui + 1, nxt);
        const char* nA = has_next ? (const char*)g.A + (size_t)nxt.pm * tstepA + (size_t)(nxt.pn / g.agdiv) * (size_t)g.agoff * 2 : cA; const char* nB = has_next ? (const char*)g.Bt + (size_t)nxt.pn * tstepB : cB;
        for (int t = 0; t < nt; t += 2) {
            const bool last = (t == nt - 2);
            const char* a1 = cA + (size_t)(t + 1) * kstep;
            const char* a2 = last ? nA : cA + (size_t)(t + 2) * kstep; const char* b2 = last ? nB : cB + (size_t)(t + 2) * kstep;
            const char* a3 = a2 + kstep; const char* b3 = b2 + kstep;
            if (last && has_next) S.a_ready(nxt);
            if constexpr (SP2) {
            PG8_LDB(B0, 0, 0); PG8_LDB(B1, 0, 1); PG8_SCHED; PG8_LDA(At, 0, 0); PG8_STAGE(PG8_SA(1, 1), a1 + hstepA, voffA);
            PG8_WAIT_V(8); PG8_WAIT_L(0); PG8_BAR; PG8_MMA(0, 0, At, B0); PG8_MMA(0, 1, At, B1); PG8_BAR; PG8_SCHED;
            PG8_LDA(At, 0, 1); PG8_STAGE(PG8_SB(0, 0), b2, voffB); PG8_STAGE(PG8_SB(0, 1), b2 + hstepB, voffB); PG8_STAGE(PG8_SA(0, 0), a2, voffA);
            PG8_WAIT_V(8); PG8_WAIT_L(0); PG8_BAR; PG8_MMA(1, 0, At, B0); PG8_MMA(1, 1, At, B1); PG8_BAR; PG8_SCHED;
            PG8_LDB(B0, 1, 0); PG8_LDB(B1, 1, 1); PG8_SCHED; PG8_LDA(At, 1, 0); PG8_STAGE(PG8_SA(0, 1), a2 + hstepA, voffA);
            PG8_WAIT_V(8); PG8_WAIT_L(0); PG8_BAR; PG8_MMA(0, 0, At, B0); PG8_MMA(0, 1, At, B1); PG8_BAR; PG8_SCHED;
            PG8_LDA(At, 1, 1); PG8_STAGE(PG8_SB(1, 0), b3, voffB); PG8_STAGE(PG8_SB(1, 1), b3 + hstepB, voffB); PG8_STAGE(PG8_SA(1, 0), a3, voffA);
            PG8_WAIT_V(8); PG8_WAIT_L(0); PG8_BAR; PG8_MMA(1, 0, At, B0); PG8_MMA(1, 1, At, B1); PG8_BAR; PG8_SCHED;
            } else {
            PG8_LDB(B0, 0, 0); PG8_SCHED; PG8_LDA(At, 0, 0); PG8_STAGE(PG8_SA(1, 1), a1 + hstepA, voffA);
            PG8_WAIT_L(8); PG8_BAR; PG8_WAIT_L(0); PG8_MMA(0, 0, At, B0); PG8_BAR; PG8_SCHED;
            PG8_LDB(B1, 0, 1); PG8_STAGE(PG8_SB(0, 0), b2, voffB);
            PG8_BAR; PG8_WAIT_L(0); PG8_MMA(0, 1, At, B1); PG8_BAR;
            PG8_LDA(At, 0, 1); PG8_STAGE(PG8_SA(0, 0), a2, voffA);
            PG8_BAR; PG8_WAIT_L(0); PG8_MMA(1, 0, At, B0); PG8_BAR; PG8_SCHED;
            PG8_STAGE(PG8_SB(0, 1), b2 + hstepB, voffB);
            PG8_WAIT_V(6); PG8_BAR; PG8_MMA(1, 1, At, B1); PG8_BAR;
            PG8_LDB(B0, 1, 0); PG8_SCHED; PG8_LDA(At, 1, 0); PG8_STAGE(PG8_SA(0, 1), a2 + hstepA, voffA);
            PG8_WAIT_L(8); PG8_BAR; PG8_WAIT_L(0); PG8_MMA(0, 0, At, B0); PG8_BAR; PG8_SCHED;
            PG8_LDB(B1, 1, 1); PG8_STAGE(PG8_SB(1, 0), b3, voffB);
            PG8_BAR; PG8_WAIT_L(0); PG8_MMA(0, 1, At, B1); PG8_BAR;
            PG8_LDA(At, 1, 1); PG8_STAGE(PG8_SA(1, 0), a3, voffA);
            PG8_BAR; PG8_WAIT_L(0); PG8_MMA(1, 0, At, B0); PG8_BAR; PG8_SCHED;
            PG8_STAGE(PG8_SB(1, 1), b3 + hstepB, voffB);
            PG8_WAIT_V(6); PG8_BAR; PG8_MMA(1, 1, At, B1); PG8_BAR;
            }
        }
        if constexpr (ALIGN_EPI) { if (wr == 0) PG8_BAR; }
        if constexpr (!Epi::AFTER_DRAIN) { E(acc, cur, wr, wc, fr, fq); S.done(cur); }
        if (!has_next) break;
#pragma unroll
        for (int a = 0; a < 2; ++a)
#pragma unroll
            for (int b = 0; b < 2; ++b)
#pragma unroll
                for (int m = 0; m < 4; ++m)
#pragma unroll
                    for (int n = 0; n < 2; ++n) acc[a][b][m][n] = (f32x4){0.f, 0.f, 0.f, 0.f};
        cur = nxt; cA = nA; cB = nB; ++ui;
        if constexpr (ALIGN_EPI) { if (wr == 1) PG8_BAR; }
    }
    PG8_WAIT_V(0);
    if constexpr (!ALIGN_EPI) { if (wr == 0) PG8_BAR; }
    PG8_BAR;
    if constexpr (Epi::AFTER_DRAIN) { E.fused(acc, cur, wr, wc, fr, fq, lds, wid, lane); S.done(cur); }
#undef PG8_SA
#undef PG8_SB
#undef PG8_STAGE
#undef PG8_LDA
#undef PG8_LDB
#undef PG8_MMA
#undef PG8_WAIT_V
#undef PG8_WAIT_L
#undef PG8_BAR
#undef PG8_SCHED
}
}

constexpr int NB = 8, SEQ = 2048, DM = 2048, M_TOK = NB * SEQ, DFF = 8192, NLAYER = 2;
constexpr int LDQ = 6656;
constexpr int C_QA = 0, C_KA = 512, C_VA = 1024, C_QB = 1536, C_KB = 2048, C_VB = 2560, C_QD = 3072, C_KD = 3584, C_VD = 4096,
              C_BG = 4608, C_CG = 5120, C_XIN = 5632, C_IQ = 6144, C_IK = 6400, C_IW = 6464, C_FD = 6468, C_END = 6472;
constexpr float LOG2E = 1.4426950408889634f;
constexpr float IDX_SCALE = 0.0625f;
constexpr float RMS_EPS = 1e-6f;

typedef unsigned short bf16_t;
typedef short bf16x8 __attribute__((ext_vector_type(8)));
typedef short s16x4 __attribute__((ext_vector_type(4)));
typedef float f32x16 __attribute__((ext_vector_type(16)));
typedef float f32x4 __attribute__((ext_vector_type(4)));
typedef float f32x2 __attribute__((ext_vector_type(2)));
typedef unsigned u32x4 __attribute__((ext_vector_type(4)));
typedef unsigned u32x2 __attribute__((ext_vector_type(2)));

DI float bf2f(bf16_t v) { return __uint_as_float((unsigned)v << 16); }
DI unsigned cvtpk(float lo, float hi) { unsigned r; asm volatile("v_cvt_pk_bf16_f32 %0, %1, %2" : "=v"(r) : "v"(lo), "v"(hi)); return r; }
DI float wave_sum(float v) {
#pragma unroll
    for (int o = 1; o < 64; o <<= 1) v += __shfl_xor(v, o);
    return v;
}

namespace att {
constexpr int SHM_V = 16384, SHM_K = 16384;
constexpr int OFF_V = 0, OFF_K = 2 * SHM_V, OFF_WS = OFF_K + 2 * SHM_K, OFF_TAB = OFF_WS + 8 * 64 * 4, OFF_FK = OFF_TAB + 512, LDS_END = OFF_FK + 8192;
#define KSWZ(row, colB) ((row) * 256 + ((colB) ^ (((row) & 7) << 4)))
#define SBAR() __builtin_amdgcn_sched_barrier(0)
DI int v_st(int k, int c) { const int kk = (k & ~0xC) | ((k & 4) << 1) | ((k & 8) >> 1); return ((kk >> 3) * 4 + (c >> 5)) * 512 + ((kk & 7) * 32 + (c & 31)) * 2; }
DI int v_rd_base(int lane) { return ((lane & 3) << 3) | (((lane >> 2) & 3) << 6) | (((lane >> 4) & 1) << 5) | (((lane >> 5) & 1) << 8); }
constexpr int v_rd_off(int d0, int ks, int half) { return d0 * 512 + ks * 4096 + half * 2048; }
DI int crow(int r, int hi) { return (r & 3) + 8 * (r >> 2) + 4 * hi; }

template <int KB, int D0LO, int D0HI>
DI void qkt(f32x16& p0, f32x16& p1, LAS const char* K_lds, int r32, int hi, const bf16x8* qr) {
#pragma unroll
    for (int r = 0; r < 16; ++r) { p0[r] = 0.f; p1[r] = 0.f; }
    LAS const char* kb[4];
#pragma unroll
    for (int dd = 0; dd < 4; ++dd) kb[dd] = K_lds + KB * SHM_K + KSWZ(r32, (dd * 16 + hi * 8) * 2);
#pragma unroll
    for (int d0 = D0LO; d0 < D0HI; ++d0) { LAS const char* a = kb[d0 & 3] + (d0 >> 2) * 128;
        const bf16x8 b0 = *(LAS const bf16x8*)a;
        const bf16x8 b1 = *(LAS const bf16x8*)(a + 32 * 256);
        p0 = __builtin_amdgcn_mfma_f32_32x32x16_bf16(b0, qr[d0 - D0LO], p0, 0, 0, 0);
        p1 = __builtin_amdgcn_mfma_f32_32x32x16_bf16(b1, qr[d0 - D0LO], p1, 0, 0, 0); }
}
template <int VB>
DI void pv_tile(f32x16* o, int vb0, bf16x8 pa0, bf16x8 pa1, bf16x8 pa2, bf16x8 pa3) {
#define TRRD(dst, off) asm volatile("ds_read_b64_tr_b16 %0, %1 offset:%2" : "=&v"(dst) : "v"(vb0), "i"(off) : "memory")
#define PV_D0(d0) do { s16x4 l0, l1, l2, l3, h0, h1, h2, h3; constexpr int b_ = VB * SHM_V + v_rd_off(d0, 0, 0);     \
        TRRD(l0, b_); TRRD(h0, b_ + 2048); TRRD(l1, b_ + 4096); TRRD(h1, b_ + 6144); TRRD(l2, b_ + 8192); TRRD(h2, b_ + 10240); TRRD(l3, b_ + 12288); TRRD(h3, b_ + 14336); \
        asm volatile("s_waitcnt lgkmcnt(0)" ::: "memory"); SBAR();   \
        o[d0] = __builtin_amdgcn_mfma_f32_32x32x16_bf16(pa0, (bf16x8){l0[0], l0[1], l0[2], l0[3], h0[0], h0[1], h0[2], h0[3]}, o[d0], 0, 0, 0);   \
        o[d0] = __builtin_amdgcn_mfma_f32_32x32x16_bf16(pa1, (bf16x8){l1[0], l1[1], l1[2], l1[3], h1[0], h1[1], h1[2], h1[3]}, o[d0], 0, 0, 0);   \
        o[d0] = __builtin_amdgcn_mfma_f32_32x32x16_bf16(pa2, (bf16x8){l2[0], l2[1], l2[2], l2[3], h2[0], h2[1], h2[2], h2[3]}, o[d0], 0, 0, 0);   \
        o[d0] = __builtin_amdgcn_mfma_f32_32x32x16_bf16(pa3, (bf16x8){l3[0], l3[1], l3[2], l3[3], h3[0], h3[1], h3[2], h3[3]}, o[d0], 0, 0, 0); } while (0)
    PV_D0(0); PV_D0(1); PV_D0(2); PV_D0(3);
#undef PV_D0
#undef TRRD
}
DI int t5_bucket(int n) {
    if (n < 16) return n;
    int b = 16;
    b += (n >= 19); b += (n >= 21); b += (n >= 24); b += (n >= 27); b += (n >= 31); b += (n >= 35); b += (n >= 40); b += (n >= 46);
    b += (n >= 52); b += (n >= 59); b += (n >= 67); b += (n >= 77); b += (n >= 87); b += (n >= 99); b += (n >= 113);
    return b;
}

struct UnitArgs {
    const bf16_t* Qp; const bf16_t* Kp; const bf16_t* Vp; bf16_t* Op; int q0;
    const unsigned long long* maskp;
    const float* fcum;
    const float* relb; int relcol;
    float lam, post;
    const float* gsub;
    float* stash;
};

template <int MODE>
DI void attn_unit(LAS char* lds, const UnitArgs& A) {
    int tid_l = threadIdx.x; asm volatile("" : "+v"(tid_l));
    const int tid = tid_l, wid = __builtin_amdgcn_readfirstlane(tid >> 6), lane = tid & 63, r32 = lane & 31, hi = lane >> 5;
    const int q0 = A.q0, NT = (q0 + 256) / 64;
    LAS char* V_lds = lds + OFF_V; LAS char* K_lds = lds + OFF_K;
    LAS float* wsf = (LAS float*)(lds + OFF_WS) + wid * 64; LAS float* li_l = wsf; LAS float* al_l = wsf + 32;
    LAS float* tab = (LAS float*)(lds + OFF_TAB); LAS float* fk = (LAS float*)(lds + OFF_FK);
    const int qlo = q0 + wid * 32, qpos = qlo + r32;
    const int sr = tid >> 4, sc = (tid & 15) * 8;
    const int vst0 = v_st(sr, sc), vst1 = v_st(32 + sr, sc), kws = KSWZ(sr, sc * 2);
    const int vb0 = (int)(unsigned)(uintptr_t)V_lds + v_rd_base(lane);
    if (MODE == 0 || MODE == 1) { if (tid < 128) { const int bk = t5_bucket(tid); tab[tid] = (A.relb[bk * 8 + A.relcol] - A.relb[31 * 8 + A.relcol]) * LOG2E; } }
    float fqv = 0.f;
    if (MODE == 2) { for (int i = tid; i < q0 + 256; i += 512) fk[i] = A.fcum[i]; fqv = A.fcum[qpos]; }
    constexpr int NPASS = (MODE == 1) ? 2 : 1, NQ = (MODE == 1) ? 4 : 8;
#pragma unroll 1
    for (int pass = 0; pass < NPASS; ++pass) {
        bf16x8 qr[NQ];
#pragma unroll
        for (int d = 0; d < NQ; ++d) qr[d] = *(const bf16x8*)(A.Qp + (size_t)(qpos) * LDQ + (MODE == 1 ? pass * 64 : 0) + d * 16 + hi * 8);
        bf16x8 st_k0, st_k1, st_v0, st_v1;
#define SLOAD(k0) do { st_v0 = *(const bf16x8*)(A.Vp + (size_t)((k0) + sr) * LDQ + sc); st_v1 = *(const bf16x8*)(A.Vp + (size_t)((k0) + 32 + sr) * LDQ + sc); \
                       st_k0 = *(const bf16x8*)(A.Kp + (size_t)((k0) + sr) * LDQ + sc); st_k1 = *(const bf16x8*)(A.Kp + (size_t)((k0) + 32 + sr) * LDQ + sc); } while (0)
#define SWRITE(bf) do { *(LAS bf16x8*)(V_lds + (bf) * SHM_V + vst0) = st_v0; *(LAS bf16x8*)(V_lds + (bf) * SHM_V + vst1) = st_v1; \
                        *(LAS bf16x8*)(K_lds + (bf) * SHM_K + kws) = st_k0; *(LAS bf16x8*)(K_lds + (bf) * SHM_K + kws + 32 * 256) = st_k1; } while (0)
        SLOAD(0); SWRITE(0);
        __syncthreads();
        float m_reg = -1e30f, l_reg = 0.f; f32x16 o[4];
#pragma unroll
        for (int d = 0; d < 4; ++d)
#pragma unroll
            for (int r = 0; r < 16; ++r) o[d][r] = 0.f;
        f32x16 p0, p1; bf16x8 pa0, pa1, pa2, pa3;
        unsigned long long mw_next = 0ull; if (MODE == 0) mw_next = A.maskp[(size_t)qpos * 32];
#define STEP(t, KB) do { const int t_ = (t); const bool more_ = (t_ + 1 < NT); const int kbase = t_ * 64; \
        const unsigned long long mw_ = mw_next; if (MODE == 0) { if (more_) mw_next = A.maskp[(size_t)qpos * 32 + t_ + 1]; } \
        if (more_) SLOAD(kbase + 64); \
        if (MODE == 1) { if (pass == 0) qkt<KB, 0, 4>(p0, p1, K_lds, r32, hi, qr); else qkt<KB, 4, 8>(p0, p1, K_lds, r32, hi, qr); } \
        else qkt<KB, 0, 8>(p0, p1, K_lds, r32, hi, qr); \
        if (MODE == 0 || MODE == 1) { if (kbase + 63 + 113 > qlo) { const int dq_ = qpos - kbase - 4 * hi; \
            _Pragma("unroll") for (int r = 0; r < 16; ++r) { const int c_ = (r & 3) + 8 * (r >> 2); int i0 = dq_ - c_, i1 = dq_ - c_ - 32; \
                i0 = i0 < 0 ? 0 : (i0 > 127 ? 127 : i0); i1 = i1 < 0 ? 0 : (i1 > 127 ? 127 : i1); p0[r] += tab[i0]; p1[r] += tab[i1]; } } } \
        if (MODE == 2) { _Pragma("unroll") for (int g = 0; g < 4; ++g) { const f32x4 f0 = *(LAS const f32x4*)(fk + kbase + 8 * g + 4 * hi), f1 = *(LAS const f32x4*)(fk + kbase + 32 + 8 * g + 4 * hi); \
                _Pragma("unroll") for (int j = 0; j < 4; ++j) { p0[4 * g + j] += fqv - f0[j]; p1[4 * g + j] += fqv - f1[j]; } } } \
        if (kbase + 63 > qlo) { const int dq_ = qpos - kbase - 4 * hi; const float NEG_ = -__builtin_inff(); \
            _Pragma("unroll") for (int r = 0; r < 16; ++r) { const int c_ = (r & 3) + 8 * (r >> 2); if (dq_ - c_ < 0) p0[r] = NEG_; if (dq_ - c_ - 32 < 0) p1[r] = NEG_; } } \
        if (MODE == 0) { const unsigned wl_ = (unsigned)mw_ >> (4 * hi), wh_ = (unsigned)(mw_ >> 32) >> (4 * hi); const float NEG_ = -__builtin_inff(); \
            _Pragma("unroll") for (int r = 0; r < 16; ++r) { const int c_ = (r & 3) + 8 * (r >> 2); if (!((wl_ >> c_) & 1u)) p0[r] = NEG_; if (!((wh_ >> c_) & 1u)) p1[r] = NEG_; } } \
        float pmax_ = p0[0]; _Pragma("unroll") for (int r = 1; r < 16; ++r) pmax_ = fmaxf(pmax_, p0[r]); _Pragma("unroll") for (int r = 0; r < 16; ++r) pmax_ = fmaxf(pmax_, p1[r]); \
        { auto rr = __builtin_amdgcn_permlane32_swap(__float_as_uint(pmax_), __float_as_uint(pmax_), false, false); pmax_ = fmaxf(__uint_as_float(rr[0]), __uint_as_float(rr[1])); } \
        float mn_ = m_reg, alpha_ = 1.f; \
        if (!__all(pmax_ - m_reg <= 8.f)) { mn_ = fmaxf(m_reg, pmax_); alpha_ = __builtin_amdgcn_exp2f(m_reg - mn_); m_reg = mn_; } \
        float ps_ = 0.f; \
        _Pragma("unroll") for (int r = 0; r < 16; ++r) { p0[r] = __builtin_amdgcn_exp2f(p0[r] - mn_); ps_ += p0[r]; } \
        _Pragma("unroll") for (int r = 0; r < 16; ++r) { p1[r] = __builtin_amdgcn_exp2f(p1[r] - mn_); ps_ += p1[r]; } \
        { auto rr = __builtin_amdgcn_permlane32_swap(__float_as_uint(ps_), __float_as_uint(ps_), false, false); ps_ = __uint_as_float(rr[0]) + __uint_as_float(rr[1]); } \
        l_reg = l_reg * alpha_ + ps_; \
        PK4(p0, 0, pa0); PK4(p0, 8, pa1); PK4(p1, 0, pa2); PK4(p1, 8, pa3); \
        if (__any(alpha_ < 1.f)) { if (hi == 0) al_l[r32] = alpha_; asm volatile("s_waitcnt lgkmcnt(0)" ::: "memory"); \
            _Pragma("unroll") for (int d_ = 0; d_ < 4; ++d_) _Pragma("unroll") for (int r = 0; r < 16; ++r) o[d_][r] *= al_l[crow(r, hi)]; } \
        SBAR(); pv_tile<KB>(o, vb0, pa0, pa1, pa2, pa3); \
        if (more_) { asm volatile("s_waitcnt vmcnt(0)" ::: "memory"); SWRITE((KB) ^ 1); } \
        __syncthreads(); } while (0)
#define PK4(P, B_, OUT) do { unsigned a0 = cvtpk(P[B_+0], P[B_+1]), a1 = cvtpk(P[B_+2], P[B_+3]);                          \
        unsigned b0 = cvtpk(P[B_+4], P[B_+5]), b1 = cvtpk(P[B_+6], P[B_+7]);                                             \
        auto r0 = __builtin_amdgcn_permlane32_swap(a0, b0, false, false); auto r1 = __builtin_amdgcn_permlane32_swap(a1, b1, false, false); \
        u32x4 w = {r0[0], r1[0], r0[1], r1[1]}; OUT = __builtin_bit_cast(bf16x8, w); } while (0)
#pragma unroll 1
        for (int t = 0; t < NT; t += 2) { STEP(t, 0); STEP(t + 1, 1); }
#undef STEP
#undef PK4
#undef SLOAD
#undef SWRITE
        if (hi == 0) li_l[r32] = l_reg; asm volatile("s_waitcnt lgkmcnt(0)" ::: "memory");
        float rli[16];
#pragma unroll
        for (int r = 0; r < 16; ++r) rli[r] = __builtin_amdgcn_rcpf(li_l[crow(r, hi)]);
        bf16_t* Ow = A.Op + (size_t)(qlo) * 2048; asm volatile("" : "+v"(Ow));
        if (MODE != 1) {
#pragma unroll
            for (int r = 0; r < 16; ++r) { const int orow = crow(r, hi);
#pragma unroll
                for (int d0 = 0; d0 < 4; ++d0) { const float v = o[d0][r] * rli[r]; const float vn = __shfl_xor(v, 1);
                    if ((r32 & 1) == 0) *(unsigned*)(Ow + (size_t)orow * 2048 + d0 * 32 + r32) = cvtpk(v, vn); } }
        } else if (pass == 0) {
#pragma unroll
            for (int d0 = 0; d0 < 4; ++d0)
#pragma unroll
                for (int r = 0; r < 16; r += 4) *(f32x4*)(A.stash + tid * 64 + d0 * 16 + r) = (f32x4){o[d0][r] * rli[r], o[d0][r + 1] * rli[r + 1], o[d0][r + 2] * rli[r + 2], o[d0][r + 3] * rli[r + 3]};
        } else {
            float ss[16];
#pragma unroll
            for (int d0 = 0; d0 < 4; ++d0)
#pragma unroll
                for (int r = 0; r < 16; r += 4) { const f32x4 sv = *(const f32x4*)(A.stash + tid * 64 + d0 * 16 + r);
#pragma unroll
                    for (int j = 0; j < 4; ++j) o[d0][r + j] = sv[j] - A.lam * (o[d0][r + j] * rli[r + j]); }
#pragma unroll
            for (int r = 0; r < 16; ++r) { float s = 0.f;
#pragma unroll
                for (int d0 = 0; d0 < 4; ++d0) { const float v = o[d0][r]; s += v * v; }
                s += __shfl_xor(s, 1); s += __shfl_xor(s, 2); s += __shfl_xor(s, 4); s += __shfl_xor(s, 8); s += __shfl_xor(s, 16);
                ss[r] = __builtin_amdgcn_rsqf(s * (1.f / 128.f) + RMS_EPS) * A.post;
                if ((r & 3) == 3) asm volatile("" ::: "memory"); }
#pragma unroll
            for (int d0 = 0; d0 < 4; ++d0) { const float gs = A.gsub[d0 * 32 + r32];
#pragma unroll
                for (int r = 0; r < 16; ++r) { const int orow = crow(r, hi); const float v = o[d0][r] * ss[r] * gs; const float vn = __shfl_xor(v, 1);
                    if ((r32 & 1) == 0) *(unsigned*)(Ow + (size_t)orow * 2048 + d0 * 32 + r32) = cvtpk(v, vn); } }
        }
        __syncthreads();
    }
}
#undef SBAR
}

#define XB_TMO      128
#define XB_XCNT(j)  (256  + 64 * (j))
#define XB_XSUB(j)  (1280 + 64 * (j))
#define XB_XGEN(j)  (2304 + 64 * (j))
#define XB_TOP      3328
#define XB_TOPGEN   3392
#define XCD_BAR_WORDS 3456
#define XB_SPIN_CAP (1u << 20)

__device__ __forceinline__ unsigned xb_ld(unsigned* p)              { return __hip_atomic_load(p, __ATOMIC_RELAXED, __HIP_MEMORY_SCOPE_AGENT); }
__device__ __forceinline__ unsigned xb_add(unsigned* p, unsigned v) { return __hip_atomic_fetch_add(p, v, __ATOMIC_RELAXED, __HIP_MEMORY_SCOPE_AGENT); }
__device__ __forceinline__ unsigned xb_xcc_id() { return (unsigned)__builtin_amdgcn_s_getreg((3 << 11) | 20) & 0xFu; }
#define XB_SPIN(cond, bar) do { unsigned _sp = 0; while (cond) { __builtin_amdgcn_s_sleep(1); \
    if ((++_sp & 255u) == 0u) { if (xb_ld(&(bar)[XB_TMO])) break; if (_sp > XB_SPIN_CAP) { atomicAdd(&(bar)[XB_TMO], 1u); break; } } } } while (0)

struct XcdBarrier {
    unsigned* bar; unsigned x;
    volatile LAS unsigned* st;
};

__device__ __forceinline__ XcdBarrier xcd_barrier_post(unsigned* bar, volatile LAS unsigned* st) {
    XcdBarrier b; b.bar = bar; b.x = xb_xcc_id(); b.st = st;
    if (threadIdx.x == 0) (void)xb_add(&bar[XB_XCNT(b.x)], 1u);
    return b;
}
__device__ __forceinline__ void xcd_barrier_complete(unsigned* bar, unsigned x, unsigned& nloc, unsigned& nx) {
    const unsigned G = gridDim.x * gridDim.y * gridDim.z;
    unsigned sum, cnt, mine, sp = 0u;
    for (;;) {
        sum = 0u; cnt = 0u; mine = 0u;
#pragma unroll
        for (unsigned j = 0; j < 16; ++j) { const unsigned c = xb_ld(&bar[XB_XCNT(j)]); sum += c; cnt += (c > 0u) ? 1u : 0u; mine = (j == x) ? c : mine; }
        if (sum == G) break;
        __builtin_amdgcn_s_sleep(1);
        if ((++sp & 255u) == 0u) { if (xb_ld(&bar[XB_TMO])) break; if (sp > XB_SPIN_CAP) { atomicAdd(&bar[XB_TMO], 1u); break; } }
    }
    nloc = mine > 0u ? mine : 1u; nx = cnt > 0u ? cnt : 1u;
}

__device__ __forceinline__ void xcd_barrier(const XcdBarrier& b) {
    asm volatile("s_waitcnt vmcnt(0)" ::: "memory");
    __syncthreads();
    if (threadIdx.x == 0) {
        unsigned* bar = b.bar; asm volatile("" : "+s"(bar));
        __builtin_amdgcn_s_waitcnt(0);
        unsigned nloc = b.st[0], nx = b.st[1];
        if (nloc == 0u) { xcd_barrier_complete(bar, b.x, nloc, nx); b.st[0] = nloc; b.st[1] = nx; }
        const unsigned old = xb_add(&bar[XB_XSUB(b.x)], 1u);
        const unsigned gen = old / nloc;
        if (old + 1u == (gen + 1u) * nloc) {
            __builtin_amdgcn_fence(__ATOMIC_RELEASE, "agent");
            asm volatile("s_waitcnt vmcnt(0)" ::: "memory");
            const unsigned og = xb_add(&bar[XB_TOP], 1u);
            const unsigned tg = og / nx;
            if (og + 1u == (tg + 1u) * nx) xb_add(&bar[XB_TOPGEN], 1u);
            else XB_SPIN(xb_ld(&bar[XB_TOPGEN]) == tg, bar);
            __builtin_amdgcn_fence(__ATOMIC_ACQUIRE, "agent");
            xb_add(&bar[XB_XGEN(b.x)], 1u);
            asm volatile("s_waitcnt vmcnt(0)" ::: "memory");
        } else {
            XB_SPIN(xb_ld(&bar[XB_XGEN(b.x)]) == gen, bar);
            __builtin_amdgcn_fence(__ATOMIC_ACQUIRE, "agent");
            asm volatile("s_waitcnt vmcnt(0)" ::: "memory");
        }
    }
    __syncthreads();
}
#define RLX_AGENT __ATOMIC_RELAXED, __HIP_MEMORY_SCOPE_AGENT
#define LDS_WAIT() asm volatile("s_waitcnt lgkmcnt(0)" ::: "memory")
DI unsigned f2bf(float f) { unsigned u = __builtin_bit_cast(unsigned, f); return (u + 0x7fffu + ((u >> 16) & 1u)) >> 16; }
DI unsigned pk2(float lo, float hi) { return f2bf(lo) | (f2bf(hi) << 16); }

struct MapPlain { DI int src(int n) const { return n; } DI float scale(int) const { return 1.f; } };
struct MapWin {
    DI int src(int n) const {
        if (n < 1536) return n;
        if (n < 3072) return 1860 + (n - 1536);
        if (n < 4608) return 4932 + (n - 3072);
        if (n < 6144) return 3396 + (n - 4608);
        if (n < 6400) return 1536 + (n - 6144);
        if (n < 6464) return 1792 + (n - 6400);
        if (n < 6468) return 1856 + (n - 6464);
        if (n < 6472) return 6468 + (n - 6468);
        return -1;
    }
    DI float scale(int n) const {
        if (n < 512) return 0.08838834764831845f * LOG2E;
        if (n >= 1536 && n < 2048) return 0.125f * LOG2E;
        if (n >= 3072 && n < 3584) return 0.08838834764831845f * LOG2E;
        return 1.f;
    }
};
struct MapGate {
    DI int src(int n) const { const int pn = n >> 8, c = n & 255; const int g = 2 * (c >> 7) + ((c >> 4) & 1), dl = 16 * ((c >> 5) & 3) + (c & 15); return g * 2048 + 64 * pn + dl; }
    DI float scale(int) const { return 1.f; }
};
template <class Map>
DI void transpose_item(const float* W, int K, int Nsrc, int nblk  , bf16_t* WT, const Map& map, LAS float* scr, int item, int lane) {
    const int kb = item / nblk, nb = item % nblk, k0 = 64 * kb, n0 = 32 * nb;
    const int nd = n0 + (lane & 31); const int s = map.src(nd); const float scl = map.scale(nd);
#pragma unroll 8
    for (int i = 0; i < 32; ++i) { const int kk = 2 * i + (lane >> 5); scr[kk * 33 + (lane & 31)] = (s >= 0) ? W[(size_t)(k0 + kk) * Nsrc + s] * scl : 0.f; }
    LDS_WAIT(); asm volatile("" ::: "memory");
    const int c = lane & 7;
#pragma unroll
    for (int j = 0; j < 4; ++j) { const int n = (lane >> 3) + 8 * j; const LAS float* sp = scr + (8 * c) * 33 + n;
        u32x4 o; o.x = pk2(sp[0 * 33], sp[1 * 33]); o.y = pk2(sp[2 * 33], sp[3 * 33]); o.z = pk2(sp[4 * 33], sp[5 * 33]); o.w = pk2(sp[6 * 33], sp[7 * 33]);
        *(u32x4*)(WT + (size_t)(n0 + n) * K + k0 + 8 * c) = o; }
    LDS_WAIT(); asm volatile("" ::: "memory");
}
DI void mod_partial_item(const float* c, const float* wada, float* modp, int item, int lane) {
    const int kc = item & 15, nb = (item >> 4) % 48, l = item / (16 * 48);
    const int k0 = kc * 128, n0 = nb * 256 + 4 * lane;
    const float* Wl = wada + (size_t)l * 2048 * 12288;
    f32x4 acc[8];
#pragma unroll
    for (int b = 0; b < 8; ++b) acc[b] = (f32x4){0.f, 0.f, 0.f, 0.f};
#pragma unroll 1
    for (int sub = 0; sub < 2; ++sub) {
        float cb[8];
#pragma unroll
        for (int b = 0; b < 8; ++b) { const float x = c[b * 2048 + k0 + 64 * sub + lane]; cb[b] = x / (1.f + __expf(-x)); }
#pragma unroll 8
        for (int kk = 0; kk < 64; ++kk) { const f32x4 w = *(const f32x4*)(Wl + (size_t)(k0 + 64 * sub + kk) * 12288 + n0);
#pragma unroll
            for (int b = 0; b < 8; ++b) { const float s = __builtin_bit_cast(float, __builtin_amdgcn_readlane(__builtin_bit_cast(int, cb[b]), kk)); acc[b] += s * w; } }
    }
#pragma unroll
    for (int b = 0; b < 8; ++b) *(f32x4*)(modp + ((size_t)(kc * 2 + l) * 8 + b) * 12288 + n0) = acc[b];
}
DI void norm_row(const float* xrow, bf16_t* orow, const f32x4 (&Av)[8], const f32x4 (&Bv)[8], int lane) {
    const f32x4* xr = (const f32x4*)xrow + lane;
    f32x4 v[8]; float s = 0.f;
#pragma unroll
    for (int j = 0; j < 8; ++j) { v[j] = xr[64 * j]; s += (v[j][0] * v[j][0] + v[j][1] * v[j][1]) + (v[j][2] * v[j][2] + v[j][3] * v[j][3]); }
    const float rstd = 1.f / sqrtf(wave_sum(s) * (1.f / 2048.f) + RMS_EPS);
    u32x2* o8 = (u32x2*)orow + lane;
#pragma unroll
    for (int j = 0; j < 8; ++j) { const f32x4 h = v[j] * rstd * Av[j] + Bv[j]; u32x2 w; w.x = cvtpk(h[0], h[1]); w.y = cvtpk(h[2], h[3]); o8[64 * j] = w; }
}
DI void final_row(float* xrow, const f32x4 (&Gv)[8], int lane) {
    f32x4* xr = (f32x4*)xrow + lane;
    f32x4 v[8]; float s = 0.f;
#pragma unroll
    for (int j = 0; j < 8; ++j) { v[j] = xr[64 * j]; s += (v[j][0] * v[j][0] + v[j][1] * v[j][1]) + (v[j][2] * v[j][2] + v[j][3] * v[j][3]); }
    const float rstd = 1.f / sqrtf(wave_sum(s) * (1.f / 2048.f) + RMS_EPS);
#pragma unroll
    for (int j = 0; j < 8; ++j) xr[64 * j] = v[j] * rstd * Gv[j];
}
DI void conv_task(const bf16_t* qkv, const float* cw, bf16_t* br, int row0, int lane) {
    const int ch = lane * 8;
    float w0[8], w1[8], w2[8];
#pragma unroll
    for (int j = 0; j < 8; ++j) { w0[j] = cw[ch + j]; w1[j] = cw[512 + ch + j]; w2[j] = cw[1024 + ch + j]; }
    float up2[8], up1[8];
    const bf16_t* rp = qkv + (size_t)row0 * LDQ + ch;
    auto load_u = [&](const bf16_t* r, float (&u)[8]) {
        const bf16x8 cg = *(const bf16x8*)(r + C_CG), xi = *(const bf16x8*)(r + C_XIN);
#pragma unroll
        for (int j = 0; j < 8; ++j) u[j] = bf2f((bf16_t)cg[j]) * bf2f((bf16_t)xi[j]);
    };
    if ((row0 & (SEQ - 1)) == 0) {
#pragma unroll
        for (int j = 0; j < 8; ++j) { up2[j] = 0.f; up1[j] = 0.f; }
    } else { load_u(rp - 2 * LDQ, up2); load_u(rp - LDQ, up1); }
    bf16_t* op = br + (size_t)row0 * 2048 + 1024 + ch;
#pragma unroll
    for (int i = 0; i < 8; ++i) { float u[8]; load_u(rp, u);
        const bf16x8 bg = *(const bf16x8*)(rp + C_BG);
        rp += LDQ; asm volatile("" : "+v"(rp));
        float y[8];
#pragma unroll
        for (int j = 0; j < 8; ++j) y[j] = bf2f((bf16_t)bg[j]) * (w0[j] * up2[j] + w1[j] * up1[j] + w2[j] * u[j]);
        u32x4 o; o.x = cvtpk(y[0], y[1]); o.y = cvtpk(y[2], y[3]); o.z = cvtpk(y[4], y[5]); o.w = cvtpk(y[6], y[7]);
        *(u32x4*)op = o; op += 2048; asm volatile("" : "+v"(op));
#pragma unroll
        for (int j = 0; j < 8; ++j) { up2[j] = up1[j]; up1[j] = u[j]; } }
}
DI void fcum_task(const bf16_t* qkvb  , float bf_h, int h, float* out  , int lane) {
    const bf16_t* p0 = qkvb + (size_t)(32 * lane) * LDQ + C_FD + h;
    float run = 0.f;
    { const bf16_t* p = p0;
#pragma unroll 1
      for (int i = 0; i < 32; ++i) { const float x = bf2f(*p) + bf_h; p += LDQ; run += fminf(x, 0.f) - log1pf(expf(-fabsf(x))); } }
    float incl = run;
#pragma unroll
    for (int o = 1; o < 64; o <<= 1) { const float y = __shfl_up(incl, o); if (lane >= o) incl += y; }
    float acc = incl - run;
    { const bf16_t* p = p0; float* op = out + 32 * lane;
#pragma unroll 1
      for (int i = 0; i < 32; ++i) { const float x = bf2f(*p) + bf_h; p += LDQ; acc += fminf(x, 0.f) - log1pf(expf(-fabsf(x))); op[i] = acc * LOG2E; } }
}
DI int rowsum16(int x) { x += __shfl_xor(x, 8); x += __shfl_xor(x, 4); x += __shfl_xor(x, 2); x += __shfl_xor(x, 1); return x; }
DI void select_task(const bf16_t* qkvb  , unsigned long long* mrow  , int t0, LAS unsigned long long* wl, int lane_in) {
    int lane = lane_in; asm volatile("" : "+v"(lane));
    const int fr = lane & 15, fq = lane >> 4, t = t0 + fq;
    const int nch = __builtin_amdgcn_readfirstlane((t0 + 3) / 512 + 1);
    const bf16_t* ap = qkvb + (size_t)(t0 + (fr >> 2)) * LDQ + C_IQ + (fr & 3) * 64 + fq * 8;
    const bf16x8 a0 = *(const bf16x8*)ap, a1 = *(const bf16x8*)(ap + 32);
    float w[4]; { const u32x2 ww = *(const u32x2*)(qkvb + (size_t)t * LDQ + C_IW);
        w[0] = __uint_as_float(ww.x << 16) * IDX_SCALE; w[1] = __uint_as_float(ww.x & 0xffff0000u) * IDX_SCALE; w[2] = __uint_as_float(ww.y << 16) * IDX_SCALE; w[3] = __uint_as_float(ww.y & 0xffff0000u) * IDX_SCALE; }
    unsigned u[128];
    const int tf = t - fr;
    const char* kbase = (const char*)qkvb + C_IK * 2;
    unsigned voff = (unsigned)(fr * LDQ + fq * 8) * 2u;
#pragma unroll
    for (int c = 0; c < 4; ++c) {
        if (c < nch) {
#pragma unroll
            for (int ii = 0; ii < 32; ++ii) { const int i = c * 32 + ii;
                const bf16x8 b0 = *(const bf16x8*)(kbase + voff), b1 = *(const bf16x8*)(kbase + voff + 64);
                voff += 16 * LDQ * 2; asm volatile("" : "+v"(voff));
                f32x4 acc = (f32x4){0.f, 0.f, 0.f, 0.f};
                acc = __builtin_amdgcn_mfma_f32_16x16x32_bf16(a0, b0, acc, 0, 0, 0);
                acc = __builtin_amdgcn_mfma_f32_16x16x32_bf16(a1, b1, acc, 0, 0, 0);
                const float sc = ((w[0] * fmaxf(acc[0], 0.f) + w[1] * fmaxf(acc[1], 0.f)) + w[2] * fmaxf(acc[2], 0.f)) + w[3] * fmaxf(acc[3], 0.f);
                unsigned bits = __float_as_uint(sc); if (bits == 0x80000000u) bits = 0u;
                const unsigned key = (bits & 0x80000000u) ? ~bits : (bits | 0x80000000u);
                u[i] = (16 * i <= tf) ? key : 0u; }
        } else {
#pragma unroll
            for (int ii = 0; ii < 32; ++ii) u[c * 32 + ii] = 0u;
        }
    }
#define CNT_GE(cnt, x, c) asm("v_cmp_ge_u32 vcc, %1, %2\n\tv_addc_co_u32 %0, vcc, 0, %0, vcc" : "+v"(cnt) : "v"(x), "v"(c) : "vcc")
#define CNT_GT(cnt, x, c) asm("v_cmp_gt_u32 vcc, %1, %2\n\tv_addc_co_u32 %0, vcc, 0, %0, vcc" : "+v"(cnt) : "v"(x), "v"(c) : "vcc")
#define FOR_CHUNKS(BODY) _Pragma("unroll") for (int c_ = 0; c_ < 4; ++c_) { if (c_ < nch) { _Pragma("unroll") for (int ii_ = 0; ii_ < 32; ++ii_) { const int i = c_ * 32 + ii_; BODY; } } }
    unsigned T = 0u;
#pragma unroll 1
    for (int bit = 31; bit >= 0; --bit) { const unsigned c = T | (1u << bit); int cnt = 0;
        FOR_CHUNKS(CNT_GE(cnt, u[i], c));
        cnt = rowsum16(cnt); if (cnt >= 256) T = c; }
    int cgt = 0, cge = 0;
    FOR_CHUNKS(CNT_GT(cgt, u[i], T); CNT_GE(cge, u[i], T));
    cgt = rowsum16(cgt); cge = rowsum16(cge);
    const int need = 256 - cgt; const bool tie = (cge - cgt) > need;
    int X0 = 4095;
    if (__any(tie)) { int x = 0; const unsigned notT = ~T;
#pragma unroll 1
        for (int bit = 10; bit >= 0; --bit) { const int c = x | (1 << bit); int g = 0; const int cf = c - fr;
            FOR_CHUNKS(unsigned tmp;
                asm("v_cmp_lt_i32 vcc, %6, %3\n\tv_cndmask_b32 %1, %4, %2, vcc\n\tv_cmp_eq_u32 vcc, %1, %5\n\tv_addc_co_u32 %0, vcc, 0, %0, vcc"
                    : "+v"(g), "=&v"(tmp) : "v"(u[i]), "v"(cf), "v"(notT), "v"(T), "n"(16 * i) : "vcc"));
            g = rowsum16(g); if (g < need) x = c; }
        if (tie) X0 = x; }
#undef CNT_GE
#undef CNT_GT
    const int xf = X0 - fr;
    FOR_CHUNKS(const bool sel = (u[i] > T) || (u[i] == T && 16 * i <= xf);
        const unsigned long long bal = __ballot(sel); if (lane == 0) wl[i] = bal;
        if ((i & 3) == 3) asm volatile("" ::: "memory"));
#undef FOR_CHUNKS
    LDS_WAIT(); asm volatile("" ::: "memory");
#pragma unroll
    for (int half = 0; half < 2; ++half) { const int j = fr + 16 * half; unsigned long long word = 0ull;
        if (j < nch * 8) {
#pragma unroll
            for (int i4 = 0; i4 < 4; ++i4) word |= ((wl[4 * j + i4] >> (16 * fq)) & 0xFFFFull) << (16 * i4); }
        mrow[(size_t)t * 32 + j] = word; }
    LDS_WAIT(); asm volatile("" ::: "memory");
}
DI void select_causal_task(unsigned long long* mrow, int t0, int lane) {
    const int fr = lane & 15, fq = lane >> 4, t = t0 + fq;
#pragma unroll
    for (int half = 0; half < 2; ++half) { const int j = fr + 16 * half; const int n = t - 64 * j + 1;
        const unsigned long long word = n >= 64 ? ~0ull : (n <= 0 ? 0ull : ((1ull << n) - 1ull));
        mrow[(size_t)t * 32 + j] = word; }
}
DI void select_any(const bf16_t* qkvb, unsigned long long* mrow, int t0, LAS unsigned long long* wl, int lane) {
    if (t0 + 3 < 256) select_causal_task(mrow, t0, lane);
    else select_task(qkvb, mrow, t0, wl, lane);
}

constexpr size_t MiB = 1u << 20;
constexpr size_t WS_CTL = 0, CTL_ZERO_BYTES = 1 * MiB;
constexpr size_t WS_MODF = 1 * MiB;
constexpr size_t WS_MODP = 2 * MiB;
constexpr size_t WS_FCUM = 14 * MiB;
constexpr size_t WS_MASK = 15 * MiB;
constexpr size_t WS_STASH = 20 * MiB;
constexpr size_t WS_W = 52 * MiB;
constexpr size_t OW_IN = 0, OW_G = 26 * MiB, OW_B = 58 * MiB, OW_O = 66 * MiB, OW_1 = 74 * MiB, OW_2 = 106 * MiB, LW_BYTES = 138 * MiB;
constexpr size_t WS_H = WS_W + 2 * LW_BYTES;
constexpr size_t WS_BR = WS_H + 64 * MiB;
constexpr size_t WS_R1 = WS_BR + 64 * MiB;
constexpr size_t WS_END = WS_R1 + 256 * MiB;
constexpr int CW_BAR = 4096;
constexpr int CW_QUEUE = 16384;

constexpr int RING_OFF = 0, RING_BYTES = 131072;
constexpr int LDSCTL_OFF = RING_BYTES, MISC_OFF = LDSCTL_OFF + 320;
constexpr int LDS_BYTES = 147456;
static_assert(att::LDS_END <= RING_BYTES, "attention scratch inside the ring region");


constexpr int NWAVES = 8;
constexpr int N_PHASES = 23;
struct Args { const float* in[19]; float* out; unsigned char* ws; int ph_lo, ph_hi; };

typedef __attribute__((address_space(4))) const unsigned char* kargp_t;
DI kargp_t karg_base() { kargp_t kp = (kargp_t)__builtin_amdgcn_kernarg_segment_ptr(); asm volatile("" : "+s"(kp)); return kp; }
typedef const float* cfptr_t; typedef float* fptr_t; typedef unsigned char* ucptr_t;
DI const float* karg_in(int i) { return *(const __attribute__((address_space(4))) cfptr_t*)(karg_base() + 8 * i); }
DI float* karg_out() { return *(const __attribute__((address_space(4))) fptr_t*)(karg_base() + 8 * 19); }
DI unsigned char* karg_ws() { return *(const __attribute__((address_space(4))) ucptr_t*)(karg_base() + 8 * 20); }
#define ARG_IN(i) karg_in(i)

template <int MODE>
DI void attn_queue(LAS unsigned char* lds, volatile LAS unsigned* MISC, int qidx, int l, int tid, int lane) {
    unsigned char* ws = karg_ws();
    unsigned* qhead = (unsigned*)(ws + WS_CTL) + CW_QUEUE + 64 * qidx;
    bf16_t* QKV = (bf16_t*)(ws + WS_R1); bf16_t* BR = (bf16_t*)(ws + WS_BR);
    float lamv = 0.f, post = 0.f;
    if (MODE == 1) { const float* lq = ARG_IN(8) + l * 256; const float a = wave_sum(lq[lane] * lq[64 + lane]), b = wave_sum(lq[128 + lane] * lq[192 + lane]);
        const float lam_init = 0.8f - 0.6f * expf(-0.3f * (float)l); lamv = expf(a) - expf(b) + lam_init; post = 1.f - lam_init; }
    for (;;) {
        if (tid == 0) MISC[0] = __hip_atomic_fetch_add(qhead, 1u, RLX_AGENT);
        __syncthreads();
        const unsigned u = MISC[0];
        __syncthreads();
        if (u >= 256u) break;
        const int qb = 7 - (int)(u >> 5), bh = (int)(u & 31u), b = bh >> 2, h = bh & 3;
        att::UnitArgs A;
        const size_t rowb = (size_t)b * SEQ;
        const int cq = MODE == 0 ? C_QA : (MODE == 1 ? C_QB : C_QD), ck = MODE == 0 ? C_KA : (MODE == 1 ? C_KB : C_KD), cv = MODE == 0 ? C_VA : (MODE == 1 ? C_VB : C_VD);
        const int oc = MODE == 0 ? 0 : (MODE == 1 ? 512 : 1536);
        A.Qp = QKV + rowb * LDQ + cq + h * 128; A.Kp = QKV + rowb * LDQ + ck + h * 128; A.Vp = QKV + rowb * LDQ + cv + h * 128;
        A.Op = BR + rowb * 2048 + oc + h * 128; A.q0 = qb * 256;
        A.maskp = (const unsigned long long*)(ws + WS_MASK) + rowb * 32;
        A.fcum = (const float*)(ws + WS_FCUM) + (size_t)(b * 4 + h) * SEQ;
        A.relb = ARG_IN(10); A.relcol = (MODE == 1 ? 4 : 0) + h;
        A.lam = lamv; A.post = post; A.gsub = ARG_IN(9) + l * 128;
        A.stash = (float*)(ws + WS_STASH) + (size_t)blockIdx.x * 64 * 512;
        att::attn_unit<MODE>((LAS char*)lds, A);
    }
}

#define IN(k) (lo <= (k) && (k) < hi)
#define SEAM(k) do { if (IN((k) + 1)) xcd_barrier(bar); } while (0)
#define PH_PTRS int tid_p = threadIdx.x; asm volatile("" : "+v"(tid_p)); const int tid = tid_p, lane = tid & 63; (void)lane; unsigned char* ws = karg_ws(); float* xbuf = karg_out(); float* modf = (float*)(ws + WS_MODF); float* modp = (float*)(ws + WS_MODP); \
    bf16_t* Hb = (bf16_t*)(ws + WS_H); bf16_t* BR = (bf16_t*)(ws + WS_BR); bf16_t* R1 = (bf16_t*)(ws + WS_R1); \
    (void)xbuf; (void)modf; (void)modp; (void)Hb; (void)BR; (void)R1
#define PH_LAYER PH_PTRS; unsigned char* wl_ = ws + WS_W + (size_t)l * LW_BYTES; const float* modl = modf + (size_t)l * 8 * 12288; (void)wl_; (void)modl
template <int l, int LO, int HI>
DI void layer_phases(LAS unsigned char* lds, volatile LAS unsigned* MISC, const XcdBarrier& bar, int wave, int G, int bx, int gw, int NGW) {
    constexpr int lo = LO, hi = HI;
        const int pb = 2 + 10 * l;
        if (IN(pb + 0)) { PH_LAYER;
            const float* xs = (l == 0) ? ARG_IN(0) : (const float*)xbuf; const float* g1 = ARG_IN(4) + l * 2048;
#ifndef PROBE_REP_N1
#define PROBE_REP_N1 1
#endif
#pragma unroll 1
          for (int rep = 0; rep < PROBE_REP_N1; ++rep)
            for (int rb = gw; rb < M_TOK / 8; rb += NGW) { const int b = (rb * 8) / SEQ; f32x4 Av[8], Bv[8];
#pragma unroll
                for (int j = 0; j < 8; ++j) { const int c = 4 * lane + 256 * j; const f32x4 g = *(const f32x4*)(g1 + c), sc = *(const f32x4*)(modl + b * 12288 + 2048 + c); Av[j] = g * (sc + 1.f); Bv[j] = *(const f32x4*)(modl + b * 12288 + c); }
#pragma unroll 1
                for (int i = 0; i < 8; ++i) norm_row(xs + (size_t)(rb * 8 + i) * 2048, Hb + (size_t)(rb * 8 + i) * 2048, Av, Bv, lane); }
            SEAM(pb + 0);
        }
        if (IN(pb + 1)) { PH_LAYER;
            pg8::Gemm g{Hb, (const bf16_t*)(wl_ + OW_IN), M_TOK, LDQ, 2048, 2048, 2048, 1 << 30, 0}; pg8::StaticOrder S; S.init(M_TOK, LDQ, G, bx);
            pg8::EpiBf16<0> E{R1, LDQ};

#ifndef NO_G1
#ifndef PROBE_REP_G1
#define PROBE_REP_G1 1
#endif
#pragma unroll 1
            for (int rep = 0; rep < PROBE_REP_G1; ++rep)
            pg8::gemm_phase<pg8::EpiBf16<0>, pg8::StaticOrder, true, true>(lds + RING_OFF, g, S, E);
#endif
            SEAM(pb + 1);
        }
        if (IN(pb + 2)) { PH_LAYER;
            LAS unsigned long long* wlq = (LAS unsigned long long*)(lds + RING_OFF) + wave * 128;
            unsigned long long* mask = (unsigned long long*)(ws + WS_MASK);
#ifndef PROBE_REP_M1
#define PROBE_REP_M1 1
#endif
#pragma unroll 1
          for (int rep = 0; rep < PROBE_REP_M1; ++rep)
            for (int k = gw; k < 2048; k += NGW) {
#pragma unroll 1
                for (int pass = 0; pass < 2; ++pass) { const int kk = pass ? 4095 - k : k; const int b = kk & 7, t0 = (kk >> 3) * 4;
#ifndef NO_SELECT
                    select_any(R1 + (size_t)b * SEQ * LDQ, mask + (size_t)b * SEQ * 32, t0, wlq, lane);
#endif
                } }
#ifndef NO_CONV
            for (int rb = gw; rb < M_TOK / 8; rb += NGW) conv_task(R1, ARG_IN(7) + l * 1536, BR, rb * 8, lane);
#endif
#ifndef NO_FCUM
            for (int k = gw; k < 32; k += NGW) { const int b = k >> 2, h = k & 3; fcum_task(R1 + (size_t)b * SEQ * LDQ, ARG_IN(6)[l * 4 + h], h, (float*)(ws + WS_FCUM) + (size_t)k * SEQ, lane); }
#endif
            SEAM(pb + 2);
        }
        if (IN(pb + 3)) { PH_LAYER;
#ifndef PROBE_REP_M2
#define PROBE_REP_M2 1
#endif
#pragma unroll 1
          for (int rep = 0; rep < PROBE_REP_M2; ++rep) {
            if (rep) xcd_barrier(bar);
            attn_queue<1>(lds + RING_OFF, MISC, 3 * l + 0 + 6 * rep, l, tid, lane);
            attn_queue<0>(lds + RING_OFF, MISC, 3 * l + 1 + 6 * rep, l, tid, lane);
            attn_queue<2>(lds + RING_OFF, MISC, 3 * l + 2 + 6 * rep, l, tid, lane);
          }
            SEAM(pb + 3);
        }
        if (IN(pb + 4)) { PH_LAYER;
            pg8::Gemm g{BR, (const bf16_t*)(wl_ + OW_B), M_TOK, 8192, 512, 2048, 512, 8, 512}; pg8::StaticOrder S; S.init(M_TOK, 8192, G, bx);
            pg8::EpiBf16<0> E{R1, 8192};

#ifndef NO_G2
#ifndef PROBE_REP_G2
#define PROBE_REP_G2 1
#endif
#pragma unroll 1
            for (int rep = 0; rep < PROBE_REP_G2; ++rep)
            pg8::gemm_phase<pg8::EpiBf16<0>, pg8::StaticOrder, true, true>(lds + RING_OFF, g, S, E);
#endif
            SEAM(pb + 4);
        }
        if (IN(pb + 5)) { PH_LAYER;
            pg8::Gemm g{Hb, (const bf16_t*)(wl_ + OW_G), M_TOK, 8192, 2048, 2048, 2048, 1 << 30, 0}; pg8::StaticOrder S; S.init(M_TOK, 8192, G, bx);
            pg8::EpiGate E{R1, ARG_IN(12) + l * 8192, BR};

#ifndef NO_G3
#ifndef PROBE_REP_G3
#define PROBE_REP_G3 1
#endif
#pragma unroll 1
            for (int rep = 0; rep < PROBE_REP_G3; ++rep)
            pg8::gemm_phase<pg8::EpiGate, pg8::StaticOrder, true, true>(lds + RING_OFF, g, S, E);
#endif

            SEAM(pb + 5);
        }
        if (IN(pb + 6)) { PH_LAYER;
            pg8::Gemm g{BR, (const bf16_t*)(wl_ + OW_O), M_TOK, 2048, 2048, 2048, 2048, 1 << 30, 0}; pg8::StaticOrder S; S.init(M_TOK, 2048, G, bx);
            pg8::EpiResid E{(l == 0) ? ARG_IN(0) : (const float*)xbuf, xbuf, modl + 4096, 12288};

#ifndef NO_G4
#ifdef PROBE_NULL_G4
            { pg8::EpiNull EN{(float*)(ws + WS_FCUM)}; pg8::gemm_phase<pg8::EpiNull, pg8::StaticOrder, true, true>(lds + RING_OFF, g, S, EN); }
#endif
            pg8::gemm_phase<pg8::EpiResid, pg8::StaticOrder, true, true>(lds + RING_OFF, g, S, E);
#endif
            SEAM(pb + 6);
        }
        if (IN(pb + 7)) { PH_LAYER;
            const float* g2 = ARG_IN(15) + l * 2048;
            for (int rb = gw; rb < M_TOK / 8; rb += NGW) { const int b = (rb * 8) / SEQ; f32x4 Av[8], Bv[8];
#pragma unroll
                for (int j = 0; j < 8; ++j) { const int c = 4 * lane + 256 * j; const f32x4 g = *(const f32x4*)(g2 + c), sc = *(const f32x4*)(modl + b * 12288 + 8192 + c); Av[j] = g * (sc + 1.f); Bv[j] = *(const f32x4*)(modl + b * 12288 + 6144 + c); }
#pragma unroll 1
                for (int i = 0; i < 8; ++i) norm_row(xbuf + (size_t)(rb * 8 + i) * 2048, Hb + (size_t)(rb * 8 + i) * 2048, Av, Bv, lane); }
            SEAM(pb + 7);
        }
        if (IN(pb + 8)) { PH_LAYER;
            pg8::Gemm g{Hb, (const bf16_t*)(wl_ + OW_1), M_TOK, 8192, 2048, 2048, 2048, 1 << 30, 0}; pg8::StaticOrder S; S.init(M_TOK, 8192, G, bx);
            pg8::EpiBf16<2> E{R1, 8192};

#ifndef NO_G5
#ifdef PROBE_NULL_G5
            { pg8::EpiNull EN{(float*)(ws + WS_FCUM)}; pg8::gemm_phase<pg8::EpiNull, pg8::StaticOrder, true, true>(lds + RING_OFF, g, S, EN); }
#endif
#ifndef PROBE_REP_G5
#define PROBE_REP_G5 1
#endif
#pragma unroll 1
            for (int rep = 0; rep < PROBE_REP_G5; ++rep)
            pg8::gemm_phase<pg8::EpiBf16<2>, pg8::StaticOrder, true, true>(lds + RING_OFF, g, S, E);
#endif

            SEAM(pb + 8);
        }
        if (IN(pb + 9)) { PH_LAYER;
            pg8::Gemm g{R1, (const bf16_t*)(wl_ + OW_2), M_TOK, 2048, 8192, 8192, 8192, 1 << 30, 0}; pg8::StaticOrder S; S.init(M_TOK, 2048, G, bx);
            pg8::EpiResid E{xbuf, xbuf, modl + 10240, 12288};

#ifndef NO_G6
#ifdef PROBE_NULL_G6
            { pg8::EpiNull EN{(float*)(ws + WS_FCUM)}; pg8::gemm_phase<pg8::EpiNull, pg8::StaticOrder, true, true>(lds + RING_OFF, g, S, EN); }
#endif
            pg8::gemm_phase<pg8::EpiResid, pg8::StaticOrder, true, true>(lds + RING_OFF, g, S, E);
#endif
            SEAM(pb + 9);
        }
}

template <int LO, int HI>
__global__ void __launch_bounds__(NWAVES * 64, 2) mk_fwd(Args args) {
    extern __shared__ __attribute__((aligned(16))) unsigned char lds_raw[];
    LAS unsigned char* lds = (LAS unsigned char*)lds_raw;
    volatile LAS unsigned* MISC = (volatile LAS unsigned*)(lds + MISC_OFF);
    const int tid0 = threadIdx.x, wave = __builtin_amdgcn_readfirstlane(tid0 >> 6);
    const int G = gridDim.x; const int bx = blockIdx.x; const int vcu = (G % 8 == 0) ? (bx % 8) * (G / 8) + bx / 8 : bx;
    const int gw = vcu * NWAVES + wave, NGW = G * NWAVES;
    for (int u = tid0; u < (LDS_BYTES - LDSCTL_OFF) / 4; u += NWAVES * 64) ((LAS unsigned*)(lds + LDSCTL_OFF))[u] = 0u;
    __syncthreads();
    constexpr int lo = LO, hi = HI; (void)args;
    XcdBarrier bar; bar.bar = (unsigned*)(karg_ws() + WS_CTL) + CW_BAR; bar.x = 0; bar.st = nullptr;
    if constexpr (hi - lo > 1) bar = xcd_barrier_post((unsigned*)(karg_ws() + WS_CTL) + CW_BAR, MISC + 8);

    if (IN(0)) { PH_PTRS;
        LAS float* scr = (LAS float*)(lds + RING_OFF + wave * 16384);
#ifndef PROBE_REP_P0
#define PROBE_REP_P0 1
#endif
#pragma unroll 1
        for (int rep = 0; rep < PROBE_REP_P0; ++rep) {
        constexpr int I_IN = 32 * 208, I_G = 32 * 256, I_B = 4 * 8 * 64, I_O = 32 * 64, I_1 = 32 * 256, I_2 = 128 * 64, I_L = I_IN + I_G + I_B + I_O + I_1 + I_2;
        for (int it = gw; it < 2 * I_L; it += NGW) {
            const int l = it / I_L; int r = it % I_L;
            unsigned char* wl_ = ws + WS_W + (size_t)l * LW_BYTES;
            if (r < I_IN) { transpose_item(ARG_IN(5) + (size_t)l * 2048 * 6472, 2048, 6472, 208, (bf16_t*)(wl_ + OW_IN), MapWin(), scr, r, lane); continue; } r -= I_IN;
            if (r < I_G) { transpose_item(ARG_IN(11) + (size_t)l * 2048 * 8192, 2048, 8192, 256, (bf16_t*)(wl_ + OW_G), MapGate(), scr, r, lane); continue; } r -= I_G;
            const float* W; int K, Ns, nblk; bf16_t* WT;
            if (r < I_B) { const int g = r / 512; r -= g * 512; W = ARG_IN(13) + (size_t)(l * 4 + g) * 512 * 2048; K = 512; Ns = 2048; nblk = 64; WT = (bf16_t*)(wl_ + OW_B) + (size_t)g * 2048 * 512; }
            else { r -= I_B;
                if (r < I_O) { W = ARG_IN(14) + (size_t)l * 2048 * 2048; K = 2048; Ns = 2048; nblk = 64; WT = (bf16_t*)(wl_ + OW_O); }
                else { r -= I_O;
                    if (r < I_1) { W = ARG_IN(16) + (size_t)l * 2048 * 8192; K = 2048; Ns = 8192; nblk = 256; WT = (bf16_t*)(wl_ + OW_1); }
                    else { r -= I_1; W = ARG_IN(17) + (size_t)l * 8192 * 2048; K = 8192; Ns = 2048; nblk = 64; WT = (bf16_t*)(wl_ + OW_2); } } }
            transpose_item(W, K, Ns, nblk, WT, MapPlain(), scr, r, lane);
        }
        for (int it = gw; it < 2 * 48 * 16; it += NGW) mod_partial_item(ARG_IN(1), ARG_IN(2), modp, it, lane);
        }
        SEAM(0);
    }
    if (IN(1)) { PH_PTRS;
        for (int i = bx * 512 + tid; i < 2 * 8 * 12288; i += G * 512) { const int n = i % 12288, l = i / (8 * 12288);
            float s = ARG_IN(3)[l * 12288 + n];
#pragma unroll
            for (int kc = 0; kc < 16; ++kc) s += modp[(size_t)kc * (2 * 8 * 12288) + i];
            modf[i] = s; }
        SEAM(1);
    }
    constexpr int L_LO = (LO <= 2) ? 0 : (LO - 2) / 10, L_HI = (HI >= 22) ? NLAYER : (HI - 2 + 9) / 10;
    if constexpr (L_LO <= 0 && 0 < L_HI) layer_phases<0, LO, HI>(lds, MISC, bar, wave, G, bx, gw, NGW);
    if constexpr (L_LO <= 1 && 1 < L_HI) layer_phases<1, LO, HI>(lds, MISC, bar, wave, G, bx, gw, NGW);
    if (IN(22)) { PH_PTRS;
        f32x4 Gv[8];
#pragma unroll
        for (int j = 0; j < 8; ++j) Gv[j] = *(const f32x4*)(ARG_IN(18) + 4 * lane + 256 * j);
        for (int rb = gw; rb < M_TOK / 8; rb += NGW) {
#pragma unroll 1
            for (int i = 0; i < 8; ++i) final_row(xbuf + (size_t)(rb * 8 + i) * 2048, Gv, lane); }
    }
}

#if !MK_ONE_LAUNCH
template <int P> static void set_attr_from() { if constexpr (P < N_PHASES) { (void)hipFuncSetAttribute((const void*)mk_fwd<P, P + 1>, hipFuncAttributeMaxDynamicSharedMemorySize, LDS_BYTES); set_attr_from<P + 1>(); } }
template <int P> static void launch_from(int grid, hipStream_t stream, Args a) {
    if constexpr (P < N_PHASES) { a.ph_lo = P; a.ph_hi = P + 1; hipLaunchKernelGGL((mk_fwd<P, P + 1>), dim3(grid), dim3(NWAVES * 64), LDS_BYTES, stream, a); launch_from<P + 1>(grid, stream, a); } }
#endif
extern "C" void kernel_launch(void* const* d_in, const int* in_sizes, int n_in, void* d_out, int out_size, void* d_ws, size_t ws_size, hipStream_t stream) {
    static int grid = 0;
    if (grid == 0) {
        if (n_in != 19 || in_sizes[0] != M_TOK * DM || out_size != M_TOK * DM || ws_size < WS_END) {
            fprintf(stderr, "kernel_launch: shape / workspace mismatch (n_in %d, in0 %d, out %d, ws %zu, need %zu); nothing launched\n", n_in, n_in > 0 ? in_sizes[0] : -1, out_size, ws_size, (size_t)WS_END); grid = -1; return; }
        int dev = 0, cus = 0, per_cu = 0;
        if (hipGetDevice(&dev) != hipSuccess || hipDeviceGetAttribute(&cus, hipDeviceAttributeMultiprocessorCount, dev) != hipSuccess) { fprintf(stderr, "kernel_launch: device query failed\n"); grid = -1; return; }
#if MK_ONE_LAUNCH
        if (hipFuncSetAttribute((const void*)mk_fwd<0, N_PHASES>, hipFuncAttributeMaxDynamicSharedMemorySize, LDS_BYTES) != hipSuccess) { fprintf(stderr, "kernel_launch: hipFuncSetAttribute failed\n"); grid = -1; return; }
        if (hipOccupancyMaxActiveBlocksPerMultiprocessor(&per_cu, (const void*)mk_fwd<0, N_PHASES>, NWAVES * 64, LDS_BYTES) != hipSuccess || per_cu < 1) fprintf(stderr, "kernel_launch: occupancy query reports %d workgroups per CU\n", per_cu);
#else
        set_attr_from<0>();
#endif
        (void)hipGetLastError();
        grid = cus;
    }
    if (grid < 0) return;
    if (hipMemsetAsync((char*)d_ws + WS_CTL, 0, CTL_ZERO_BYTES, stream) != hipSuccess) { fprintf(stderr, "kernel_launch: memset failed\n"); return; }
    Args a{};
    for (int i = 0; i < 19; ++i) a.in[i] = (const float*)d_in[i];
    a.out = (float*)d_out; a.ws = (unsigned char*)d_ws;
#if MK_ONE_LAUNCH
    a.ph_lo = 0; a.ph_hi = N_PHASES;
    hipLaunchKernelGGL((mk_fwd<0, N_PHASES>), dim3(grid), dim3(NWAVES * 64), LDS_BYTES, stream, a);
#else
    launch_from<0>(grid, stream, a);
#endif
    const hipError_t le = hipPeekAtLastError();
    if (le != hipSuccess) fprintf(stderr, "kernel_launch: launch failed: %s\n", hipGetErrorName(le));
}
```

```cpp
#include <hip/hip_runtime.h>
#include <cstdio>
#include <cstdint>

#ifndef MK_ONE_LAUNCH
#define MK_ONE_LAUNCH 1
#endif

#define DI __device__ __forceinline__
#define LAS __attribute__((address_space(3)))
#define GAS __attribute__((address_space(1)))

namespace pg8 {
#define PG8_LAS __attribute__((address_space(3)))
typedef unsigned short bf16_t;
typedef short bf16x8 __attribute__((ext_vector_type(8)));
typedef float f32x4 __attribute__((ext_vector_type(4)));
typedef float f32x2 __attribute__((ext_vector_type(2)));
typedef unsigned u32x4 __attribute__((ext_vector_type(4)));
typedef unsigned u32x2 __attribute__((ext_vector_type(2)));
typedef int i32x8a __attribute__((ext_vector_type(8), aligned(16)));
constexpr int BM = 256, BK = 64, HALF = 128, HTB = HALF * BK * 2  , STAGE_BYTES = 8 * HTB, NXCD = 8, WGM = 8;

__host__ __device__ __forceinline__ int lds_byte(int r, int c) { const int st = (r >> 4) * 2 + (c >> 5), rr = r & 15, cc = c & 31, ob = rr * 64 + cc * 2; return st * 1024 + (ob ^ (((ob >> 9) & 1) << 5)); }
__host__ __device__ __forceinline__ void stage_rc(int b, int& R, int& C) { const int st = b / 1024, sb = b % 1024, swz = sb ^ (((sb >> 9) & 1) << 5); R = (st >> 1) * 16 + swz / 64; C = (st & 1) * 32 + (swz % 64) / 2; }
__host__ __device__ __forceinline__ int perm32(int rho) { const int n = rho >> 4, i = rho & 15; return 8 * (i >> 2) + 4 * n + (i & 3); }

struct Unit { int pm, pn; };
struct Gemm { const bf16_t* A; const bf16_t* Bt; int M, N, K, lda, ldb, agdiv, agoff; };

struct StaticOrder {
    int nM, nN, nwg, G, c;
    __host__ __device__ void init(int M, int N, int G_, int c_) { nM = M / BM; nN = N / BM; nwg = nM * nN; G = G_; c = c_; }
    __host__ __device__ bool next(int i, Unit& u) const {
        const long L = (long)i * G + c; if (L >= nwg) return false;
        int wgid = (int)L; { const int q = nwg / NXCD, r = nwg % NXCD, xcd = wgid % NXCD, off = wgid / NXCD; wgid = (xcd < r ? xcd * (q + 1) : r * (q + 1) + (xcd - r) * q) + off; }
        const int nig = WGM * nN, gid = wgid / nig, fm = gid * WGM, gsz = (nM - fm) < WGM ? (nM - fm) : WGM;
        u.pm = fm + ((wgid % nig) % gsz); u.pn = (wgid % nig) / gsz; return true;
    }
    __device__ __forceinline__ void a_ready(const Unit&) const {}
    __device__ __forceinline__ void done(const Unit&) const {}
};

__device__ __forceinline__ unsigned cvt_pk_bf16(float lo, float hi) { unsigned r; asm volatile("v_cvt_pk_bf16_f32 %0, %1, %2" : "=v"(r) : "v"(lo), "v"(hi)); return r; }

template <int ACT> struct EpiBf16 {
    static constexpr bool PERM = true, AFTER_DRAIN = false;
    bf16_t* O; int ldc;
    __device__ __forceinline__ void operator()(const f32x4 (&acc)[2][2][4][2], const Unit& u, int wr, int wc, int fr, int fq) const {
        const int row0 = u.pm * BM + wr * 64 + fr; const int col0 = u.pn * BM + wc * 32 + 8 * fq;
#pragma unroll
        for (int ai = 0; ai < 2; ++ai)
#pragma unroll
            for (int m = 0; m < 4; ++m) { bf16_t* rowp = O + (size_t)(row0 + ai * HALF + m * 16) * ldc + col0;
#pragma unroll
                for (int bj = 0; bj < 2; ++bj) { f32x4 v0 = acc[ai][bj][m][0], v1 = acc[ai][bj][m][1];
                    if (ACT == 2) {
#pragma unroll
                        for (int j = 0; j < 4; ++j) { const float a = fmaxf(v0[j], 0.f), b = fmaxf(v1[j], 0.f); v0[j] = a * a; v1[j] = b * b; } }
                    u32x4 w; w.x = cvt_pk_bf16(v0[0], v0[1]); w.y = cvt_pk_bf16(v0[2], v0[3]); w.z = cvt_pk_bf16(v1[0], v1[1]); w.w = cvt_pk_bf16(v1[2], v1[3]);
                    *(u32x4*)(rowp + bj * HALF) = w; } }
    }
};
struct EpiNull {
    static constexpr bool PERM = true, AFTER_DRAIN = false;
    float* sink;
    __device__ __forceinline__ void operator()(const f32x4 (&acc)[2][2][4][2], const Unit& u, int wr, int wc, int fr, int fq) const {
        f32x4 s = (f32x4){0.f, 0.f, 0.f, 0.f};
#pragma unroll
        for (int ai = 0; ai < 2; ++ai)
#pragma unroll
            for (int bj = 0; bj < 2; ++bj)
#pragma unroll
                for (int m = 0; m < 4; ++m)
#pragma unroll
                    for (int n = 0; n < 2; ++n) s += acc[ai][bj][m][n];
        if (s[0] + s[1] + s[2] + s[3] == 1.2345678e33f) sink[u.pm] = s[0];
    }
};
struct EpiResid {
    static constexpr bool PERM = false, AFTER_DRAIN = false;
    const float* xin; float* xout; const float* gate; int gstride;
    __device__ __forceinline__ void operator()(const f32x4 (&acc)[2][2][4][2], const Unit& u, int wr, int wc, int fr, int fq) const {
        const int b = u.pm >> 3; const int col0 = u.pn * BM + wc * 32 + 4 * fq;
        f32x4 gv[2][2];
#pragma unroll
        for (int bj = 0; bj < 2; ++bj)
#pragma unroll
            for (int n = 0; n < 2; ++n) gv[bj][n] = *(const f32x4*)(gate + (size_t)b * gstride + col0 + bj * HALF + n * 16);
#pragma unroll
        for (int ai = 0; ai < 2; ++ai)
#pragma unroll
            for (int m = 0; m < 4; ++m) { const size_t off = (size_t)(u.pm * BM + ai * HALF + wr * 64 + m * 16 + fr) * 2048 + col0;
#pragma unroll
                for (int bj = 0; bj < 2; ++bj)
#pragma unroll
                    for (int n = 0; n < 2; ++n) { const f32x4 x = *(const f32x4*)(xin + off + bj * HALF + n * 16);
                        *(f32x4*)(xout + off + bj * HALF + n * 16) = x + gv[bj][n] * acc[ai][bj][m][n]; }
                if (m & 1) asm volatile("" ::: "memory"); }
    }
};
struct EpiGate {
    static constexpr bool PERM = false, AFTER_DRAIN = false;
    const bf16_t* P; const float* bgate; bf16_t* O; float ascale;
    __device__ __forceinline__ void operator()(const f32x4 (&acc)[2][2][4][2], const Unit& u, int wr, int wc, int fr, int fq) const {
        const int d0 = u.pn * 64 + wc * 16 + 4 * fq;
        f32x4 bv[2][2];
#pragma unroll
        for (int bj = 0; bj < 2; ++bj)
#pragma unroll
            for (int n = 0; n < 2; ++n) bv[bj][n] = *(const f32x4*)(bgate + (2 * bj + n) * 2048 + d0);
#pragma unroll
        for (int ai = 0; ai < 2; ++ai)
#pragma unroll
            for (int m = 0; m < 4; ++m) { const size_t row = (size_t)(u.pm * BM + ai * HALF + wr * 64 + m * 16 + fr);
                f32x4 s = (f32x4){0.f, 0.f, 0.f, 0.f};
#pragma unroll
                for (int bj = 0; bj < 2; ++bj)
#pragma unroll
                    for (int n = 0; n < 2; ++n) { const u32x2 pw = *(const u32x2*)(P + row * 8192 + (2 * bj + n) * 2048 + d0);
                        const f32x4 pv = (f32x4){__uint_as_float(pw.x << 16), __uint_as_float(pw.x & 0xffff0000u), __uint_as_float(pw.y << 16), __uint_as_float(pw.y & 0xffff0000u)};
                        const f32x4 x = acc[ai][bj][m][n] * ascale + bv[bj][n];
#pragma unroll
                        for (int j = 0; j < 4; ++j) { const float sg = __builtin_amdgcn_rcpf(1.f + __builtin_amdgcn_exp2f(-1.4426950408889634f * x[j])); s[j] += sg * pv[j]; } }
                u32x2 w; w.x = cvt_pk_bf16(s[0], s[1]); w.y = cvt_pk_bf16(s[2], s[3]);
                *(u32x2*)(O + row * 2048 + d0) = w;
                if (m & 1) asm volatile("" ::: "memory"); }
    }
};

template <class Epi, class Sched, bool ALIGN_EPI = false, bool SP2 = false, bool FP8 = false>
__device__ __forceinline__ void gemm_phase(PG8_LAS unsigned char* lds, const Gemm g, const Sched& S, const Epi& E) {
    int tid_l = threadIdx.x; asm volatile("" : "+v"(tid_l));
    const int tid = tid_l, wid = __builtin_amdgcn_readfirstlane(tid >> 6), lane = tid & 63, wr = wid >> 2, wc = wid & 3, fr = lane & 15, fq = lane >> 4;
    const int K = g.K, nt = K / BK;
    unsigned voffA[2], voffB[2];
#pragma unroll
    for (int i = 0; i < 2; ++i) { int R, C; stage_rc(tid * 16 + i * 8192, R, C); const int Rb = Epi::PERM ? ((R & ~31) + perm32(R & 31)) : R;
        voffA[i] = (unsigned)(R * g.lda + C) * 2u; voffB[i] = (unsigned)(Rb * g.ldb + C) * 2u; }
    const size_t kstep = (size_t)(BK * 2);
    const size_t hstepA = (size_t)HALF * g.lda * 2, hstepB = (size_t)HALF * g.ldb * 2;
    const size_t tstepA = 2 * hstepA, tstepB = 2 * hstepB;
    const unsigned ldsw = (unsigned)wid * 1024u;
    const int aoff = FP8 ? lds_byte(wr * 64 + fr, fq * 16) : lds_byte(wr * 64 + fr, fq * 8), boff = FP8 ? lds_byte(wc * 32 + fr, fq * 16) : lds_byte(wc * 32 + fr, fq * 8);
#define PG8_SA(b, h) (((b) * 2 + (h)) * HTB)
#define PG8_SB(b, h) ((4 + (b) * 2 + (h)) * HTB)
#define PG8_STAGE(bufoff, gbase, voff) do { _Pragma("unroll") for (int _i = 0; _i < 2; ++_i) \
        __builtin_amdgcn_global_load_lds((const unsigned*)((const char*)(gbase) + (voff)[_i]), (PG8_LAS unsigned*)(lds + (bufoff) + ldsw + _i * 8192), 16, 0, 0); } while (0)
#define PG8_LDA(dst, b, h) do { if constexpr (FP8) { _Pragma("unroll") for (int m = 0; m < 4; ++m) dst##8[m] = *(const PG8_LAS i32x8a*)(lds + PG8_SA(b, h) + aoff + m * 2048); } \
        else { _Pragma("unroll") for (int m = 0; m < 4; ++m) _Pragma("unroll") for (int k = 0; k < 2; ++k) dst[m][k] = *(const PG8_LAS bf16x8*)(lds + PG8_SA(b, h) + aoff + m * 2048 + k * 1024); } } while (0)
#define PG8_LDB(dst, b, h) do { if constexpr (FP8) { _Pragma("unroll") for (int n = 0; n < 2; ++n) dst##8[n] = *(const PG8_LAS i32x8a*)(lds + PG8_SB(b, h) + boff + n * 2048); } \
        else { _Pragma("unroll") for (int n = 0; n < 2; ++n) _Pragma("unroll") for (int k = 0; k < 2; ++k) dst[n][k] = *(const PG8_LAS bf16x8*)(lds + PG8_SB(b, h) + boff + n * 2048 + k * 1024); } } while (0)
#define PG8_MMA(ai, bj, At, Bt) do { __builtin_amdgcn_s_setprio(1); \
        if constexpr (FP8) { _Pragma("unroll") for (int m = 0; m < 4; ++m) _Pragma("unroll") for (int n = 0; n < 2; ++n) \
            asm volatile("v_mfma_scale_f32_16x16x128_f8f6f4 %0, %1, %2, %0, %3, %3 op_sel_hi:[0,0,0]" : "+v"(acc[ai][bj][m][n]) : "v"(Bt##8[n]), "v"(At##8[m]), "v"(sc1)); } \
        else { _Pragma("unroll") for (int m = 0; m < 4; ++m) _Pragma("unroll") for (int n = 0; n < 2; ++n) _Pragma("unroll") for (int k = 0; k < 2; ++k) \
            acc[ai][bj][m][n] = __builtin_amdgcn_mfma_f32_16x16x32_bf16(Bt[n][k], At[m][k], acc[ai][bj][m][n], 0, 0, 0); } \
        __builtin_amdgcn_s_setprio(0); } while (0)
#define PG8_WAIT_V(n) asm volatile("s_waitcnt vmcnt(" #n ")" ::: "memory")
#define PG8_WAIT_L(n) asm volatile("s_waitcnt lgkmcnt(" #n ")" ::: "memory")
#define PG8_BAR __builtin_amdgcn_s_barrier()
#define PG8_SCHED __builtin_amdgcn_sched_barrier(0)
    Unit cur, nxt; int ui = 0;
    if (!S.next(0, cur)) return;
    f32x4 acc[2][2][4][2];
#pragma unroll
    for (int a = 0; a < 2; ++a)
#pragma unroll
        for (int b = 0; b < 2; ++b)
#pragma unroll
            for (int m = 0; m < 4; ++m)
#pragma unroll
                for (int n = 0; n < 2; ++n) acc[a][b][m][n] = (f32x4){0.f, 0.f, 0.f, 0.f};
    bf16x8 At[4][2], B0[2][2], B1[2][2];
    i32x8a At8[4], B08[2], B18[2];
    int sc1 = 0x7F7F7F7F; asm volatile("" : "+v"(sc1));
    const char* cA = (const char*)g.A + (size_t)cur.pm * tstepA + (size_t)(cur.pn / g.agdiv) * (size_t)g.agoff * 2; const char* cB = (const char*)g.Bt + (size_t)cur.pn * tstepB;
    S.a_ready(cur);
    if constexpr (SP2) {
        PG8_STAGE(PG8_SB(0, 0), cB, voffB); PG8_STAGE(PG8_SB(0, 1), cB + hstepB, voffB); PG8_STAGE(PG8_SA(0, 0), cA, voffA); PG8_STAGE(PG8_SA(0, 1), cA + hstepA, voffA);
        if (wr == 1) PG8_BAR;
        PG8_WAIT_V(2); PG8_BAR;
        PG8_STAGE(PG8_SB(1, 0), cB + kstep, voffB); PG8_STAGE(PG8_SA(1, 0), cA + kstep, voffA); PG8_STAGE(PG8_SB(1, 1), cB + hstepB + kstep, voffB);
        PG8_WAIT_V(6); PG8_BAR;
    } else {
        PG8_STAGE(PG8_SB(0, 0), cB, voffB); PG8_STAGE(PG8_SA(0, 0), cA, voffA); PG8_STAGE(PG8_SB(0, 1), cB + hstepB, voffB); PG8_STAGE(PG8_SA(0, 1), cA + hstepA, voffA);
        if (wr == 1) PG8_BAR;
        PG8_WAIT_V(4); PG8_BAR;
        PG8_STAGE(PG8_SB(1, 0), cB + kstep, voffB); PG8_STAGE(PG8_SA(1, 0), cA + kstep, voffA); PG8_STAGE(PG8_SB(1, 1), cB + hstepB + kstep, voffB);
        PG8_WAIT_V(6); PG8_BAR;
    }
    for (;;) {
        const bool has_next = S.next(ui + 1, nxt);
        const char* nA = has_next ? (const char*)g.A + (size_t)nxt.pm * tstepA + (size_t)(nxt.pn / g.agdiv) * (size_t)g.agoff * 2 : cA; const char* nB = has_next ? (const char*)g.Bt + (size_t)nxt.pn * tstepB : cB;
        for (int t = 0; t < nt; t += 2) {
            const bool last = (t == nt - 2);
            const char* a1 = cA + (size_t)(t + 1) * kstep;
            const char* a2 = last ? nA : cA + (size_t)(t + 2) * kstep; const char* b2 = last ? nB : cB + (size_t)(t + 2) * kstep;
            const char* a3 = a2 + kstep; const char* b3 = b2 + kstep;
            if (last && has_next) S.a_ready(nxt);
            if constexpr (SP2) {
            PG8_LDB(B0, 0, 0); PG8_LDB(B1, 0, 1); PG8_SCHED; PG8_LDA(At, 0, 0); PG8_STAGE(PG8_SA(1, 1), a1 + hstepA, voffA);
            PG8_WAIT_V(8); PG8_WAIT_L(0); PG8_BAR; PG8_MMA(0, 0, At, B0); PG8_MMA(0, 1, At, B1); PG8_BAR; PG8_SCHED;
            PG8_LDA(At, 0, 1); PG8_STAGE(PG8_SB(0, 0), b2, voffB); PG8_STAGE(PG8_SB(0, 1), b2 + hstepB, voffB); PG8_STAGE(PG8_SA(0, 0), a2, voffA);
            PG8_WAIT_V(8); PG8_WAIT_L(0); PG8_BAR; PG8_MMA(1, 0, At, B0); PG8_MMA(1, 1, At, B1); PG8_BAR; PG8_SCHED;
            PG8_LDB(B0, 1, 0); PG8_LDB(B1, 1, 1); PG8_SCHED; PG8_LDA(At, 1, 0); PG8_STAGE(PG8_SA(0, 1), a2 + hstepA, voffA);
            PG8_WAIT_V(8); PG8_WAIT_L(0); PG8_BAR; PG8_MMA(0, 0, At, B0); PG8_MMA(0, 1, At, B1); PG8_BAR; PG8_SCHED;
            PG8_LDA(At, 1, 1); PG8_STAGE(PG8_SB(1, 0), b3, voffB); PG8_STAGE(PG8_SB(1, 1), b3 + hstepB, voffB); PG8_STAGE(PG8_SA(1, 0), a3, voffA);
            PG8_WAIT_V(8); PG8_WAIT_L(0); PG8_BAR; PG8_MMA(1, 0, At, B0); PG8_MMA(1, 1, At, B1); PG8_BAR; PG8_SCHED;
            } else {
            PG8_LDB(B0, 0, 0); PG8_SCHED; PG8_LDA(At, 0, 0); PG8_STAGE(PG8_SA(1, 1), a1 + hstepA, voffA);
            PG8_WAIT_L(8); PG8_BAR; PG8_WAIT_L(0); PG8_MMA(0, 0, At, B0); PG8_BAR; PG8_SCHED;
            PG8_LDB(B1, 0, 1); PG8_STAGE(PG8_SB(0, 0), b2, voffB);
            PG8_BAR; PG8_WAIT_L(0); PG8_MMA(0, 1, At, B1); PG8_BAR;
            PG8_LDA(At, 0, 1); PG8_STAGE(PG8_SA(0, 0), a2, voffA);
            PG8_BAR; PG8_WAIT_L(0); PG8_MMA(1, 0, At, B0); PG8_BAR; PG8_SCHED;
            PG8_STAGE(PG8_SB(0, 1), b2 + hstepB, voffB);
            PG8_WAIT_V(6); PG8_BAR; PG8_MMA(1, 1, At, B1); PG8_BAR;
            PG8_LDB(B0, 1, 0); PG8_SCHED; PG8_LDA(At, 1, 0); PG8_STAGE(PG8_SA(0, 1), a2 + hstepA, voffA);
            PG8_WAIT_L(8); PG8_BAR; PG8_WAIT_L(0); PG8_MMA(0, 0, At, B0); PG8_BAR; PG8_SCHED;
            PG8_LDB(B1, 1, 1); PG8_STAGE(PG8_SB(1, 0), b3, voffB);
            PG8_BAR; PG8_WAIT_L(0); PG8_MMA(0, 1, At, B1); PG8_BAR;
            PG8_LDA(At, 1, 1); PG8_STAGE(PG8_SA(1, 0), a3, voffA);
            PG8_BAR; PG8_WAIT_L(0); PG8_MMA(1, 0, At, B0); PG8_BAR; PG8_SCHED;
            PG8_STAGE(PG8_SB(1, 1), b3 + hstepB, voffB);
            PG8_WAIT_V(6); PG8_BAR; PG8_MMA(1, 1, At, B1); PG8_BAR;
            }
        }
        if constexpr (ALIGN_EPI) { if (wr == 0) PG8_BAR; }
        if constexpr (FP8) asm volatile("s_nop 15\n\ts_nop 7" ::: "memory");
        if constexpr (!Epi::AFTER_DRAIN) { E(acc, cur, wr, wc, fr, fq); S.done(cur); }
        if (!has_next) break;
#pragma unroll
        for (int a = 0; a < 2; ++a)
#pragma unroll
            for (int b = 0; b < 2; ++b)
#pragma unroll
                for (int m = 0; m < 4; ++m)
#pragma unroll
                    for (int n = 0; n < 2; ++n) acc[a][b][m][n] = (f32x4){0.f, 0.f, 0.f, 0.f};
        cur = nxt; cA = nA; cB = nB; ++ui;
        if constexpr (ALIGN_EPI) { if (wr == 1) PG8_BAR; }
    }
    PG8_WAIT_V(0);
    if constexpr (!ALIGN_EPI) { if (wr == 0) PG8_BAR; }
    PG8_BAR;
    if constexpr (Epi::AFTER_DRAIN) { E.fused(acc, cur, wr, wc, fr, fq, lds, wid, lane); S.done(cur); }
#undef PG8_SA
#undef PG8_SB
#undef PG8_STAGE
#undef PG8_LDA
#undef PG8_LDB
#undef PG8_MMA
#undef PG8_WAIT_V
#undef PG8_WAIT_L
#undef PG8_BAR
#undef PG8_SCHED
}
}

constexpr int NB = 8, SEQ = 2048, DM = 2048, M_TOK = NB * SEQ, DFF = 8192, NLAYER = 2;
constexpr int LDQ = 6656;
constexpr int C_QA = 0, C_KA = 512, C_VA = 1024, C_QB = 1536, C_KB = 2048, C_VB = 2560, C_QD = 3072, C_KD = 3584, C_VD = 4096,
              C_BG = 4608, C_CG = 5120, C_XIN = 5632, C_IQ = 6144, C_IK = 6400, C_IW = 6464, C_FD = 6468, C_END = 6472;
constexpr float LOG2E = 1.4426950408889634f;
constexpr float IDX_SCALE = 0.0625f;
constexpr float RMS_EPS = 1e-6f;

typedef unsigned short bf16_t;
typedef short bf16x8 __attribute__((ext_vector_type(8)));
typedef short s16x4 __attribute__((ext_vector_type(4)));
typedef float f32x16 __attribute__((ext_vector_type(16)));
typedef float f32x4 __attribute__((ext_vector_type(4)));
typedef float f32x2 __attribute__((ext_vector_type(2)));
typedef unsigned u32x4 __attribute__((ext_vector_type(4)));
typedef unsigned u32x2 __attribute__((ext_vector_type(2)));

DI float bf2f(bf16_t v) { return __uint_as_float((unsigned)v << 16); }
DI unsigned cvtpk(float lo, float hi) { unsigned r; asm volatile("v_cvt_pk_bf16_f32 %0, %1, %2" : "=v"(r) : "v"(lo), "v"(hi)); return r; }
DI float wave_sum(float v) {
#pragma unroll
    for (int o = 1; o < 64; o <<= 1) v += __shfl_xor(v, o);
    return v;
}

namespace att {
constexpr int SHM_V = 16384, SHM_K = 16384;
constexpr int OFF_V = 0, OFF_K = 2 * SHM_V, OFF_WS = OFF_K + 2 * SHM_K, OFF_TAB = OFF_WS + 8 * 64 * 4, OFF_FK = OFF_TAB + 512, LDS_END = OFF_FK + 8192;
#define KSWZ(row, colB) ((row) * 256 + ((colB) ^ (((row) & 7) << 4)))
#define SBAR() __builtin_amdgcn_sched_barrier(0)
DI int v_st(int k, int c) { const int kk = (k & ~0xC) | ((k & 4) << 1) | ((k & 8) >> 1); return ((kk >> 3) * 4 + (c >> 5)) * 512 + ((kk & 7) * 32 + (c & 31)) * 2; }
DI int v_rd_base(int lane) { return ((lane & 3) << 3) | (((lane >> 2) & 3) << 6) | (((lane >> 4) & 1) << 5) | (((lane >> 5) & 1) << 8); }
constexpr int v_rd_off(int d0, int ks, int half) { return d0 * 512 + ks * 4096 + half * 2048; }
DI int crow(int r, int hi) { return (r & 3) + 8 * (r >> 2) + 4 * hi; }

template <int KB, int D0LO, int D0HI>
DI void qkt(f32x16& p0, f32x16& p1, LAS const char* K_lds, int r32, int hi, const bf16x8* qr) {
#pragma unroll
    for (int r = 0; r < 16; ++r) { p0[r] = 0.f; p1[r] = 0.f; }
    LAS const char* kb[4];
#pragma unroll
    for (int dd = 0; dd < 4; ++dd) kb[dd] = K_lds + KB * SHM_K + KSWZ(r32, (dd * 16 + hi * 8) * 2);
#pragma unroll
    for (int d0 = D0LO; d0 < D0HI; ++d0) { LAS const char* a = kb[d0 & 3] + (d0 >> 2) * 128;
        const bf16x8 b0 = *(LAS const bf16x8*)a;
        const bf16x8 b1 = *(LAS const bf16x8*)(a + 32 * 256);
        p0 = __builtin_amdgcn_mfma_f32_32x32x16_bf16(b0, qr[d0 - D0LO], p0, 0, 0, 0);
        p1 = __builtin_amdgcn_mfma_f32_32x32x16_bf16(b1, qr[d0 - D0LO], p1, 0, 0, 0); }
}
template <int VB>
DI void pv_tile(f32x16* o, int vb0, bf16x8 pa0, bf16x8 pa1, bf16x8 pa2, bf16x8 pa3) {
#define TRRD(dst, off) asm volatile("ds_read_b64_tr_b16 %0, %1 offset:%2" : "=&v"(dst) : "v"(vb0), "i"(off) : "memory")
#define PV_D0(d0) do { s16x4 l0, l1, l2, l3, h0, h1, h2, h3; constexpr int b_ = VB * SHM_V + v_rd_off(d0, 0, 0);     \
        TRRD(l0, b_); TRRD(h0, b_ + 2048); TRRD(l1, b_ + 4096); TRRD(h1, b_ + 6144); TRRD(l2, b_ + 8192); TRRD(h2, b_ + 10240); TRRD(l3, b_ + 12288); TRRD(h3, b_ + 14336); \
        asm volatile("s_waitcnt lgkmcnt(0)" ::: "memory"); SBAR();   \
        o[d0] = __builtin_amdgcn_mfma_f32_32x32x16_bf16(pa0, (bf16x8){l0[0], l0[1], l0[2], l0[3], h0[0], h0[1], h0[2], h0[3]}, o[d0], 0, 0, 0);   \
        o[d0] = __builtin_amdgcn_mfma_f32_32x32x16_bf16(pa1, (bf16x8){l1[0], l1[1], l1[2], l1[3], h1[0], h1[1], h1[2], h1[3]}, o[d0], 0, 0, 0);   \
        o[d0] = __builtin_amdgcn_mfma_f32_32x32x16_bf16(pa2, (bf16x8){l2[0], l2[1], l2[2], l2[3], h2[0], h2[1], h2[2], h2[3]}, o[d0], 0, 0, 0);   \
        o[d0] = __builtin_amdgcn_mfma_f32_32x32x16_bf16(pa3, (bf16x8){l3[0], l3[1], l3[2], l3[3], h3[0], h3[1], h3[2], h3[3]}, o[d0], 0, 0, 0); } while (0)
    PV_D0(0); PV_D0(1); PV_D0(2); PV_D0(3);
#undef PV_D0
#undef TRRD
}
DI int t5_bucket(int n) {
    if (n < 16) return n;
    int b = 16;
    b += (n >= 19); b += (n >= 21); b += (n >= 24); b += (n >= 27); b += (n >= 31); b += (n >= 35); b += (n >= 40); b += (n >= 46);
    b += (n >= 52); b += (n >= 59); b += (n >= 67); b += (n >= 77); b += (n >= 87); b += (n >= 99); b += (n >= 113);
    return b;
}

struct UnitArgs {
    const bf16_t* Qp; const bf16_t* Kp; const bf16_t* Vp; bf16_t* Op; int q0;
    const unsigned long long* maskp;
    const float* fcum;
    const float* relb; int relcol;
    float lam, post;
    const float* gsub;
    float* stash;
};

template <int MODE>
DI void attn_unit(LAS char* lds, const UnitArgs& A) {
    int tid_l = threadIdx.x; asm volatile("" : "+v"(tid_l));
    const int tid = tid_l, wid = __builtin_amdgcn_readfirstlane(tid >> 6), lane = tid & 63, r32 = lane & 31, hi = lane >> 5;
    const int q0 = A.q0, NT = (q0 + 256) / 64;
    LAS char* V_lds = lds + OFF_V; LAS char* K_lds = lds + OFF_K;
    LAS float* wsf = (LAS float*)(lds + OFF_WS) + wid * 64; LAS float* li_l = wsf; LAS float* al_l = wsf + 32;
    LAS float* tab = (LAS float*)(lds + OFF_TAB); LAS float* fk = (LAS float*)(lds + OFF_FK);
    const int qlo = q0 + wid * 32, qpos = qlo + r32;
    const int sr = tid >> 4, sc = (tid & 15) * 8;
    const int vst0 = v_st(sr, sc), vst1 = v_st(32 + sr, sc), kws = KSWZ(sr, sc * 2);
    const int vb0 = (int)(unsigned)(uintptr_t)V_lds + v_rd_base(lane);
    if (MODE == 0 || MODE == 1) { if (tid < 128) { const int bk = t5_bucket(tid); tab[tid] = (A.relb[bk * 8 + A.relcol] - A.relb[31 * 8 + A.relcol]) * LOG2E; } }
    float fqv = 0.f;
    if (MODE == 2) { for (int i = tid; i < q0 + 256; i += 512) fk[i] = A.fcum[i]; fqv = A.fcum[qpos]; }
    constexpr int NPASS = (MODE == 1) ? 2 : 1, NQ = (MODE == 1) ? 4 : 8;
#pragma unroll 1
    for (int pass = 0; pass < NPASS; ++pass) {
        bf16x8 qr[NQ];
#pragma unroll
        for (int d = 0; d < NQ; ++d) qr[d] = *(const bf16x8*)(A.Qp + (size_t)(qpos) * LDQ + (MODE == 1 ? pass * 64 : 0) + d * 16 + hi * 8);
        bf16x8 st_k0, st_k1, st_v0, st_v1;
#define SLOAD(k0) do { st_v0 = *(const bf16x8*)(A.Vp + (size_t)((k0) + sr) * LDQ + sc); st_v1 = *(const bf16x8*)(A.Vp + (size_t)((k0) + 32 + sr) * LDQ + sc); \
                       st_k0 = *(const bf16x8*)(A.Kp + (size_t)((k0) + sr) * LDQ + sc); st_k1 = *(const bf16x8*)(A.Kp + (size_t)((k0) + 32 + sr) * LDQ + sc); } while (0)
#define SWRITE(bf) do { *(LAS bf16x8*)(V_lds + (bf) * SHM_V + vst0) = st_v0; *(LAS bf16x8*)(V_lds + (bf) * SHM_V + vst1) = st_v1; \
                        *(LAS bf16x8*)(K_lds + (bf) * SHM_K + kws) = st_k0; *(LAS bf16x8*)(K_lds + (bf) * SHM_K + kws + 32 * 256) = st_k1; } while (0)
        SLOAD(0); SWRITE(0);
        __syncthreads();
        float m_reg = -1e30f, l_reg = 0.f; f32x16 o[4];
#pragma unroll
        for (int d = 0; d < 4; ++d)
#pragma unroll
            for (int r = 0; r < 16; ++r) o[d][r] = 0.f;
        f32x16 p0, p1; bf16x8 pa0, pa1, pa2, pa3;
        unsigned long long mw_next = 0ull; if (MODE == 0) mw_next = A.maskp[(size_t)qpos * 32];
#define STEP(t, KB) do { const int t_ = (t); const bool more_ = (t_ + 1 < NT); const int kbase = t_ * 64; \
        const unsigned long long mw_ = mw_next; if (MODE == 0) { if (more_) mw_next = A.maskp[(size_t)qpos * 32 + t_ + 1]; } \
        if (more_) SLOAD(kbase + 64); \
        if (MODE == 1) { if (pass == 0) qkt<KB, 0, 4>(p0, p1, K_lds, r32, hi, qr); else qkt<KB, 4, 8>(p0, p1, K_lds, r32, hi, qr); } \
        else qkt<KB, 0, 8>(p0, p1, K_lds, r32, hi, qr); \
        if (MODE == 0 || MODE == 1) { if (kbase + 63 + 113 > qlo) { const int dq_ = qpos - kbase - 4 * hi; \
            _Pragma("unroll") for (int r = 0; r < 16; ++r) { const int c_ = (r & 3) + 8 * (r >> 2); int i0 = dq_ - c_, i1 = dq_ - c_ - 32; \
                i0 = i0 < 0 ? 0 : (i0 > 127 ? 127 : i0); i1 = i1 < 0 ? 0 : (i1 > 127 ? 127 : i1); p0[r] += tab[i0]; p1[r] += tab[i1]; } } } \
        if (MODE == 2) { _Pragma("unroll") for (int g = 0; g < 4; ++g) { const f32x4 f0 = *(LAS const f32x4*)(fk + kbase + 8 * g + 4 * hi), f1 = *(LAS const f32x4*)(fk + kbase + 32 + 8 * g + 4 * hi); \
                _Pragma("unroll") for (int j = 0; j < 4; ++j) { p0[4 * g + j] += fqv - f0[j]; p1[4 * g + j] += fqv - f1[j]; } } } \
        if (kbase + 63 > qlo) { const int dq_ = qpos - kbase - 4 * hi; const float NEG_ = -__builtin_inff(); \
            _Pragma("unroll") for (int r = 0; r < 16; ++r) { const int c_ = (r & 3) + 8 * (r >> 2); if (dq_ - c_ < 0) p0[r] = NEG_; if (dq_ - c_ - 32 < 0) p1[r] = NEG_; } } \
        if (MODE == 0) { const unsigned wl_ = (unsigned)mw_ >> (4 * hi), wh_ = (unsigned)(mw_ >> 32) >> (4 * hi); const float NEG_ = -__builtin_inff(); \
            _Pragma("unroll") for (int r = 0; r < 16; ++r) { const int c_ = (r & 3) + 8 * (r >> 2); if (!((wl_ >> c_) & 1u)) p0[r] = NEG_; if (!((wh_ >> c_) & 1u)) p1[r] = NEG_; } } \
        float pmax_ = p0[0]; _Pragma("unroll") for (int r = 1; r < 16; ++r) pmax_ = fmaxf(pmax_, p0[r]); _Pragma("unroll") for (int r = 0; r < 16; ++r) pmax_ = fmaxf(pmax_, p1[r]); \
        { auto rr = __builtin_amdgcn_permlane32_swap(__float_as_uint(pmax_), __float_as_uint(pmax_), false, false); pmax_ = fmaxf(__uint_as_float(rr[0]), __uint_as_float(rr[1])); } \
        float mn_ = m_reg, alpha_ = 1.f; \
        if (!__all(pmax_ - m_reg <= 8.f)) { mn_ = fmaxf(m_reg, pmax_); alpha_ = __builtin_amdgcn_exp2f(m_reg - mn_); m_reg = mn_; } \
        float ps_ = 0.f; \
        _Pragma("unroll") for (int r = 0; r < 16; ++r) { p0[r] = __builtin_amdgcn_exp2f(p0[r] - mn_); ps_ += p0[r]; } \
        _Pragma("unroll") for (int r = 0; r < 16; ++r) { p1[r] = __builtin_amdgcn_exp2f(p1[r] - mn_); ps_ += p1[r]; } \
        { auto rr = __builtin_amdgcn_permlane32_swap(__float_as_uint(ps_), __float_as_uint(ps_), false, false); ps_ = __uint_as_float(rr[0]) + __uint_as_float(rr[1]); } \
        l_reg = l_reg * alpha_ + ps_; \
        PK4(p0, 0, pa0); PK4(p0, 8, pa1); PK4(p1, 0, pa2); PK4(p1, 8, pa3); \
        if (__any(alpha_ < 1.f)) { if (hi == 0) al_l[r32] = alpha_; asm volatile("s_waitcnt lgkmcnt(0)" ::: "memory"); \
            _Pragma("unroll") for (int d_ = 0; d_ < 4; ++d_) _Pragma("unroll") for (int r = 0; r < 16; ++r) o[d_][r] *= al_l[crow(r, hi)]; } \
        SBAR(); pv_tile<KB>(o, vb0, pa0, pa1, pa2, pa3); \
        if (more_) { asm volatile("s_waitcnt vmcnt(0)" ::: "memory"); SWRITE((KB) ^ 1); } \
        __syncthreads(); } while (0)
#define PK4(P, B_, OUT) do { unsigned a0 = cvtpk(P[B_+0], P[B_+1]), a1 = cvtpk(P[B_+2], P[B_+3]);                          \
        unsigned b0 = cvtpk(P[B_+4], P[B_+5]), b1 = cvtpk(P[B_+6], P[B_+7]);                                             \
        auto r0 = __builtin_amdgcn_permlane32_swap(a0, b0, false, false); auto r1 = __builtin_amdgcn_permlane32_swap(a1, b1, false, false); \
        u32x4 w = {r0[0], r1[0], r0[1], r1[1]}; OUT = __builtin_bit_cast(bf16x8, w); } while (0)
#pragma unroll 1
        for (int t = 0; t < NT; t += 2) { STEP(t, 0); STEP(t + 1, 1); }
#undef STEP
#undef PK4
#undef SLOAD
#undef SWRITE
        if (hi == 0) li_l[r32] = l_reg; asm volatile("s_waitcnt lgkmcnt(0)" ::: "memory");
        float rli[16];
#pragma unroll
        for (int r = 0; r < 16; ++r) rli[r] = __builtin_amdgcn_rcpf(li_l[crow(r, hi)]);
        bf16_t* Ow = A.Op + (size_t)(qlo) * 2048; asm volatile("" : "+v"(Ow));
        if (MODE != 1) {
#pragma unroll
            for (int r = 0; r < 16; ++r) { const int orow = crow(r, hi);
#pragma unroll
                for (int d0 = 0; d0 < 4; ++d0) { const float v = o[d0][r] * rli[r]; const float vn = __shfl_xor(v, 1);
                    if ((r32 & 1) == 0) *(unsigned*)(Ow + (size_t)orow * 2048 + d0 * 32 + r32) = cvtpk(v, vn); } }
        } else if (pass == 0) {
#pragma unroll
            for (int d0 = 0; d0 < 4; ++d0)
#pragma unroll
                for (int r = 0; r < 16; r += 4) *(f32x4*)(A.stash + tid * 64 + d0 * 16 + r) = (f32x4){o[d0][r] * rli[r], o[d0][r + 1] * rli[r + 1], o[d0][r + 2] * rli[r + 2], o[d0][r + 3] * rli[r + 3]};
        } else {
            float ss[16];
#pragma unroll
            for (int d0 = 0; d0 < 4; ++d0)
#pragma unroll
                for (int r = 0; r < 16; r += 4) { const f32x4 sv = *(const f32x4*)(A.stash + tid * 64 + d0 * 16 + r);
#pragma unroll
                    for (int j = 0; j < 4; ++j) o[d0][r + j] = sv[j] - A.lam * (o[d0][r + j] * rli[r + j]); }
#pragma unroll
            for (int r = 0; r < 16; ++r) { float s = 0.f;
#pragma unroll
                for (int d0 = 0; d0 < 4; ++d0) { const float v = o[d0][r]; s += v * v; }
                s += __shfl_xor(s, 1); s += __shfl_xor(s, 2); s += __shfl_xor(s, 4); s += __shfl_xor(s, 8); s += __shfl_xor(s, 16);
                ss[r] = __builtin_amdgcn_rsqf(s * (1.f / 128.f) + RMS_EPS) * A.post;
                if ((r & 3) == 3) asm volatile("" ::: "memory"); }
#pragma unroll
            for (int d0 = 0; d0 < 4; ++d0) { const float gs = A.gsub[d0 * 32 + r32];
#pragma unroll
                for (int r = 0; r < 16; ++r) { const int orow = crow(r, hi); const float v = o[d0][r] * ss[r] * gs; const float vn = __shfl_xor(v, 1);
                    if ((r32 & 1) == 0) *(unsigned*)(Ow + (size_t)orow * 2048 + d0 * 32 + r32) = cvtpk(v, vn); } }
        }
        __syncthreads();
    }
}
#undef SBAR
}

#define XB_TMO      128
#define XB_XCNT(j)  (256  + 64 * (j))
#define XB_XSUB(j)  (1280 + 64 * (j))
#define XB_XGEN(j)  (2304 + 64 * (j))
#define XB_TOP      3328
#define XB_TOPGEN   3392
#define XCD_BAR_WORDS 3456
#define XB_SPIN_CAP (1u << 20)

__device__ __forceinline__ unsigned xb_ld(unsigned* p)              { return __hip_atomic_load(p, __ATOMIC_RELAXED, __HIP_MEMORY_SCOPE_AGENT); }
__device__ __forceinline__ unsigned xb_add(unsigned* p, unsigned v) { return __hip_atomic_fetch_add(p, v, __ATOMIC_RELAXED, __HIP_MEMORY_SCOPE_AGENT); }
__device__ __forceinline__ unsigned xb_xcc_id() { return (unsigned)__builtin_amdgcn_s_getreg((3 << 11) | 20) & 0xFu; }
#define XB_SPIN(cond, bar) do { unsigned _sp = 0; while (cond) { __builtin_amdgcn_s_sleep(1); \
    if ((++_sp & 255u) == 0u) { if (xb_ld(&(bar)[XB_TMO])) break; if (_sp > XB_SPIN_CAP) { atomicAdd(&(bar)[XB_TMO], 1u); break; } } } } while (0)

struct XcdBarrier {
    unsigned* bar; unsigned x;
    volatile LAS unsigned* st;
};

__device__ __forceinline__ XcdBarrier xcd_barrier_post(unsigned* bar, volatile LAS unsigned* st) {
    XcdBarrier b; b.bar = bar; b.x = xb_xcc_id(); b.st = st;
    if (threadIdx.x == 0) (void)xb_add(&bar[XB_XCNT(b.x)], 1u);
    return b;
}
__device__ __forceinline__ void xcd_barrier_complete(unsigned* bar, unsigned x, unsigned& nloc, unsigned& nx) {
    const unsigned G = gridDim.x * gridDim.y * gridDim.z;
    unsigned sum, cnt, mine, sp = 0u;
    for (;;) {
        sum = 0u; cnt = 0u; mine = 0u;
#pragma unroll
        for (unsigned j = 0; j < 16; ++j) { const unsigned c = xb_ld(&bar[XB_XCNT(j)]); sum += c; cnt += (c > 0u) ? 1u : 0u; mine = (j == x) ? c : mine; }
        if (sum == G) break;
        __builtin_amdgcn_s_sleep(1);
        if ((++sp & 255u) == 0u) { if (xb_ld(&bar[XB_TMO])) break; if (sp > XB_SPIN_CAP) { atomicAdd(&bar[XB_TMO], 1u); break; } }
    }
    nloc = mine > 0u ? mine : 1u; nx = cnt > 0u ? cnt : 1u;
}

__device__ __forceinline__ void xcd_barrier(const XcdBarrier& b) {
    asm volatile("s_waitcnt vmcnt(0)" ::: "memory");
    __syncthreads();
    if (threadIdx.x == 0) {
        unsigned* bar = b.bar; asm volatile("" : "+s"(bar));
        __builtin_amdgcn_s_waitcnt(0);
        unsigned nloc = b.st[0], nx = b.st[1];
        if (nloc == 0u) { xcd_barrier_complete(bar, b.x, nloc, nx); b.st[0] = nloc; b.st[1] = nx; }
        const unsigned old = xb_add(&bar[XB_XSUB(b.x)], 1u);
        const unsigned gen = old / nloc;
        if (old + 1u == (gen + 1u) * nloc) {
            __builtin_amdgcn_fence(__ATOMIC_RELEASE, "agent");
            asm volatile("s_waitcnt vmcnt(0)" ::: "memory");
            const unsigned og = xb_add(&bar[XB_TOP], 1u);
            const unsigned tg = og / nx;
            if (og + 1u == (tg + 1u) * nx) xb_add(&bar[XB_TOPGEN], 1u);
            else XB_SPIN(xb_ld(&bar[XB_TOPGEN]) == tg, bar);
            __builtin_amdgcn_fence(__ATOMIC_ACQUIRE, "agent");
            xb_add(&bar[XB_XGEN(b.x)], 1u);
            asm volatile("s_waitcnt vmcnt(0)" ::: "memory");
        } else {
            XB_SPIN(xb_ld(&bar[XB_XGEN(b.x)]) == gen, bar);
            __builtin_amdgcn_fence(__ATOMIC_ACQUIRE, "agent");
            asm volatile("s_waitcnt vmcnt(0)" ::: "memory");
        }
    }
    __syncthreads();
}
#define RLX_AGENT __ATOMIC_RELAXED, __HIP_MEMORY_SCOPE_AGENT
#define LDS_WAIT() asm volatile("s_waitcnt lgkmcnt(0)" ::: "memory")
DI unsigned f2bf(float f) { unsigned u = __builtin_bit_cast(unsigned, f); return (u + 0x7fffu + ((u >> 16) & 1u)) >> 16; }
DI unsigned pk2(float lo, float hi) { return f2bf(lo) | (f2bf(hi) << 16); }

struct MapPlain { DI int src(int n) const { return n; } DI float scale(int) const { return 1.f; } };
struct MapWin {
    DI int src(int n) const {
        if (n < 1536) return n;
        if (n < 3072) return 1860 + (n - 1536);
        if (n < 4608) return 4932 + (n - 3072);
        if (n < 6144) return 3396 + (n - 4608);
        if (n < 6400) return 1536 + (n - 6144);
        if (n < 6464) return 1792 + (n - 6400);
        if (n < 6468) return 1856 + (n - 6464);
        if (n < 6472) return 6468 + (n - 6468);
        return -1;
    }
    DI float scale(int n) const {
        if (n < 512) return 0.08838834764831845f * LOG2E;
        if (n >= 1536 && n < 2048) return 0.125f * LOG2E;
        if (n >= 3072 && n < 3584) return 0.08838834764831845f * LOG2E;
        return 1.f;
    }
};
struct MapGate {
    DI int src(int n) const { const int pn = n >> 8, c = n & 255; const int g = 2 * (c >> 7) + ((c >> 4) & 1), dl = 16 * ((c >> 5) & 3) + (c & 15); return g * 2048 + 64 * pn + dl; }
    DI float scale(int) const { return 1.f; }
};
template <class Map>
DI void transpose_item(const float* W, int K, int Nsrc, int nblk  , bf16_t* WT, const Map& map, LAS float* scr, int item, int lane) {
    const int kb = item / nblk, nb = item % nblk, k0 = 64 * kb, n0 = 32 * nb;
    const int nd = n0 + (lane & 31); const int s = map.src(nd); const float scl = map.scale(nd);
#pragma unroll 8
    for (int i = 0; i < 32; ++i) { const int kk = 2 * i + (lane >> 5); scr[kk * 33 + (lane & 31)] = (s >= 0) ? W[(size_t)(k0 + kk) * Nsrc + s] * scl : 0.f; }
    LDS_WAIT(); asm volatile("" ::: "memory");
    const int c = lane & 7;
#pragma unroll
    for (int j = 0; j < 4; ++j) { const int n = (lane >> 3) + 8 * j; const LAS float* sp = scr + (8 * c) * 33 + n;
        u32x4 o; o.x = pk2(sp[0 * 33], sp[1 * 33]); o.y = pk2(sp[2 * 33], sp[3 * 33]); o.z = pk2(sp[4 * 33], sp[5 * 33]); o.w = pk2(sp[6 * 33], sp[7 * 33]);
        *(u32x4*)(WT + (size_t)(n0 + n) * K + k0 + 8 * c) = o; }
    LDS_WAIT(); asm volatile("" ::: "memory");
}
constexpr float WG8_SCALE = 64.f;
template <class Map>
DI void transpose_item8(const float* W, int K, int Nsrc, int nblk, unsigned char* WT, const Map& map, LAS float* scr, int item, int lane) {
    const int kb = item / nblk, nb = item % nblk, k0 = 64 * kb, n0 = 32 * nb;
    const int nd = n0 + (lane & 31); const int s = map.src(nd); const float scl = map.scale(nd) * WG8_SCALE;
#pragma unroll 8
    for (int i = 0; i < 32; ++i) { const int kk = 2 * i + (lane >> 5); scr[kk * 33 + (lane & 31)] = (s >= 0) ? W[(size_t)(k0 + kk) * Nsrc + s] * scl : 0.f; }
    LDS_WAIT(); asm volatile("" ::: "memory");
#pragma unroll
    for (int j = 0; j < 2; ++j) { const int q = lane + 64 * j, n = q >> 2, c = q & 3; const LAS float* sp = scr + (16 * c) * 33 + n;
        int o[4];
#pragma unroll
        for (int e = 0; e < 4; ++e) { int w = 0; w = __builtin_amdgcn_cvt_pk_fp8_f32(sp[(4 * e + 0) * 33], sp[(4 * e + 1) * 33], w, false); w = __builtin_amdgcn_cvt_pk_fp8_f32(sp[(4 * e + 2) * 33], sp[(4 * e + 3) * 33], w, true); o[e] = w; }
        *(u32x4*)(WT + (size_t)(n0 + n) * K + k0 + 16 * c) = (u32x4){(unsigned)o[0], (unsigned)o[1], (unsigned)o[2], (unsigned)o[3]}; }
    LDS_WAIT(); asm volatile("" ::: "memory");
}
DI void mod_partial_item(const float* c, const float* wada, float* modp, int item, int lane) {
    const int kc = item & 15, nb = (item >> 4) % 48, l = item / (16 * 48);
    const int k0 = kc * 128, n0 = nb * 256 + 4 * lane;
    const float* Wl = wada + (size_t)l * 2048 * 12288;
    f32x4 acc[8];
#pragma unroll
    for (int b = 0; b < 8; ++b) acc[b] = (f32x4){0.f, 0.f, 0.f, 0.f};
#pragma unroll 1
    for (int sub = 0; sub < 2; ++sub) {
        float cb[8];
#pragma unroll
        for (int b = 0; b < 8; ++b) { const float x = c[b * 2048 + k0 + 64 * sub + lane]; cb[b] = x / (1.f + __expf(-x)); }
#pragma unroll 8
        for (int kk = 0; kk < 64; ++kk) { const f32x4 w = *(const f32x4*)(Wl + (size_t)(k0 + 64 * sub + kk) * 12288 + n0);
#pragma unroll
            for (int b = 0; b < 8; ++b) { const float s = __builtin_bit_cast(float, __builtin_amdgcn_readlane(__builtin_bit_cast(int, cb[b]), kk)); acc[b] += s * w; } }
    }
#pragma unroll
    for (int b = 0; b < 8; ++b) *(f32x4*)(modp + ((size_t)(kc * 2 + l) * 8 + b) * 12288 + n0) = acc[b];
}
template <bool F8>
DI void norm_row(const float* xrow, bf16_t* orow, unsigned char* orow8, const f32x4 (&Av)[8], const f32x4 (&Bv)[8], int lane) {
    const f32x4* xr = (const f32x4*)xrow + lane;
    f32x4 v[8]; float s = 0.f;
#pragma unroll
    for (int j = 0; j < 8; ++j) { v[j] = xr[64 * j]; s += (v[j][0] * v[j][0] + v[j][1] * v[j][1]) + (v[j][2] * v[j][2] + v[j][3] * v[j][3]); }
    const float rstd = 1.f / sqrtf(wave_sum(s) * (1.f / 2048.f) + RMS_EPS);
    u32x2* o8 = (u32x2*)orow + lane;
#pragma unroll
    for (int j = 0; j < 8; ++j) { const f32x4 h = v[j] * rstd * Av[j] + Bv[j]; u32x2 w; w.x = cvtpk(h[0], h[1]); w.y = cvtpk(h[2], h[3]); o8[64 * j] = w;
        if (F8) { int q = 0; q = __builtin_amdgcn_cvt_pk_fp8_f32(h[0], h[1], q, false); q = __builtin_amdgcn_cvt_pk_fp8_f32(h[2], h[3], q, true); ((int*)orow8)[lane + 64 * j] = q; } }
}
DI void final_row(float* xrow, const f32x4 (&Gv)[8], int lane) {
    f32x4* xr = (f32x4*)xrow + lane;
    f32x4 v[8]; float s = 0.f;
#pragma unroll
    for (int j = 0; j < 8; ++j) { v[j] = xr[64 * j]; s += (v[j][0] * v[j][0] + v[j][1] * v[j][1]) + (v[j][2] * v[j][2] + v[j][3] * v[j][3]); }
    const float rstd = 1.f / sqrtf(wave_sum(s) * (1.f / 2048.f) + RMS_EPS);
#pragma unroll
    for (int j = 0; j < 8; ++j) xr[64 * j] = v[j] * rstd * Gv[j];
}
DI void conv_task(const bf16_t* qkv, const float* cw, bf16_t* br, int row0, int lane) {
    const int ch = lane * 8;
    float w0[8], w1[8], w2[8];
#pragma unroll
    for (int j = 0; j < 8; ++j) { w0[j] = cw[ch + j]; w1[j] = cw[512 + ch + j]; w2[j] = cw[1024 + ch + j]; }
    float up2[8], up1[8];
    const bf16_t* rp = qkv + (size_t)row0 * LDQ + ch;
    auto load_u = [&](const bf16_t* r, float (&u)[8]) {
        const bf16x8 cg = *(const bf16x8*)(r + C_CG), xi = *(const bf16x8*)(r + C_XIN);
#pragma unroll
        for (int j = 0; j < 8; ++j) u[j] = bf2f((bf16_t)cg[j]) * bf2f((bf16_t)xi[j]);
    };
    if ((row0 & (SEQ - 1)) == 0) {
#pragma unroll
        for (int j = 0; j < 8; ++j) { up2[j] = 0.f; up1[j] = 0.f; }
    } else { load_u(rp - 2 * LDQ, up2); load_u(rp - LDQ, up1); }
    bf16_t* op = br + (size_t)row0 * 2048 + 1024 + ch;
#pragma unroll
    for (int i = 0; i < 8; ++i) { float u[8]; load_u(rp, u);
        const bf16x8 bg = *(const bf16x8*)(rp + C_BG);
        rp += LDQ; asm volatile("" : "+v"(rp));
        float y[8];
#pragma unroll
        for (int j = 0; j < 8; ++j) y[j] = bf2f((bf16_t)bg[j]) * (w0[j] * up2[j] + w1[j] * up1[j] + w2[j] * u[j]);
        u32x4 o; o.x = cvtpk(y[0], y[1]); o.y = cvtpk(y[2], y[3]); o.z = cvtpk(y[4], y[5]); o.w = cvtpk(y[6], y[7]);
        *(u32x4*)op = o; op += 2048; asm volatile("" : "+v"(op));
#pragma unroll
        for (int j = 0; j < 8; ++j) { up2[j] = up1[j]; up1[j] = u[j]; } }
}
DI void fcum_task(const bf16_t* qkvb  , float bf_h, int h, float* out  , int lane) {
    const bf16_t* p0 = qkvb + (size_t)(32 * lane) * LDQ + C_FD + h;
    float run = 0.f;
    { const bf16_t* p = p0;
#pragma unroll 1
      for (int i = 0; i < 32; ++i) { const float x = bf2f(*p) + bf_h; p += LDQ; run += fminf(x, 0.f) - log1pf(expf(-fabsf(x))); } }
    float incl = run;
#pragma unroll
    for (int o = 1; o < 64; o <<= 1) { const float y = __shfl_up(incl, o); if (lane >= o) incl += y; }
    float acc = incl - run;
    { const bf16_t* p = p0; float* op = out + 32 * lane;
#pragma unroll 1
      for (int i = 0; i < 32; ++i) { const float x = bf2f(*p) + bf_h; p += LDQ; acc += fminf(x, 0.f) - log1pf(expf(-fabsf(x))); op[i] = acc * LOG2E; } }
}
DI int rowsum16(int x) { x += __shfl_xor(x, 8); x += __shfl_xor(x, 4); x += __shfl_xor(x, 2); x += __shfl_xor(x, 1); return x; }
DI void select_task(const bf16_t* qkvb  , unsigned long long* mrow  , int t0, LAS unsigned long long* wl, int lane_in) {
    int lane = lane_in; asm volatile("" : "+v"(lane));
    const int fr = lane & 15, fq = lane >> 4, t = t0 + fq;
    const int nch = __builtin_amdgcn_readfirstlane((t0 + 3) / 512 + 1);
    const bf16_t* ap = qkvb + (size_t)(t0 + (fr >> 2)) * LDQ + C_IQ + (fr & 3) * 64 + fq * 8;
    const bf16x8 a0 = *(const bf16x8*)ap, a1 = *(const bf16x8*)(ap + 32);
    float w[4]; { const u32x2 ww = *(const u32x2*)(qkvb + (size_t)t * LDQ + C_IW);
        w[0] = __uint_as_float(ww.x << 16) * IDX_SCALE; w[1] = __uint_as_float(ww.x & 0xffff0000u) * IDX_SCALE; w[2] = __uint_as_float(ww.y << 16) * IDX_SCALE; w[3] = __uint_as_float(ww.y & 0xffff0000u) * IDX_SCALE; }
    unsigned u[128];
    const int tf = t - fr;
    const char* kbase = (const char*)qkvb + C_IK * 2;
    unsigned voff = (unsigned)(fr * LDQ + fq * 8) * 2u;
#pragma unroll
    for (int c = 0; c < 4; ++c) {
        if (c < nch) {
#pragma unroll
            for (int ii = 0; ii < 32; ++ii) { const int i = c * 32 + ii;
                const bf16x8 b0 = *(const bf16x8*)(kbase + voff), b1 = *(const bf16x8*)(kbase + voff + 64);
                voff += 16 * LDQ * 2; asm volatile("" : "+v"(voff));
                f32x4 acc = (f32x4){0.f, 0.f, 0.f, 0.f};
                acc = __builtin_amdgcn_mfma_f32_16x16x32_bf16(a0, b0, acc, 0, 0, 0);
                acc = __builtin_amdgcn_mfma_f32_16x16x32_bf16(a1, b1, acc, 0, 0, 0);
                const float sc = ((w[0] * fmaxf(acc[0], 0.f) + w[1] * fmaxf(acc[1], 0.f)) + w[2] * fmaxf(acc[2], 0.f)) + w[3] * fmaxf(acc[3], 0.f);
                unsigned bits = __float_as_uint(sc); if (bits == 0x80000000u) bits = 0u;
                const unsigned key = (bits & 0x80000000u) ? ~bits : (bits | 0x80000000u);
                u[i] = (16 * i <= tf) ? key : 0u; }
        } else {
#pragma unroll
            for (int ii = 0; ii < 32; ++ii) u[c * 32 + ii] = 0u;
        }
    }
#define CNT_GE(cnt, x, c) asm("v_cmp_ge_u32 vcc, %1, %2\n\tv_addc_co_u32 %0, vcc, 0, %0, vcc" : "+v"(cnt) : "v"(x), "v"(c) : "vcc")
#define CNT_GT(cnt, x, c) asm("v_cmp_gt_u32 vcc, %1, %2\n\tv_addc_co_u32 %0, vcc, 0, %0, vcc" : "+v"(cnt) : "v"(x), "v"(c) : "vcc")
#define FOR_CHUNKS(BODY) _Pragma("unroll") for (int c_ = 0; c_ < 4; ++c_) { if (c_ < nch) { _Pragma("unroll") for (int ii_ = 0; ii_ < 32; ++ii_) { const int i = c_ * 32 + ii_; BODY; } } }
    unsigned T = 0u;
#pragma unroll 1
    for (int bit = 31; bit >= 0; --bit) { const unsigned c = T | (1u << bit); int cnt = 0;
        FOR_CHUNKS(CNT_GE(cnt, u[i], c));
        cnt = rowsum16(cnt); if (cnt >= 256) T = c; }
    int cgt = 0, cge = 0;
    FOR_CHUNKS(CNT_GT(cgt, u[i], T); CNT_GE(cge, u[i], T));
    cgt = rowsum16(cgt); cge = rowsum16(cge);
    const int need = 256 - cgt; const bool tie = (cge - cgt) > need;
    int X0 = 4095;
    if (__any(tie)) { int x = 0; const unsigned notT = ~T;
#pragma unroll 1
        for (int bit = 10; bit >= 0; --bit) { const int c = x | (1 << bit); int g = 0; const int cf = c - fr;
            FOR_CHUNKS(unsigned tmp;
                asm("v_cmp_lt_i32 vcc, %6, %3\n\tv_cndmask_b32 %1, %4, %2, vcc\n\tv_cmp_eq_u32 vcc, %1, %5\n\tv_addc_co_u32 %0, vcc, 0, %0, vcc"
                    : "+v"(g), "=&v"(tmp) : "v"(u[i]), "v"(cf), "v"(notT), "v"(T), "n"(16 * i) : "vcc"));
            g = rowsum16(g); if (g < need) x = c; }
        if (tie) X0 = x; }
#undef CNT_GE
#undef CNT_GT
    const int xf = X0 - fr;
    FOR_CHUNKS(const bool sel = (u[i] > T) || (u[i] == T && 16 * i <= xf);
        const unsigned long long bal = __ballot(sel); if (lane == 0) wl[i] = bal;
        if ((i & 3) == 3) asm volatile("" ::: "memory"));
#undef FOR_CHUNKS
    LDS_WAIT(); asm volatile("" ::: "memory");
#pragma unroll
    for (int half = 0; half < 2; ++half) { const int j = fr + 16 * half; unsigned long long word = 0ull;
        if (j < nch * 8) {
#pragma unroll
            for (int i4 = 0; i4 < 4; ++i4) word |= ((wl[4 * j + i4] >> (16 * fq)) & 0xFFFFull) << (16 * i4); }
        mrow[(size_t)t * 32 + j] = word; }
    LDS_WAIT(); asm volatile("" ::: "memory");
}
DI void select_causal_task(unsigned long long* mrow, int t0, int lane) {
    const int fr = lane & 15, fq = lane >> 4, t = t0 + fq;
#pragma unroll
    for (int half = 0; half < 2; ++half) { const int j = fr + 16 * half; const int n = t - 64 * j + 1;
        const unsigned long long word = n >= 64 ? ~0ull : (n <= 0 ? 0ull : ((1ull << n) - 1ull));
        mrow[(size_t)t * 32 + j] = word; }
}
DI void select_any(const bf16_t* qkvb, unsigned long long* mrow, int t0, LAS unsigned long long* wl, int lane) {
    if (t0 + 3 < 256) select_causal_task(mrow, t0, lane);
    else select_task(qkvb, mrow, t0, wl, lane);
}

constexpr size_t MiB = 1u << 20;
constexpr size_t WS_CTL = 0, CTL_ZERO_BYTES = 1 * MiB;
constexpr size_t WS_MODF = 1 * MiB;
constexpr size_t WS_MODP = 2 * MiB;
constexpr size_t WS_FCUM = 14 * MiB;
constexpr size_t WS_MASK = 15 * MiB;
constexpr size_t WS_STASH = 20 * MiB;
constexpr size_t WS_W = 52 * MiB;
constexpr size_t OW_IN = 0, OW_G = 26 * MiB, OW_B = 58 * MiB, OW_O = 66 * MiB, OW_1 = 74 * MiB, OW_2 = 106 * MiB, LW_BYTES = 138 * MiB;
constexpr size_t WS_H = WS_W + 2 * LW_BYTES;
constexpr size_t WS_BR = WS_H + 64 * MiB;
constexpr size_t WS_R1 = WS_BR + 64 * MiB;
constexpr size_t WS_H8 = WS_R1 + 256 * MiB;
constexpr size_t WS_END = WS_H8 + 32 * MiB;
constexpr int CW_BAR = 4096;
constexpr int CW_QUEUE = 16384;

constexpr int RING_OFF = 0, RING_BYTES = 131072;
constexpr int LDSCTL_OFF = RING_BYTES, MISC_OFF = LDSCTL_OFF + 320;
constexpr int LDS_BYTES = 147456;
static_assert(att::LDS_END <= RING_BYTES, "attention scratch inside the ring region");


constexpr int NWAVES = 8;
constexpr int N_PHASES = 23;
struct Args { const float* in[19]; float* out; unsigned char* ws; int ph_lo, ph_hi; };

typedef __attribute__((address_space(4))) const unsigned char* kargp_t;
DI kargp_t karg_base() { kargp_t kp = (kargp_t)__builtin_amdgcn_kernarg_segment_ptr(); asm volatile("" : "+s"(kp)); return kp; }
typedef const float* cfptr_t; typedef float* fptr_t; typedef unsigned char* ucptr_t;
DI const float* karg_in(int i) { return *(const __attribute__((address_space(4))) cfptr_t*)(karg_base() + 8 * i); }
DI float* karg_out() { return *(const __attribute__((address_space(4))) fptr_t*)(karg_base() + 8 * 19); }
DI unsigned char* karg_ws() { return *(const __attribute__((address_space(4))) ucptr_t*)(karg_base() + 8 * 20); }
#define ARG_IN(i) karg_in(i)

template <int MODE>
DI void attn_queue(LAS unsigned char* lds, volatile LAS unsigned* MISC, int qidx, int l, int tid, int lane) {
    unsigned char* ws = karg_ws();
    unsigned* qhead = (unsigned*)(ws + WS_CTL) + CW_QUEUE + 64 * qidx;
    bf16_t* QKV = (bf16_t*)(ws + WS_R1); bf16_t* BR = (bf16_t*)(ws + WS_BR);
    float lamv = 0.f, post = 0.f;
    if (MODE == 1) { const float* lq = ARG_IN(8) + l * 256; const float a = wave_sum(lq[lane] * lq[64 + lane]), b = wave_sum(lq[128 + lane] * lq[192 + lane]);
        const float lam_init = 0.8f - 0.6f * expf(-0.3f * (float)l); lamv = expf(a) - expf(b) + lam_init; post = 1.f - lam_init; }
    for (;;) {
        if (tid == 0) MISC[0] = __hip_atomic_fetch_add(qhead, 1u, RLX_AGENT);
        __syncthreads();
        const unsigned u = MISC[0];
        __syncthreads();
        if (u >= 256u) break;
        const int qb = 7 - (int)(u >> 5), bh = (int)(u & 31u), b = bh >> 2, h = bh & 3;
        att::UnitArgs A;
        const size_t rowb = (size_t)b * SEQ;
        const int cq = MODE == 0 ? C_QA : (MODE == 1 ? C_QB : C_QD), ck = MODE == 0 ? C_KA : (MODE == 1 ? C_KB : C_KD), cv = MODE == 0 ? C_VA : (MODE == 1 ? C_VB : C_VD);
        const int oc = MODE == 0 ? 0 : (MODE == 1 ? 512 : 1536);
        A.Qp = QKV + rowb * LDQ + cq + h * 128; A.Kp = QKV + rowb * LDQ + ck + h * 128; A.Vp = QKV + rowb * LDQ + cv + h * 128;
        A.Op = BR + rowb * 2048 + oc + h * 128; A.q0 = qb * 256;
        A.maskp = (const unsigned long long*)(ws + WS_MASK) + rowb * 32;
        A.fcum = (const float*)(ws + WS_FCUM) + (size_t)(b * 4 + h) * SEQ;
        A.relb = ARG_IN(10); A.relcol = (MODE == 1 ? 4 : 0) + h;
        A.lam = lamv; A.post = post; A.gsub = ARG_IN(9) + l * 128;
        A.stash = (float*)(ws + WS_STASH) + (size_t)blockIdx.x * 64 * 512;
        att::attn_unit<MODE>((LAS char*)lds, A);
    }
}

#define IN(k) (lo <= (k) && (k) < hi)
#define SEAM(k) do { if (IN((k) + 1)) xcd_barrier(bar); } while (0)
#define PH_PTRS int tid_p = threadIdx.x; asm volatile("" : "+v"(tid_p)); const int tid = tid_p, lane = tid & 63; (void)lane; unsigned char* ws = karg_ws(); float* xbuf = karg_out(); float* modf = (float*)(ws + WS_MODF); float* modp = (float*)(ws + WS_MODP); \
    bf16_t* Hb = (bf16_t*)(ws + WS_H); bf16_t* BR = (bf16_t*)(ws + WS_BR); bf16_t* R1 = (bf16_t*)(ws + WS_R1); \
    (void)xbuf; (void)modf; (void)modp; (void)Hb; (void)BR; (void)R1
#define PH_LAYER PH_PTRS; unsigned char* wl_ = ws + WS_W + (size_t)l * LW_BYTES; const float* modl = modf + (size_t)l * 8 * 12288; (void)wl_; (void)modl
template <int l, int LO, int HI>
DI void layer_phases(LAS unsigned char* lds, volatile LAS unsigned* MISC, const XcdBarrier& bar, int wave, int G, int bx, int gw, int NGW) {
    constexpr int lo = LO, hi = HI;
        const int pb = 2 + 10 * l;
        if (IN(pb + 0)) { PH_LAYER;
            const float* xs = (l == 0) ? ARG_IN(0) : (const float*)xbuf; const float* g1 = ARG_IN(4) + l * 2048;
#ifndef PROBE_REP_N1
#define PROBE_REP_N1 1
#endif
#pragma unroll 1
          for (int rep = 0; rep < PROBE_REP_N1; ++rep)
            for (int rb = gw; rb < M_TOK / 8; rb += NGW) { const int b = (rb * 8) / SEQ; f32x4 Av[8], Bv[8];
#pragma unroll
                for (int j = 0; j < 8; ++j) { const int c = 4 * lane + 256 * j; const f32x4 g = *(const f32x4*)(g1 + c), sc = *(const f32x4*)(modl + b * 12288 + 2048 + c); Av[j] = g * (sc + 1.f); Bv[j] = *(const f32x4*)(modl + b * 12288 + c); }
#pragma unroll 1
                for (int i = 0; i < 8; ++i) norm_row<true>(xs + (size_t)(rb * 8 + i) * 2048, Hb + (size_t)(rb * 8 + i) * 2048, ws + WS_H8 + (size_t)(rb * 8 + i) * 2048, Av, Bv, lane); }
            SEAM(pb + 0);
        }
        if (IN(pb + 1)) { PH_LAYER;
            pg8::Gemm g{Hb, (const bf16_t*)(wl_ + OW_IN), M_TOK, LDQ, 2048, 2048, 2048, 1 << 30, 0}; pg8::StaticOrder S; S.init(M_TOK, LDQ, G, bx);
            pg8::EpiBf16<0> E{R1, LDQ};

#ifndef NO_G1
#ifndef PROBE_REP_G1
#define PROBE_REP_G1 1
#endif
#pragma unroll 1
            for (int rep = 0; rep < PROBE_REP_G1; ++rep)
            pg8::gemm_phase<pg8::EpiBf16<0>, pg8::StaticOrder, true, true>(lds + RING_OFF, g, S, E);
#endif
            SEAM(pb + 1);
        }
        if (IN(pb + 2)) { PH_LAYER;
            LAS unsigned long long* wlq = (LAS unsigned long long*)(lds + RING_OFF) + wave * 128;
            unsigned long long* mask = (unsigned long long*)(ws + WS_MASK);
#ifndef PROBE_REP_M1
#define PROBE_REP_M1 1
#endif
#pragma unroll 1
          for (int rep = 0; rep < PROBE_REP_M1; ++rep)
            for (int k = gw; k < 2048; k += NGW) {
#pragma unroll 1
                for (int pass = 0; pass < 2; ++pass) { const int kk = pass ? 4095 - k : k; const int b = kk & 7, t0 = (kk >> 3) * 4;
#ifndef NO_SELECT
                    select_any(R1 + (size_t)b * SEQ * LDQ, mask + (size_t)b * SEQ * 32, t0, wlq, lane);
#endif
                } }
#ifndef NO_CONV
            for (int rb = gw; rb < M_TOK / 8; rb += NGW) conv_task(R1, ARG_IN(7) + l * 1536, BR, rb * 8, lane);
#endif
#ifndef NO_FCUM
            for (int k = gw; k < 32; k += NGW) { const int b = k >> 2, h = k & 3; fcum_task(R1 + (size_t)b * SEQ * LDQ, ARG_IN(6)[l * 4 + h], h, (float*)(ws + WS_FCUM) + (size_t)k * SEQ, lane); }
#endif
            SEAM(pb + 2);
        }
        if (IN(pb + 3)) { PH_LAYER;
#ifndef PROBE_REP_M2
#define PROBE_REP_M2 1
#endif
#pragma unroll 1
          for (int rep = 0; rep < PROBE_REP_M2; ++rep) {
            if (rep) xcd_barrier(bar);
            attn_queue<1>(lds + RING_OFF, MISC, 3 * l + 0 + 6 * rep, l, tid, lane);
            attn_queue<0>(lds + RING_OFF, MISC, 3 * l + 1 + 6 * rep, l, tid, lane);
            attn_queue<2>(lds + RING_OFF, MISC, 3 * l + 2 + 6 * rep, l, tid, lane);
          }
            SEAM(pb + 3);
        }
        if (IN(pb + 4)) { PH_LAYER;
            pg8::Gemm g{BR, (const bf16_t*)(wl_ + OW_B), M_TOK, 8192, 512, 2048, 512, 8, 512}; pg8::StaticOrder S; S.init(M_TOK, 8192, G, bx);
            pg8::EpiBf16<0> E{R1, 8192};

#ifndef NO_G2
#ifndef PROBE_REP_G2
#define PROBE_REP_G2 1
#endif
#pragma unroll 1
            for (int rep = 0; rep < PROBE_REP_G2; ++rep)
            pg8::gemm_phase<pg8::EpiBf16<0>, pg8::StaticOrder, true, true>(lds + RING_OFF, g, S, E);
#endif
            SEAM(pb + 4);
        }
        if (IN(pb + 5)) { PH_LAYER;
            pg8::Gemm g{(const bf16_t*)(ws + WS_H8), (const bf16_t*)(wl_ + OW_G), M_TOK, 8192, 1024, 1024, 1024, 1 << 30, 0}; pg8::StaticOrder S; S.init(M_TOK, 8192, G, bx);
            pg8::EpiGate E{R1, ARG_IN(12) + l * 8192, BR, 1.f / WG8_SCALE};

#ifndef NO_G3
#ifndef PROBE_REP_G3
#define PROBE_REP_G3 1
#endif
#pragma unroll 1
            for (int rep = 0; rep < PROBE_REP_G3; ++rep)
            pg8::gemm_phase<pg8::EpiGate, pg8::StaticOrder, true, true, true>(lds + RING_OFF, g, S, E);
#endif

            SEAM(pb + 5);
        }
        if (IN(pb + 6)) { PH_LAYER;
            pg8::Gemm g{BR, (const bf16_t*)(wl_ + OW_O), M_TOK, 2048, 2048, 2048, 2048, 1 << 30, 0}; pg8::StaticOrder S; S.init(M_TOK, 2048, G, bx);
            pg8::EpiResid E{(l == 0) ? ARG_IN(0) : (const float*)xbuf, xbuf, modl + 4096, 12288};

#ifndef NO_G4
#ifdef PROBE_NULL_G4
            { pg8::EpiNull EN{(float*)(ws + WS_FCUM)}; pg8::gemm_phase<pg8::EpiNull, pg8::StaticOrder, true, true>(lds + RING_OFF, g, S, EN); }
#endif
            pg8::gemm_phase<pg8::EpiResid, pg8::StaticOrder, true, true>(lds + RING_OFF, g, S, E);
#endif
            SEAM(pb + 6);
        }
        if (IN(pb + 7)) { PH_LAYER;
            const float* g2 = ARG_IN(15) + l * 2048;
            for (int rb = gw; rb < M_TOK / 8; rb += NGW) { const int b = (rb * 8) / SEQ; f32x4 Av[8], Bv[8];
#pragma unroll
                for (int j = 0; j < 8; ++j) { const int c = 4 * lane + 256 * j; const f32x4 g = *(const f32x4*)(g2 + c), sc = *(const f32x4*)(modl + b * 12288 + 8192 + c); Av[j] = g * (sc + 1.f); Bv[j] = *(const f32x4*)(modl + b * 12288 + 6144 + c); }
#pragma unroll 1
                for (int i = 0; i < 8; ++i) norm_row<false>(xbuf + (size_t)(rb * 8 + i) * 2048, Hb + (size_t)(rb * 8 + i) * 2048, nullptr, Av, Bv, lane); }
            SEAM(pb + 7);
        }
        if (IN(pb + 8)) { PH_LAYER;
            pg8::Gemm g{Hb, (const bf16_t*)(wl_ + OW_1), M_TOK, 8192, 2048, 2048, 2048, 1 << 30, 0}; pg8::StaticOrder S; S.init(M_TOK, 8192, G, bx);
            pg8::EpiBf16<2> E{R1, 8192};

#ifndef NO_G5
#ifdef PROBE_NULL_G5
            { pg8::EpiNull EN{(float*)(ws + WS_FCUM)}; pg8::gemm_phase<pg8::EpiNull, pg8::StaticOrder, true, true>(lds + RING_OFF, g, S, EN); }
#endif
#ifndef PROBE_REP_G5
#define PROBE_REP_G5 1
#endif
#pragma unroll 1
            for (int rep = 0; rep < PROBE_REP_G5; ++rep)
            pg8::gemm_phase<pg8::EpiBf16<2>, pg8::StaticOrder, true, true>(lds + RING_OFF, g, S, E);
#endif

            SEAM(pb + 8);
        }
        if (IN(pb + 9)) { PH_LAYER;
            pg8::Gemm g{R1, (const bf16_t*)(wl_ + OW_2), M_TOK, 2048, 8192, 8192, 8192, 1 << 30, 0}; pg8::StaticOrder S; S.init(M_TOK, 2048, G, bx);
            pg8::EpiResid E{xbuf, xbuf, modl + 10240, 12288};

#ifndef NO_G6
#ifdef PROBE_NULL_G6
            { pg8::EpiNull EN{(float*)(ws + WS_FCUM)}; pg8::gemm_phase<pg8::EpiNull, pg8::StaticOrder, true, true>(lds + RING_OFF, g, S, EN); }
#endif
            pg8::gemm_phase<pg8::EpiResid, pg8::StaticOrder, true, true>(lds + RING_OFF, g, S, E);
#endif
            SEAM(pb + 9);
        }
}

template <int LO, int HI>
__global__ void __launch_bounds__(NWAVES * 64, 2) mk_fwd(Args args) {
    extern __shared__ __attribute__((aligned(16))) unsigned char lds_raw[];
    LAS unsigned char* lds = (LAS unsigned char*)lds_raw;
    volatile LAS unsigned* MISC = (volatile LAS unsigned*)(lds + MISC_OFF);
    const int tid0 = threadIdx.x, wave = __builtin_amdgcn_readfirstlane(tid0 >> 6);
    const int G = gridDim.x; const int bx = blockIdx.x; const int vcu = (G % 8 == 0) ? (bx % 8) * (G / 8) + bx / 8 : bx;
    const int gw = vcu * NWAVES + wave, NGW = G * NWAVES;
    for (int u = tid0; u < (LDS_BYTES - LDSCTL_OFF) / 4; u += NWAVES * 64) ((LAS unsigned*)(lds + LDSCTL_OFF))[u] = 0u;
    __syncthreads();
    constexpr int lo = LO, hi = HI; (void)args;
    XcdBarrier bar; bar.bar = (unsigned*)(karg_ws() + WS_CTL) + CW_BAR; bar.x = 0; bar.st = nullptr;
    if constexpr (hi - lo > 1) bar = xcd_barrier_post((unsigned*)(karg_ws() + WS_CTL) + CW_BAR, MISC + 8);

    if (IN(0)) { PH_PTRS;
        LAS float* scr = (LAS float*)(lds + RING_OFF + wave * 16384);
#ifndef PROBE_REP_P0
#define PROBE_REP_P0 1
#endif
#pragma unroll 1
        for (int rep = 0; rep < PROBE_REP_P0; ++rep) {
        constexpr int I_IN = 32 * 208, I_G = 32 * 256, I_B = 4 * 8 * 64, I_O = 32 * 64, I_1 = 32 * 256, I_2 = 128 * 64, I_L = I_IN + I_G + I_B + I_O + I_1 + I_2;
        for (int it = gw; it < 2 * I_L; it += NGW) {
            const int l = it / I_L; int r = it % I_L;
            unsigned char* wl_ = ws + WS_W + (size_t)l * LW_BYTES;
            if (r < I_IN) { transpose_item(ARG_IN(5) + (size_t)l * 2048 * 6472, 2048, 6472, 208, (bf16_t*)(wl_ + OW_IN), MapWin(), scr, r, lane); continue; } r -= I_IN;
            if (r < I_G) { transpose_item8(ARG_IN(11) + (size_t)l * 2048 * 8192, 2048, 8192, 256, (unsigned char*)(wl_ + OW_G), MapGate(), scr, r, lane); continue; } r -= I_G;
            const float* W; int K, Ns, nblk; bf16_t* WT;
            if (r < I_B) { const int g = r / 512; r -= g * 512; W = ARG_IN(13) + (size_t)(l * 4 + g) * 512 * 2048; K = 512; Ns = 2048; nblk = 64; WT = (bf16_t*)(wl_ + OW_B) + (size_t)g * 2048 * 512; }
            else { r -= I_B;
                if (r < I_O) { W = ARG_IN(14) + (size_t)l * 2048 * 2048; K = 2048; Ns = 2048; nblk = 64; WT = (bf16_t*)(wl_ + OW_O); }
                else { r -= I_O;
                    if (r < I_1) { W = ARG_IN(16) + (size_t)l * 2048 * 8192; K = 2048; Ns = 8192; nblk = 256; WT = (bf16_t*)(wl_ + OW_1); }
                    else { r -= I_1; W = ARG_IN(17) + (size_t)l * 8192 * 2048; K = 8192; Ns = 2048; nblk = 64; WT = (bf16_t*)(wl_ + OW_2); } } }
            transpose_item(W, K, Ns, nblk, WT, MapPlain(), scr, r, lane);
        }
        for (int it = gw; it < 2 * 48 * 16; it += NGW) mod_partial_item(ARG_IN(1), ARG_IN(2), modp, it, lane);
        }
        SEAM(0);
    }
    if (IN(1)) { PH_PTRS;
        for (int i = bx * 512 + tid; i < 2 * 8 * 12288; i += G * 512) { const int n = i % 12288, l = i / (8 * 12288);
            float s = ARG_IN(3)[l * 12288 + n];
#pragma unroll
            for (int kc = 0; kc < 16; ++kc) s += modp[(size_t)kc * (2 * 8 * 12288) + i];
            modf[i] = s; }
        SEAM(1);
    }
    constexpr int L_LO = (LO <= 2) ? 0 : (LO - 2) / 10, L_HI = (HI >= 22) ? NLAYER : (HI - 2 + 9) / 10;
    if constexpr (L_LO <= 0 && 0 < L_HI) layer_phases<0, LO, HI>(lds, MISC, bar, wave, G, bx, gw, NGW);
    if constexpr (L_LO <= 1 && 1 < L_HI) layer_phases<1, LO, HI>(lds, MISC, bar, wave, G, bx, gw, NGW);
    if (IN(22)) { PH_PTRS;
        f32x4 Gv[8];
#pragma unroll
        for (int j = 0; j < 8; ++j) Gv[j] = *(const f32x4*)(ARG_IN(18) + 4 * lane + 256 * j);
        for (int rb = gw; rb < M_TOK / 8; rb += NGW) {
#pragma unroll 1
            for (int i = 0; i < 8; ++i) final_row(xbuf + (size_t)(rb * 8 + i) * 2048, Gv, lane); }
    }
}

#if !MK_ONE_LAUNCH
template <int P> static void set_attr_from() { if constexpr (P < N_PHASES) { (void)hipFuncSetAttribute((const void*)mk_fwd<P, P + 1>, hipFuncAttributeMaxDynamicSharedMemorySize, LDS_BYTES); set_attr_from<P + 1>(); } }
template <int P> static void launch_from(int grid, hipStream_t stream, Args a) {
    if constexpr (P < N_PHASES) { a.ph_lo = P; a.ph_hi = P + 1; hipLaunchKernelGGL((mk_fwd<P, P + 1>), dim3(grid), dim3(NWAVES * 64), LDS_BYTES, stream, a); launch_from<P + 1>(grid, stream, a); } }
#endif
extern "C" void kernel_launch(void* const* d_in, const int* in_sizes, int n_in, void* d_out, int out_size, void* d_ws, size_t ws_size, hipStream_t stream) {
    static int grid = 0;
    if (grid == 0) {
        if (n_in != 19 || in_sizes[0] != M_TOK * DM || out_size != M_TOK * DM || ws_size < WS_END) {
            fprintf(stderr, "kernel_launch: shape / workspace mismatch (n_in %d, in0 %d, out %d, ws %zu, need %zu); nothing launched\n", n_in, n_in > 0 ? in_sizes[0] : -1, out_size, ws_size, (size_t)WS_END); grid = -1; return; }
        int dev = 0, cus = 0, per_cu = 0;
        if (hipGetDevice(&dev) != hipSuccess || hipDeviceGetAttribute(&cus, hipDeviceAttributeMultiprocessorCount, dev) != hipSuccess) { fprintf(stderr, "kernel_launch: device query failed\n"); grid = -1; return; }
#if MK_ONE_LAUNCH
        if (hipFuncSetAttribute((const void*)mk_fwd<0, N_PHASES>, hipFuncAttributeMaxDynamicSharedMemorySize, LDS_BYTES) != hipSuccess) { fprintf(stderr, "kernel_launch: hipFuncSetAttribute failed\n"); grid = -1; return; }
        if (hipOccupancyMaxActiveBlocksPerMultiprocessor(&per_cu, (const void*)mk_fwd<0, N_PHASES>, NWAVES * 64, LDS_BYTES) != hipSuccess || per_cu < 1) fprintf(stderr, "kernel_launch: occupancy query reports %d workgroups per CU\n", per_cu);
#else
        set_attr_from<0>();
#endif
        (void)hipGetLastError();
        grid = cus;
    }
    if (grid < 0) return;
    if (hipMemsetAsync((char*)d_ws + WS_CTL, 0, CTL_ZERO_BYTES, stream) != hipSuccess) { fprintf(stderr, "kernel_launch: memset failed\n"); return; }
    Args a{};
    for (int i = 0; i < 19; ++i) a.in[i] = (const float*)d_in[i];
    a.out = (float*)d_out; a.ws = (unsigned char*)d_ws;
#if MK_ONE_LAUNCH
    a.ph_lo = 0; a.ph_hi = N_PHASES;
    hipLaunchKernelGGL((mk_fwd<0, N_PHASES>), dim3(grid), dim3(NWAVES * 64), LDS_BYTES, stream, a);
#else
    launch_from<0>(grid, stream, a);
#endif
    const hipError_t le = hipPeekAtLastError();
    if (le != hipSuccess) fprintf(stderr, "kernel_launch: launch failed: %s\n", hipGetErrorName(le));
}
```

```cpp
#include <hip/hip_runtime.h>
#include <cstdio>
#include <cstdint>

#ifndef MK_ONE_LAUNCH
#define MK_ONE_LAUNCH 1
#endif

#define DI __device__ __forceinline__
#define LAS __attribute__((address_space(3)))
#define GAS __attribute__((address_space(1)))

namespace pg8 {
#define PG8_LAS __attribute__((address_space(3)))
typedef unsigned short bf16_t;
typedef short bf16x8 __attribute__((ext_vector_type(8)));
typedef float f32x4 __attribute__((ext_vector_type(4)));
typedef float f32x2 __attribute__((ext_vector_type(2)));
typedef unsigned u32x4 __attribute__((ext_vector_type(4)));
typedef unsigned u32x2 __attribute__((ext_vector_type(2)));
typedef int i32x8a __attribute__((ext_vector_type(8), aligned(16)));
constexpr int BM = 256, BK = 64, HALF = 128, HTB = HALF * BK * 2  , STAGE_BYTES = 8 * HTB, NXCD = 8, WGM = 8;

__host__ __device__ __forceinline__ int lds_byte(int r, int c) { const int st = (r >> 4) * 2 + (c >> 5), rr = r & 15, cc = c & 31, ob = rr * 64 + cc * 2; return st * 1024 + (ob ^ (((ob >> 9) & 1) << 5)); }
__host__ __device__ __forceinline__ void stage_rc(int b, int& R, int& C) { const int st = b / 1024, sb = b % 1024, swz = sb ^ (((sb >> 9) & 1) << 5); R = (st >> 1) * 16 + swz / 64; C = (st & 1) * 32 + (swz % 64) / 2; }
__host__ __device__ __forceinline__ int perm32(int rho) { const int n = rho >> 4, i = rho & 15; return 8 * (i >> 2) + 4 * n + (i & 3); }

struct Unit { int pm, pn; };
struct Gemm { const bf16_t* A; const bf16_t* Bt; int M, N, K, lda, ldb, agdiv, agoff; };

struct StaticOrder {
    int nM, nN, nwg, G, c;
    __host__ __device__ void init(int M, int N, int G_, int c_) { nM = M / BM; nN = N / BM; nwg = nM * nN; G = G_; c = c_; }
    __host__ __device__ bool next(int i, Unit& u) const {
        const long L = (long)i * G + c; if (L >= nwg) return false;
        int wgid = (int)L; { const int q = nwg / NXCD, r = nwg % NXCD, xcd = wgid % NXCD, off = wgid / NXCD; wgid = (xcd < r ? xcd * (q + 1) : r * (q + 1) + (xcd - r) * q) + off; }
        const int nig = WGM * nN, gid = wgid / nig, fm = gid * WGM, gsz = (nM - fm) < WGM ? (nM - fm) : WGM;
        u.pm = fm + ((wgid % nig) % gsz); u.pn = (wgid % nig) / gsz; return true;
    }
    __device__ __forceinline__ void a_ready(const Unit&) const {}
    __device__ __forceinline__ void done(const Unit&) const {}
};

struct RangeOrder : StaticOrder {
    int i0, n;
    __host__ __device__ bool next(int i, Unit& u) const { if (i >= n) return false; return StaticOrder::next(i + i0, u); }
};
__device__ __forceinline__ unsigned cvt_pk_bf16(float lo, float hi) { unsigned r; asm volatile("v_cvt_pk_bf16_f32 %0, %1, %2" : "=v"(r) : "v"(lo), "v"(hi)); return r; }

template <int ACT> struct EpiBf16 {
    static constexpr bool PERM = true, AFTER_DRAIN = false;
    bf16_t* O; int ldc;
    __device__ __forceinline__ void operator()(const f32x4 (&acc)[2][2][4][2], const Unit& u, int wr, int wc, int fr, int fq) const {
        const int row0 = u.pm * BM + wr * 64 + fr; const int col0 = u.pn * BM + wc * 32 + 8 * fq;
#pragma unroll
        for (int ai = 0; ai < 2; ++ai)
#pragma unroll
            for (int m = 0; m < 4; ++m) { bf16_t* rowp = O + (size_t)(row0 + ai * HALF + m * 16) * ldc + col0;
#pragma unroll
                for (int bj = 0; bj < 2; ++bj) { f32x4 v0 = acc[ai][bj][m][0], v1 = acc[ai][bj][m][1];
                    if (ACT == 2) {
#pragma unroll
                        for (int j = 0; j < 4; ++j) { const float a = fmaxf(v0[j], 0.f), b = fmaxf(v1[j], 0.f); v0[j] = a * a; v1[j] = b * b; } }
                    u32x4 w; w.x = cvt_pk_bf16(v0[0], v0[1]); w.y = cvt_pk_bf16(v0[2], v0[3]); w.z = cvt_pk_bf16(v1[0], v1[1]); w.w = cvt_pk_bf16(v1[2], v1[3]);
                    *(u32x4*)(rowp + bj * HALF) = w; } }
    }
};
struct EpiNull {
    static constexpr bool PERM = true, AFTER_DRAIN = false;
    float* sink;
    __device__ __forceinline__ void operator()(const f32x4 (&acc)[2][2][4][2], const Unit& u, int wr, int wc, int fr, int fq) const {
        f32x4 s = (f32x4){0.f, 0.f, 0.f, 0.f};
#pragma unroll
        for (int ai = 0; ai < 2; ++ai)
#pragma unroll
            for (int bj = 0; bj < 2; ++bj)
#pragma unroll
                for (int m = 0; m < 4; ++m)
#pragma unroll
                    for (int n = 0; n < 2; ++n) s += acc[ai][bj][m][n];
        if (s[0] + s[1] + s[2] + s[3] == 1.2345678e33f) sink[u.pm] = s[0];
    }
};
struct EpiBf16s {
    static constexpr bool PERM = true, AFTER_DRAIN = false;
    bf16_t* O; int ldc; float sd, sq; unsigned qmask;
    __device__ __forceinline__ void operator()(const f32x4 (&acc)[2][2][4][2], const Unit& u, int wr, int wc, int fr, int fq) const {
        const int row0 = u.pm * BM + wr * 64 + fr; const int col0 = u.pn * BM + wc * 32 + 8 * fq; const float sc = ((qmask >> u.pn) & 1u) ? sq : sd;
#pragma unroll
        for (int ai = 0; ai < 2; ++ai)
#pragma unroll
            for (int m = 0; m < 4; ++m) { bf16_t* rowp = O + (size_t)(row0 + ai * HALF + m * 16) * ldc + col0;
#pragma unroll
                for (int bj = 0; bj < 2; ++bj) { const f32x4 v0 = acc[ai][bj][m][0] * sc, v1 = acc[ai][bj][m][1] * sc;
                    u32x4 w; w.x = cvt_pk_bf16(v0[0], v0[1]); w.y = cvt_pk_bf16(v0[2], v0[3]); w.z = cvt_pk_bf16(v1[0], v1[1]); w.w = cvt_pk_bf16(v1[2], v1[3]);
                    *(u32x4*)(rowp + bj * HALF) = w; } }
    }
};
struct EpiResid {
    static constexpr bool PERM = false, AFTER_DRAIN = false;
    const float* xin; float* xout; const float* gate; int gstride;
    __device__ __forceinline__ void operator()(const f32x4 (&acc)[2][2][4][2], const Unit& u, int wr, int wc, int fr, int fq) const {
        const int b = u.pm >> 3; const int col0 = u.pn * BM + wc * 32 + 4 * fq;
        f32x4 gv[2][2];
#pragma unroll
        for (int bj = 0; bj < 2; ++bj)
#pragma unroll
            for (int n = 0; n < 2; ++n) gv[bj][n] = *(const f32x4*)(gate + (size_t)b * gstride + col0 + bj * HALF + n * 16);
#pragma unroll
        for (int ai = 0; ai < 2; ++ai)
#pragma unroll
            for (int m = 0; m < 4; ++m) { const size_t off = (size_t)(u.pm * BM + ai * HALF + wr * 64 + m * 16 + fr) * 2048 + col0;
#pragma unroll
                for (int bj = 0; bj < 2; ++bj)
#pragma unroll
                    for (int n = 0; n < 2; ++n) { const f32x4 x = *(const f32x4*)(xin + off + bj * HALF + n * 16);
                        *(f32x4*)(xout + off + bj * HALF + n * 16) = x + gv[bj][n] * acc[ai][bj][m][n]; }
                if (m & 1) asm volatile("" ::: "memory"); }
    }
};
struct EpiGate {
    static constexpr bool PERM = false, AFTER_DRAIN = false;
    const bf16_t* P; const float* bgate; bf16_t* O; float ascale;
    __device__ __forceinline__ void operator()(const f32x4 (&acc)[2][2][4][2], const Unit& u, int wr, int wc, int fr, int fq) const {
        const int d0 = u.pn * 64 + wc * 16 + 4 * fq;
        f32x4 bv[2][2];
#pragma unroll
        for (int bj = 0; bj < 2; ++bj)
#pragma unroll
            for (int n = 0; n < 2; ++n) bv[bj][n] = *(const f32x4*)(bgate + (2 * bj + n) * 2048 + d0);
#pragma unroll
        for (int ai = 0; ai < 2; ++ai)
#pragma unroll
            for (int m = 0; m < 4; ++m) { const size_t row = (size_t)(u.pm * BM + ai * HALF + wr * 64 + m * 16 + fr);
                f32x4 s = (f32x4){0.f, 0.f, 0.f, 0.f};
#pragma unroll
                for (int bj = 0; bj < 2; ++bj)
#pragma unroll
                    for (int n = 0; n < 2; ++n) { const u32x2 pw = *(const u32x2*)(P + row * 8192 + (2 * bj + n) * 2048 + d0);
                        const f32x4 pv = (f32x4){__uint_as_float(pw.x << 16), __uint_as_float(pw.x & 0xffff0000u), __uint_as_float(pw.y << 16), __uint_as_float(pw.y & 0xffff0000u)};
                        const f32x4 x = acc[ai][bj][m][n] * ascale + bv[bj][n];
#pragma unroll
                        for (int j = 0; j < 4; ++j) { const float sg = __builtin_amdgcn_rcpf(1.f + __builtin_amdgcn_exp2f(-1.4426950408889634f * x[j])); s[j] += sg * pv[j]; } }
                u32x2 w; w.x = cvt_pk_bf16(s[0], s[1]); w.y = cvt_pk_bf16(s[2], s[3]);
                *(u32x2*)(O + row * 2048 + d0) = w;
                if (m & 1) asm volatile("" ::: "memory"); }
    }
};

template <class Epi, class Sched, bool ALIGN_EPI = false, bool SP2 = false, bool FP8 = false>
__device__ __forceinline__ void gemm_phase(PG8_LAS unsigned char* lds, const Gemm g, const Sched& S, const Epi& E) {
    int tid_l = threadIdx.x; asm volatile("" : "+v"(tid_l));
    const int tid = tid_l, wid = __builtin_amdgcn_readfirstlane(tid >> 6), lane = tid & 63, wr = wid >> 2, wc = wid & 3, fr = lane & 15, fq = lane >> 4;
    const int K = g.K, nt = K / BK;
    unsigned voffA[2], voffB[2];
#pragma unroll
    for (int i = 0; i < 2; ++i) { int R, C; stage_rc(tid * 16 + i * 8192, R, C); const int Rb = Epi::PERM ? ((R & ~31) + perm32(R & 31)) : R;
        voffA[i] = (unsigned)(R * g.lda + C) * 2u; voffB[i] = (unsigned)(Rb * g.ldb + C) * 2u; }
    const size_t kstep = (size_t)(BK * 2);
    const size_t hstepA = (size_t)HALF * g.lda * 2, hstepB = (size_t)HALF * g.ldb * 2;
    const size_t tstepA = 2 * hstepA, tstepB = 2 * hstepB;
    const unsigned ldsw = (unsigned)wid * 1024u;
    const int aoff = FP8 ? lds_byte(wr * 64 + fr, fq * 16) : lds_byte(wr * 64 + fr, fq * 8), boff = FP8 ? lds_byte(wc * 32 + fr, fq * 16) : lds_byte(wc * 32 + fr, fq * 8);
#define PG8_SA(b, h) (((b) * 2 + (h)) * HTB)
#define PG8_SB(b, h) ((4 + (b) * 2 + (h)) * HTB)
#define PG8_STAGE(bufoff, gbase, voff) do { _Pragma("unroll") for (int _i = 0; _i < 2; ++_i) \
        __builtin_amdgcn_global_load_lds((const unsigned*)((const char*)(gbase) + (voff)[_i]), (PG8_LAS unsigned*)(lds + (bufoff) + ldsw + _i * 8192), 16, 0, 0); } while (0)
#define PG8_LDA(dst, b, h) do { if constexpr (FP8) { _Pragma("unroll") for (int m = 0; m < 4; ++m) dst##8[m] = *(const PG8_LAS i32x8a*)(lds + PG8_SA(b, h) + aoff + m * 2048); } \
        else { _Pragma("unroll") for (int m = 0; m < 4; ++m) _Pragma("unroll") for (int k = 0; k < 2; ++k) dst[m][k] = *(const PG8_LAS bf16x8*)(lds + PG8_SA(b, h) + aoff + m * 2048 + k * 1024); } } while (0)
#define PG8_LDB(dst, b, h) do { if constexpr (FP8) { _Pragma("unroll") for (int n = 0; n < 2; ++n) dst##8[n] = *(const PG8_LAS i32x8a*)(lds + PG8_SB(b, h) + boff + n * 2048); } \
        else { _Pragma("unroll") for (int n = 0; n < 2; ++n) _Pragma("unroll") for (int k = 0; k < 2; ++k) dst[n][k] = *(const PG8_LAS bf16x8*)(lds + PG8_SB(b, h) + boff + n * 2048 + k * 1024); } } while (0)
#define PG8_MMA(ai, bj, At, Bt) do { __builtin_amdgcn_s_setprio(1); \
        if constexpr (FP8) { _Pragma("unroll") for (int m = 0; m < 4; ++m) _Pragma("unroll") for (int n = 0; n < 2; ++n) \
            asm volatile("v_mfma_scale_f32_16x16x128_f8f6f4 %0, %1, %2, %0, %3, %3 op_sel_hi:[0,0,0]" : "+v"(acc[ai][bj][m][n]) : "v"(Bt##8[n]), "v"(At##8[m]), "v"(sc1)); } \
        else { _Pragma("unroll") for (int m = 0; m < 4; ++m) _Pragma("unroll") for (int n = 0; n < 2; ++n) _Pragma("unroll") for (int k = 0; k < 2; ++k) \
            acc[ai][bj][m][n] = __builtin_amdgcn_mfma_f32_16x16x32_bf16(Bt[n][k], At[m][k], acc[ai][bj][m][n], 0, 0, 0); } \
        __builtin_amdgcn_s_setprio(0); } while (0)
#define PG8_WAIT_V(n) asm volatile("s_waitcnt vmcnt(" #n ")" ::: "memory")
#define PG8_WAIT_L(n) asm volatile("s_waitcnt lgkmcnt(" #n ")" ::: "memory")
#define PG8_BAR __builtin_amdgcn_s_barrier()
#define PG8_SCHED __builtin_amdgcn_sched_barrier(0)
    Unit cur, nxt; int ui = 0;
    if (!S.next(0, cur)) return;
    f32x4 acc[2][2][4][2];
#pragma unroll
    for (int a = 0; a < 2; ++a)
#pragma unroll
        for (int b = 0; b < 2; ++b)
#pragma unroll
            for (int m = 0; m < 4; ++m)
#pragma unroll
                for (int n = 0; n < 2; ++n) acc[a][b][m][n] = (f32x4){0.f, 0.f, 0.f, 0.f};
    bf16x8 At[4][2], B0[2][2], B1[2][2];
    i32x8a At8[4], B08[2], B18[2];
    int sc1 = 0x7F7F7F7F; asm volatile("" : "+v"(sc1));
    const char* cA = (const char*)g.A + (size_t)cur.pm * tstepA + (size_t)(cur.pn / g.agdiv) * (size_t)g.agoff * 2; const char* cB = (const char*)g.Bt + (size_t)cur.pn * tstepB;
    S.a_ready(cur);
    if constexpr (SP2) {
        PG8_STAGE(PG8_SB(0, 0), cB, voffB); PG8_STAGE(PG8_SB(0, 1), cB + hstepB, voffB); PG8_STAGE(PG8_SA(0, 0), cA, voffA); PG8_STAGE(PG8_SA(0, 1), cA + hstepA, voffA);
        if (wr == 1) PG8_BAR;
        PG8_WAIT_V(2); PG8_BAR;
        PG8_STAGE(PG8_SB(1, 0), cB + kstep, voffB); PG8_STAGE(PG8_SA(1, 0), cA + kstep, voffA); PG8_STAGE(PG8_SB(1, 1), cB + hstepB + kstep, voffB);
        PG8_WAIT_V(6); PG8_BAR;
    } else {
        PG8_STAGE(PG8_SB(0, 0), cB, voffB); PG8_STAGE(PG8_SA(0, 0), cA, voffA); PG8_STAGE(PG8_SB(0, 1), cB + hstepB, voffB); PG8_STAGE(PG8_SA(0, 1), cA + hstepA, voffA);
        if (wr == 1) PG8_BAR;
        PG8_WAIT_V(4); PG8_BAR;
        PG8_STAGE(PG8_SB(1, 0), cB + kstep, voffB); PG8_STAGE(PG8_SA(1, 0), cA + kstep, voffA); PG8_STAGE(PG8_SB(1, 1), cB + hstepB + kstep, voffB);
        PG8_WAIT_V(6); PG8_BAR;
    }
    for (;;) {
        const bool has_next = S.next(ui + 1, nxt);
        const char* nA = has_next ? (const char*)g.A + (size_t)nxt.pm * tstepA + (size_t)(nxt.pn / g.agdiv) * (size_t)g.agoff * 2 : cA; const char* nB = has_next ? (const char*)g.Bt + (size_t)nxt.pn * tstepB : cB;
        for (int t = 0; t < nt; t += 2) {
            const bool last = (t == nt - 2);
            const char* a1 = cA + (size_t)(t + 1) * kstep;
            const char* a2 = last ? nA : cA + (size_t)(t + 2) * kstep; const char* b2 = last ? nB : cB + (size_t)(t + 2) * kstep;
            const char* a3 = a2 + kstep; const char* b3 = b2 + kstep;
            if (last && has_next) S.a_ready(nxt);
            if constexpr (SP2) {
            PG8_LDB(B0, 0, 0); PG8_LDB(B1, 0, 1); PG8_SCHED; PG8_LDA(At, 0, 0); PG8_STAGE(PG8_SA(1, 1), a1 + hstepA, voffA);
            PG8_WAIT_V(8); PG8_WAIT_L(0); PG8_BAR; PG8_MMA(0, 0, At, B0); PG8_MMA(0, 1, At, B1); PG8_BAR; PG8_SCHED;
            PG8_LDA(At, 0, 1); PG8_STAGE(PG8_SB(0, 0), b2, voffB); PG8_STAGE(PG8_SB(0, 1), b2 + hstepB, voffB); PG8_STAGE(PG8_SA(0, 0), a2, voffA);
            PG8_WAIT_V(8); PG8_WAIT_L(0); PG8_BAR; PG8_MMA(1, 0, At, B0); PG8_MMA(1, 1, At, B1); PG8_BAR; PG8_SCHED;
            PG8_LDB(B0, 1, 0); PG8_LDB(B1, 1, 1); PG8_SCHED; PG8_LDA(At, 1, 0); PG8_STAGE(PG8_SA(0, 1), a2 + hstepA, voffA);
            PG8_WAIT_V(8); PG8_WAIT_L(0); PG8_BAR; PG8_MMA(0, 0, At, B0); PG8_MMA(0, 1, At, B1); PG8_BAR; PG8_SCHED;
            PG8_LDA(At, 1, 1); PG8_STAGE(PG8_SB(1, 0), b3, voffB); PG8_STAGE(PG8_SB(1, 1), b3 + hstepB, voffB); PG8_STAGE(PG8_SA(1, 0), a3, voffA);
            PG8_WAIT_V(8); PG8_WAIT_L(0); PG8_BAR; PG8_MMA(1, 0, At, B0); PG8_MMA(1, 1, At, B1); PG8_BAR; PG8_SCHED;
            } else {
            PG8_LDB(B0, 0, 0); PG8_SCHED; PG8_LDA(At, 0, 0); PG8_STAGE(PG8_SA(1, 1), a1 + hstepA, voffA);
            PG8_WAIT_L(8); PG8_BAR; PG8_WAIT_L(0); PG8_MMA(0, 0, At, B0); PG8_BAR; PG8_SCHED;
            PG8_LDB(B1, 0, 1); PG8_STAGE(PG8_SB(0, 0), b2, voffB);
            PG8_BAR; PG8_WAIT_L(0); PG8_MMA(0, 1, At, B1); PG8_BAR;
            PG8_LDA(At, 0, 1); PG8_STAGE(PG8_SA(0, 0), a2, voffA);
            PG8_BAR; PG8_WAIT_L(0); PG8_MMA(1, 0, At, B0); PG8_BAR; PG8_SCHED;
            PG8_STAGE(PG8_SB(0, 1), b2 + hstepB, voffB);
            PG8_WAIT_V(6); PG8_BAR; PG8_MMA(1, 1, At, B1); PG8_BAR;
            PG8_LDB(B0, 1, 0); PG8_SCHED; PG8_LDA(At, 1, 0); PG8_STAGE(PG8_SA(0, 1), a2 + hstepA, voffA);
            PG8_WAIT_L(8); PG8_BAR; PG8_WAIT_L(0); PG8_MMA(0, 0, At, B0); PG8_BAR; PG8_SCHED;
            PG8_LDB(B1, 1, 1); PG8_STAGE(PG8_SB(1, 0), b3, voffB);
            PG8_BAR; PG8_WAIT_L(0); PG8_MMA(0, 1, At, B1); PG8_BAR;
            PG8_LDA(At, 1, 1); PG8_STAGE(PG8_SA(1, 0), a3, voffA);
            PG8_BAR; PG8_WAIT_L(0); PG8_MMA(1, 0, At, B0); PG8_BAR; PG8_SCHED;
            PG8_STAGE(PG8_SB(1, 1), b3 + hstepB, voffB);
            PG8_WAIT_V(6); PG8_BAR; PG8_MMA(1, 1, At, B1); PG8_BAR;
            }
        }
        if constexpr (ALIGN_EPI) { if (wr == 0) PG8_BAR; }
        if constexpr (FP8) asm volatile("s_nop 15\n\ts_nop 7" ::: "memory");
        if constexpr (!Epi::AFTER_DRAIN) { E(acc, cur, wr, wc, fr, fq); S.done(cur); }
        if (!has_next) break;
#pragma unroll
        for (int a = 0; a < 2; ++a)
#pragma unroll
            for (int b = 0; b < 2; ++b)
#pragma unroll
                for (int m = 0; m < 4; ++m)
#pragma unroll
                    for (int n = 0; n < 2; ++n) acc[a][b][m][n] = (f32x4){0.f, 0.f, 0.f, 0.f};
        cur = nxt; cA = nA; cB = nB; ++ui;
        if constexpr (ALIGN_EPI) { if (wr == 1) PG8_BAR; }
    }
    PG8_WAIT_V(0);
    if constexpr (!ALIGN_EPI) { if (wr == 0) PG8_BAR; }
    PG8_BAR;
    if constexpr (Epi::AFTER_DRAIN) { E.fused(acc, cur, wr, wc, fr, fq, lds, wid, lane); S.done(cur); }
#undef PG8_SA
#undef PG8_SB
#undef PG8_STAGE
#undef PG8_LDA
#undef PG8_LDB
#undef PG8_MMA
#undef PG8_WAIT_V
#undef PG8_WAIT_L
#undef PG8_BAR
#undef PG8_SCHED
}
}

constexpr int NB = 8, SEQ = 2048, DM = 2048, M_TOK = NB * SEQ, DFF = 8192, NLAYER = 2;
constexpr int LDQ = 6656;
constexpr int C_QB = 0, C_KB = 512, C_VB = 1024, C_VD = 1536, C_BG = 2048, C_CG = 2560, C_XIN = 3072, C_IQ = 3584, C_IK = 3840, C_IW = 3904, C_FD = 3908,
              C_QA = 4096, C_KA = 4608, C_VA = 5120, C_QD = 5632, C_KD = 6144;
constexpr int N_IN16 = 4096, N_IN8 = LDQ - N_IN16;
constexpr float LOG2E = 1.4426950408889634f;
constexpr float IDX_SCALE = 0.0625f;
constexpr float RMS_EPS = 1e-6f;

typedef unsigned short bf16_t;
typedef short bf16x8 __attribute__((ext_vector_type(8)));
typedef short s16x4 __attribute__((ext_vector_type(4)));
typedef float f32x16 __attribute__((ext_vector_type(16)));
typedef float f32x4 __attribute__((ext_vector_type(4)));
typedef float f32x2 __attribute__((ext_vector_type(2)));
typedef unsigned u32x4 __attribute__((ext_vector_type(4)));
typedef unsigned u32x2 __attribute__((ext_vector_type(2)));

DI float bf2f(bf16_t v) { return __uint_as_float((unsigned)v << 16); }
DI unsigned cvtpk(float lo, float hi) { unsigned r; asm volatile("v_cvt_pk_bf16_f32 %0, %1, %2" : "=v"(r) : "v"(lo), "v"(hi)); return r; }
DI float wave_sum(float v) {
#pragma unroll
    for (int o = 1; o < 64; o <<= 1) v += __shfl_xor(v, o);
    return v;
}

namespace att {
constexpr int SHM_V = 16384, SHM_K = 16384;
constexpr int OFF_V = 0, OFF_K = 2 * SHM_V, OFF_WS = OFF_K + 2 * SHM_K, OFF_TAB = OFF_WS + 8 * 64 * 4, OFF_FK = OFF_TAB + 512, LDS_END = OFF_FK + 8192;
#define KSWZ(row, colB) ((row) * 256 + ((colB) ^ (((row) & 7) << 4)))
#define SBAR() __builtin_amdgcn_sched_barrier(0)
DI int v_st(int k, int c) { const int kk = (k & ~0xC) | ((k & 4) << 1) | ((k & 8) >> 1); return ((kk >> 3) * 4 + (c >> 5)) * 512 + ((kk & 7) * 32 + (c & 31)) * 2; }
DI int v_rd_base(int lane) { return ((lane & 3) << 3) | (((lane >> 2) & 3) << 6) | (((lane >> 4) & 1) << 5) | (((lane >> 5) & 1) << 8); }
constexpr int v_rd_off(int d0, int ks, int half) { return d0 * 512 + ks * 4096 + half * 2048; }
DI int crow(int r, int hi) { return (r & 3) + 8 * (r >> 2) + 4 * hi; }

template <int KB, int D0LO, int D0HI>
DI void qkt(f32x16& p0, f32x16& p1, LAS const char* K_lds, int r32, int hi, const bf16x8* qr) {
#pragma unroll
    for (int r = 0; r < 16; ++r) { p0[r] = 0.f; p1[r] = 0.f; }
    LAS const char* kb[4];
#pragma unroll
    for (int dd = 0; dd < 4; ++dd) kb[dd] = K_lds + KB * SHM_K + KSWZ(r32, (dd * 16 + hi * 8) * 2);
#pragma unroll
    for (int d0 = D0LO; d0 < D0HI; ++d0) { LAS const char* a = kb[d0 & 3] + (d0 >> 2) * 128;
        const bf16x8 b0 = *(LAS const bf16x8*)a;
        const bf16x8 b1 = *(LAS const bf16x8*)(a + 32 * 256);
        p0 = __builtin_amdgcn_mfma_f32_32x32x16_bf16(b0, qr[d0 - D0LO], p0, 0, 0, 0);
        p1 = __builtin_amdgcn_mfma_f32_32x32x16_bf16(b1, qr[d0 - D0LO], p1, 0, 0, 0); }
}
template <int VB>
DI void pv_tile(f32x16* o, int vb0, bf16x8 pa0, bf16x8 pa1, bf16x8 pa2, bf16x8 pa3) {
#define TRRD(dst, off) asm volatile("ds_read_b64_tr_b16 %0, %1 offset:%2" : "=&v"(dst) : "v"(vb0), "i"(off) : "memory")
#define PV_D0(d0) do { s16x4 l0, l1, l2, l3, h0, h1, h2, h3; constexpr int b_ = VB * SHM_V + v_rd_off(d0, 0, 0);     \
        TRRD(l0, b_); TRRD(h0, b_ + 2048); TRRD(l1, b_ + 4096); TRRD(h1, b_ + 6144); TRRD(l2, b_ + 8192); TRRD(h2, b_ + 10240); TRRD(l3, b_ + 12288); TRRD(h3, b_ + 14336); \
        asm volatile("s_waitcnt lgkmcnt(0)" ::: "memory"); SBAR();   \
        o[d0] = __builtin_amdgcn_mfma_f32_32x32x16_bf16(pa0, (bf16x8){l0[0], l0[1], l0[2], l0[3], h0[0], h0[1], h0[2], h0[3]}, o[d0], 0, 0, 0);   \
        o[d0] = __builtin_amdgcn_mfma_f32_32x32x16_bf16(pa1, (bf16x8){l1[0], l1[1], l1[2], l1[3], h1[0], h1[1], h1[2], h1[3]}, o[d0], 0, 0, 0);   \
        o[d0] = __builtin_amdgcn_mfma_f32_32x32x16_bf16(pa2, (bf16x8){l2[0], l2[1], l2[2], l2[3], h2[0], h2[1], h2[2], h2[3]}, o[d0], 0, 0, 0);   \
        o[d0] = __builtin_amdgcn_mfma_f32_32x32x16_bf16(pa3, (bf16x8){l3[0], l3[1], l3[2], l3[3], h3[0], h3[1], h3[2], h3[3]}, o[d0], 0, 0, 0); } while (0)
    PV_D0(0); PV_D0(1); PV_D0(2); PV_D0(3);
#undef PV_D0
#undef TRRD
}
DI int t5_bucket(int n) {
    if (n < 16) return n;
    int b = 16;
    b += (n >= 19); b += (n >= 21); b += (n >= 24); b += (n >= 27); b += (n >= 31); b += (n >= 35); b += (n >= 40); b += (n >= 46);
    b += (n >= 52); b += (n >= 59); b += (n >= 67); b += (n >= 77); b += (n >= 87); b += (n >= 99); b += (n >= 113);
    return b;
}

struct UnitArgs {
    const bf16_t* Qp; const bf16_t* Kp; const bf16_t* Vp; bf16_t* Op; int q0;
    const unsigned long long* maskp;
    const float* fcum;
    const float* relb; int relcol;
    float lam, post;
    const float* gsub;
    float* stash;
};

template <int MODE>
DI void attn_unit(LAS char* lds, const UnitArgs& A) {
    int tid_l = threadIdx.x; asm volatile("" : "+v"(tid_l));
    const int tid = tid_l, wid = __builtin_amdgcn_readfirstlane(tid >> 6), lane = tid & 63, r32 = lane & 31, hi = lane >> 5;
    const int q0 = A.q0, NT = (q0 + 256) / 64;
    LAS char* V_lds = lds + OFF_V; LAS char* K_lds = lds + OFF_K;
    LAS float* wsf = (LAS float*)(lds + OFF_WS) + wid * 64; LAS float* li_l = wsf; LAS float* al_l = wsf + 32;
    LAS float* tab = (LAS float*)(lds + OFF_TAB); LAS float* fk = (LAS float*)(lds + OFF_FK);
    const int qlo = q0 + wid * 32, qpos = qlo + r32;
    const int sr = tid >> 4, sc = (tid & 15) * 8;
    const int vst0 = v_st(sr, sc), vst1 = v_st(32 + sr, sc), kws = KSWZ(sr, sc * 2);
    const int vb0 = (int)(unsigned)(uintptr_t)V_lds + v_rd_base(lane);
    if (MODE == 0 || MODE == 1) { if (tid < 128) { const int bk = t5_bucket(tid); tab[tid] = (A.relb[bk * 8 + A.relcol] - A.relb[31 * 8 + A.relcol]) * LOG2E; } }
    float fqv = 0.f;
    if (MODE == 2) { for (int i = tid; i < q0 + 256; i += 512) fk[i] = A.fcum[i]; fqv = A.fcum[qpos]; }
    constexpr int NPASS = (MODE == 1) ? 2 : 1, NQ = (MODE == 1) ? 4 : 8;
#pragma unroll 1
    for (int pass = 0; pass < NPASS; ++pass) {
        bf16x8 qr[NQ];
#pragma unroll
        for (int d = 0; d < NQ; ++d) qr[d] = *(const bf16x8*)(A.Qp + (size_t)(qpos) * LDQ + (MODE == 1 ? pass * 64 : 0) + d * 16 + hi * 8);
        bf16x8 st_k0, st_k1, st_v0, st_v1;
#define SLOAD(k0) do { st_v0 = *(const bf16x8*)(A.Vp + (size_t)((k0) + sr) * LDQ + sc); st_v1 = *(const bf16x8*)(A.Vp + (size_t)((k0) + 32 + sr) * LDQ + sc); \
                       st_k0 = *(const bf16x8*)(A.Kp + (size_t)((k0) + sr) * LDQ + sc); st_k1 = *(const bf16x8*)(A.Kp + (size_t)((k0) + 32 + sr) * LDQ + sc); } while (0)
#define SWRITE(bf) do { *(LAS bf16x8*)(V_lds + (bf) * SHM_V + vst0) = st_v0; *(LAS bf16x8*)(V_lds + (bf) * SHM_V + vst1) = st_v1; \
                        *(LAS bf16x8*)(K_lds + (bf) * SHM_K + kws) = st_k0; *(LAS bf16x8*)(K_lds + (bf) * SHM_K + kws + 32 * 256) = st_k1; } while (0)
        SLOAD(0); SWRITE(0);
        __syncthreads();
        float m_reg = -1e30f, l_reg = 0.f; f32x16 o[4];
#pragma unroll
        for (int d = 0; d < 4; ++d)
#pragma unroll
            for (int r = 0; r < 16; ++r) o[d][r] = 0.f;
        f32x16 p0, p1; bf16x8 pa0, pa1, pa2, pa3;
        unsigned long long mw_next = 0ull; if (MODE == 0) mw_next = A.maskp[(size_t)qpos * 32];
#define STEP(t, KB) do { const int t_ = (t); const bool more_ = (t_ + 1 < NT); const int kbase = t_ * 64; \
        const unsigned long long mw_ = mw_next; if (MODE == 0) { if (more_) mw_next = A.maskp[(size_t)qpos * 32 + t_ + 1]; } \
        if (more_) SLOAD(kbase + 64); \
        if (MODE == 1) { if (pass == 0) qkt<KB, 0, 4>(p0, p1, K_lds, r32, hi, qr); else qkt<KB, 4, 8>(p0, p1, K_lds, r32, hi, qr); } \
        else qkt<KB, 0, 8>(p0, p1, K_lds, r32, hi, qr); \
        if (MODE == 0 || MODE == 1) { if (kbase + 63 + 113 > qlo) { const int dq_ = qpos - kbase - 4 * hi; \
            _Pragma("unroll") for (int r = 0; r < 16; ++r) { const int c_ = (r & 3) + 8 * (r >> 2); int i0 = dq_ - c_, i1 = dq_ - c_ - 32; \
                i0 = i0 < 0 ? 0 : (i0 > 127 ? 127 : i0); i1 = i1 < 0 ? 0 : (i1 > 127 ? 127 : i1); p0[r] += tab[i0]; p1[r] += tab[i1]; } } } \
        if (MODE == 2) { _Pragma("unroll") for (int g = 0; g < 4; ++g) { const f32x4 f0 = *(LAS const f32x4*)(fk + kbase + 8 * g + 4 * hi), f1 = *(LAS const f32x4*)(fk + kbase + 32 + 8 * g + 4 * hi); \
                _Pragma("unroll") for (int j = 0; j < 4; ++j) { p0[4 * g + j] += fqv - f0[j]; p1[4 * g + j] += fqv - f1[j]; } } } \
        if (kbase + 63 > qlo) { const int dq_ = qpos - kbase - 4 * hi; const float NEG_ = -__builtin_inff(); \
            _Pragma("unroll") for (int r = 0; r < 16; ++r) { const int c_ = (r & 3) + 8 * (r >> 2); if (dq_ - c_ < 0) p0[r] = NEG_; if (dq_ - c_ - 32 < 0) p1[r] = NEG_; } } \
        if (MODE == 0) { const unsigned wl_ = (unsigned)mw_ >> (4 * hi), wh_ = (unsigned)(mw_ >> 32) >> (4 * hi); const float NEG_ = -__builtin_inff(); \
            _Pragma("unroll") for (int r = 0; r < 16; ++r) { const int c_ = (r & 3) + 8 * (r >> 2); if (!((wl_ >> c_) & 1u)) p0[r] = NEG_; if (!((wh_ >> c_) & 1u)) p1[r] = NEG_; } } \
        float pmax_ = p0[0]; _Pragma("unroll") for (int r = 1; r < 16; ++r) pmax_ = fmaxf(pmax_, p0[r]); _Pragma("unroll") for (int r = 0; r < 16; ++r) pmax_ = fmaxf(pmax_, p1[r]); \
        { auto rr = __builtin_amdgcn_permlane32_swap(__float_as_uint(pmax_), __float_as_uint(pmax_), false, false); pmax_ = fmaxf(__uint_as_float(rr[0]), __uint_as_float(rr[1])); } \
        float mn_ = m_reg, alpha_ = 1.f; \
        if (!__all(pmax_ - m_reg <= 8.f)) { mn_ = fmaxf(m_reg, pmax_); alpha_ = __builtin_amdgcn_exp2f(m_reg - mn_); m_reg = mn_; } \
        float ps_ = 0.f; \
        _Pragma("unroll") for (int r = 0; r < 16; ++r) { p0[r] = __builtin_amdgcn_exp2f(p0[r] - mn_); ps_ += p0[r]; } \
        _Pragma("unroll") for (int r = 0; r < 16; ++r) { p1[r] = __builtin_amdgcn_exp2f(p1[r] - mn_); ps_ += p1[r]; } \
        { auto rr = __builtin_amdgcn_permlane32_swap(__float_as_uint(ps_), __float_as_uint(ps_), false, false); ps_ = __uint_as_float(rr[0]) + __uint_as_float(rr[1]); } \
        l_reg = l_reg * alpha_ + ps_; \
        PK4(p0, 0, pa0); PK4(p0, 8, pa1); PK4(p1, 0, pa2); PK4(p1, 8, pa3); \
        if (__any(alpha_ < 1.f)) { if (hi == 0) al_l[r32] = alpha_; asm volatile("s_waitcnt lgkmcnt(0)" ::: "memory"); \
            _Pragma("unroll") for (int d_ = 0; d_ < 4; ++d_) _Pragma("unroll") for (int r = 0; r < 16; ++r) o[d_][r] *= al_l[crow(r, hi)]; } \
        SBAR(); pv_tile<KB>(o, vb0, pa0, pa1, pa2, pa3); \
        if (more_) { asm volatile("s_waitcnt vmcnt(0)" ::: "memory"); SWRITE((KB) ^ 1); } \
        __syncthreads(); } while (0)
#define PK4(P, B_, OUT) do { unsigned a0 = cvtpk(P[B_+0], P[B_+1]), a1 = cvtpk(P[B_+2], P[B_+3]);                          \
        unsigned b0 = cvtpk(P[B_+4], P[B_+5]), b1 = cvtpk(P[B_+6], P[B_+7]);                                             \
        auto r0 = __builtin_amdgcn_permlane32_swap(a0, b0, false, false); auto r1 = __builtin_amdgcn_permlane32_swap(a1, b1, false, false); \
        u32x4 w = {r0[0], r1[0], r0[1], r1[1]}; OUT = __builtin_bit_cast(bf16x8, w); } while (0)
#pragma unroll 1
        for (int t = 0; t < NT; t += 2) { STEP(t, 0); STEP(t + 1, 1); }
#undef STEP
#undef PK4
#undef SLOAD
#undef SWRITE
        if (hi == 0) li_l[r32] = l_reg; asm volatile("s_waitcnt lgkmcnt(0)" ::: "memory");
        float rli[16];
#pragma unroll
        for (int r = 0; r < 16; ++r) rli[r] = __builtin_amdgcn_rcpf(li_l[crow(r, hi)]);
        bf16_t* Ow = A.Op + (size_t)(qlo) * 2048; asm volatile("" : "+v"(Ow));
        if (MODE != 1) {
#pragma unroll
            for (int r = 0; r < 16; ++r) { const int orow = crow(r, hi);
#pragma unroll
                for (int d0 = 0; d0 < 4; ++d0) { const float v = o[d0][r] * rli[r]; const float vn = __shfl_xor(v, 1);
                    if ((r32 & 1) == 0) *(unsigned*)(Ow + (size_t)orow * 2048 + d0 * 32 + r32) = cvtpk(v, vn); } }
        } else if (pass == 0) {
#pragma unroll
            for (int d0 = 0; d0 < 4; ++d0)
#pragma unroll
                for (int r = 0; r < 16; r += 4) *(f32x4*)(A.stash + tid * 64 + d0 * 16 + r) = (f32x4){o[d0][r] * rli[r], o[d0][r + 1] * rli[r + 1], o[d0][r + 2] * rli[r + 2], o[d0][r + 3] * rli[r + 3]};
        } else {
            float ss[16];
#pragma unroll
            for (int d0 = 0; d0 < 4; ++d0)
#pragma unroll
                for (int r = 0; r < 16; r += 4) { const f32x4 sv = *(const f32x4*)(A.stash + tid * 64 + d0 * 16 + r);
#pragma unroll
                    for (int j = 0; j < 4; ++j) o[d0][r + j] = sv[j] - A.lam * (o[d0][r + j] * rli[r + j]); }
#pragma unroll
            for (int r = 0; r < 16; ++r) { float s = 0.f;
#pragma unroll
                for (int d0 = 0; d0 < 4; ++d0) { const float v = o[d0][r]; s += v * v; }
                s += __shfl_xor(s, 1); s += __shfl_xor(s, 2); s += __shfl_xor(s, 4); s += __shfl_xor(s, 8); s += __shfl_xor(s, 16);
                ss[r] = __builtin_amdgcn_rsqf(s * (1.f / 128.f) + RMS_EPS) * A.post;
                if ((r & 3) == 3) asm volatile("" ::: "memory"); }
#pragma unroll
            for (int d0 = 0; d0 < 4; ++d0) { const float gs = A.gsub[d0 * 32 + r32];
#pragma unroll
                for (int r = 0; r < 16; ++r) { const int orow = crow(r, hi); const float v = o[d0][r] * ss[r] * gs; const float vn = __shfl_xor(v, 1);
                    if ((r32 & 1) == 0) *(unsigned*)(Ow + (size_t)orow * 2048 + d0 * 32 + r32) = cvtpk(v, vn); } }
        }
        __syncthreads();
    }
}
#undef SBAR
}

#define XB_TMO      128
#define XB_XCNT(j)  (256  + 64 * (j))
#define XB_XSUB(j)  (1280 + 64 * (j))
#define XB_XGEN(j)  (2304 + 64 * (j))
#define XB_TOP      3328
#define XB_TOPGEN   3392
#define XCD_BAR_WORDS 3456
#define XB_SPIN_CAP (1u << 20)

__device__ __forceinline__ unsigned xb_ld(unsigned* p)              { return __hip_atomic_load(p, __ATOMIC_RELAXED, __HIP_MEMORY_SCOPE_AGENT); }
__device__ __forceinline__ unsigned xb_add(unsigned* p, unsigned v) { return __hip_atomic_fetch_add(p, v, __ATOMIC_RELAXED, __HIP_MEMORY_SCOPE_AGENT); }
__device__ __forceinline__ unsigned xb_xcc_id() { return (unsigned)__builtin_amdgcn_s_getreg((3 << 11) | 20) & 0xFu; }
#define XB_SPIN(cond, bar) do { unsigned _sp = 0; while (cond) { __builtin_amdgcn_s_sleep(1); \
    if ((++_sp & 255u) == 0u) { if (xb_ld(&(bar)[XB_TMO])) break; if (_sp > XB_SPIN_CAP) { atomicAdd(&(bar)[XB_TMO], 1u); break; } } } } while (0)

struct XcdBarrier {
    unsigned* bar; unsigned x;
    volatile LAS unsigned* st;
};

__device__ __forceinline__ XcdBarrier xcd_barrier_post(unsigned* bar, volatile LAS unsigned* st) {
    XcdBarrier b; b.bar = bar; b.x = xb_xcc_id(); b.st = st;
    if (threadIdx.x == 0) (void)xb_add(&bar[XB_XCNT(b.x)], 1u);
    return b;
}
__device__ __forceinline__ void xcd_barrier_complete(unsigned* bar, unsigned x, unsigned& nloc, unsigned& nx) {
    const unsigned G = gridDim.x * gridDim.y * gridDim.z;
    unsigned sum, cnt, mine, sp = 0u;
    for (;;) {
        sum = 0u; cnt = 0u; mine = 0u;
#pragma unroll
        for (unsigned j = 0; j < 16; ++j) { const unsigned c = xb_ld(&bar[XB_XCNT(j)]); sum += c; cnt += (c > 0u) ? 1u : 0u; mine = (j == x) ? c : mine; }
        if (sum == G) break;
        __builtin_amdgcn_s_sleep(1);
        if ((++sp & 255u) == 0u) { if (xb_ld(&bar[XB_TMO])) break; if (sp > XB_SPIN_CAP) { atomicAdd(&bar[XB_TMO], 1u); break; } }
    }
    nloc = mine > 0u ? mine : 1u; nx = cnt > 0u ? cnt : 1u;
}

__device__ __forceinline__ void xcd_barrier(const XcdBarrier& b) {
    asm volatile("s_waitcnt vmcnt(0)" ::: "memory");
    __syncthreads();
    if (threadIdx.x == 0) {
        unsigned* bar = b.bar; asm volatile("" : "+s"(bar));
        __builtin_amdgcn_s_waitcnt(0);
        unsigned nloc = b.st[0], nx = b.st[1];
        if (nloc == 0u) { xcd_barrier_complete(bar, b.x, nloc, nx); b.st[0] = nloc; b.st[1] = nx; }
        const unsigned old = xb_add(&bar[XB_XSUB(b.x)], 1u);
        const unsigned gen = old / nloc;
        if (old + 1u == (gen + 1u) * nloc) {
            __builtin_amdgcn_fence(__ATOMIC_RELEASE, "agent");
            asm volatile("s_waitcnt vmcnt(0)" ::: "memory");
            const unsigned og = xb_add(&bar[XB_TOP], 1u);
            const unsigned tg = og / nx;
            if (og + 1u == (tg + 1u) * nx) xb_add(&bar[XB_TOPGEN], 1u);
            else XB_SPIN(xb_ld(&bar[XB_TOPGEN]) == tg, bar);
            __builtin_amdgcn_fence(__ATOMIC_ACQUIRE, "agent");
            xb_add(&bar[XB_XGEN(b.x)], 1u);
            asm volatile("s_waitcnt vmcnt(0)" ::: "memory");
        } else {
            XB_SPIN(xb_ld(&bar[XB_XGEN(b.x)]) == gen, bar);
            __builtin_amdgcn_fence(__ATOMIC_ACQUIRE, "agent");
            asm volatile("s_waitcnt vmcnt(0)" ::: "memory");
        }
    }
    __syncthreads();
}
#define RLX_AGENT __ATOMIC_RELAXED, __HIP_MEMORY_SCOPE_AGENT
#define LDS_WAIT() asm volatile("s_waitcnt lgkmcnt(0)" ::: "memory")
DI unsigned f2bf(float f) { unsigned u = __builtin_bit_cast(unsigned, f); return (u + 0x7fffu + ((u >> 16) & 1u)) >> 16; }
DI unsigned pk2(float lo, float hi) { return f2bf(lo) | (f2bf(hi) << 16); }

struct MapPlain { DI int src(int n) const { return n; } DI float scale(int) const { return 1.f; } };
struct MapWin {
    DI int src(int n) const {
        if (n < 1536) return 1860 + n;
        if (n < 2048) return 5956 + (n - 1536);
        if (n < 3584) return 3396 + (n - 2048);
        if (n < 3840) return 1536 + (n - 3584);
        if (n < 3904) return 1792 + (n - 3840);
        if (n < 3908) return 1856 + (n - 3904);
        if (n < 3912) return 6468 + (n - 3908);
        if (n < 4096) return -1;
        if (n < 5632) return n - 4096;
        if (n < 6144) return 4932 + (n - 5632);
        return 5444 + (n - 6144);
    }
    DI float scale(int n) const { return n < 512 ? 0.125f * LOG2E : 1.f; }
};
constexpr float QSCALE128 = 0.08838834764831845f * LOG2E;
struct MapGate {
    DI int src(int n) const { const int pn = n >> 8, c = n & 255; const int g = 2 * (c >> 7) + ((c >> 4) & 1), dl = 16 * ((c >> 5) & 3) + (c & 15); return g * 2048 + 64 * pn + dl; }
    DI float scale(int) const { return 1.f; }
};
template <class Map>
DI void transpose_item(const float* W, int K, int Nsrc, int nblk  , bf16_t* WT, const Map& map, LAS float* scr, int item, int lane) {
    const int kb = item / nblk, nb = item % nblk, k0 = 64 * kb, n0 = 32 * nb;
    const int nd = n0 + (lane & 31); const int s = map.src(nd); const float scl = map.scale(nd);
#pragma unroll 8
    for (int i = 0; i < 32; ++i) { const int kk = 2 * i + (lane >> 5); scr[kk * 33 + (lane & 31)] = (s >= 0) ? W[(size_t)(k0 + kk) * Nsrc + s] * scl : 0.f; }
    LDS_WAIT(); asm volatile("" ::: "memory");
    const int c = lane & 7;
#pragma unroll
    for (int j = 0; j < 4; ++j) { const int n = (lane >> 3) + 8 * j; const LAS float* sp = scr + (8 * c) * 33 + n;
        u32x4 o; o.x = pk2(sp[0 * 33], sp[1 * 33]); o.y = pk2(sp[2 * 33], sp[3 * 33]); o.z = pk2(sp[4 * 33], sp[5 * 33]); o.w = pk2(sp[6 * 33], sp[7 * 33]);
        *(u32x4*)(WT + (size_t)(n0 + n) * K + k0 + 8 * c) = o; }
    LDS_WAIT(); asm volatile("" ::: "memory");
}
constexpr float WG8_SCALE = 64.f;
template <class Map>
DI void transpose_item8(const float* W, int K, int Nsrc, int nblk, unsigned char* WT, const Map& map, int noff  , LAS float* scr, int item, int lane) {
    const int kb = item / nblk, nb = item % nblk, k0 = 64 * kb, n0 = 32 * nb;
    const int nd = noff + n0 + (lane & 31); const int s = map.src(nd); const float scl = map.scale(nd) * WG8_SCALE;
#pragma unroll 8
    for (int i = 0; i < 32; ++i) { const int kk = 2 * i + (lane >> 5); scr[kk * 33 + (lane & 31)] = (s >= 0) ? W[(size_t)(k0 + kk) * Nsrc + s] * scl : 0.f; }
    LDS_WAIT(); asm volatile("" ::: "memory");
#pragma unroll
    for (int j = 0; j < 2; ++j) { const int q = lane + 64 * j, n = q >> 2, c = q & 3; const LAS float* sp = scr + (16 * c) * 33 + n;
        int o[4];
#pragma unroll
        for (int e = 0; e < 4; ++e) { int w = 0; w = __builtin_amdgcn_cvt_pk_fp8_f32(sp[(4 * e + 0) * 33], sp[(4 * e + 1) * 33], w, false); w = __builtin_amdgcn_cvt_pk_fp8_f32(sp[(4 * e + 2) * 33], sp[(4 * e + 3) * 33], w, true); o[e] = w; }
        *(u32x4*)(WT + (size_t)(n0 + n) * K + k0 + 16 * c) = (u32x4){(unsigned)o[0], (unsigned)o[1], (unsigned)o[2], (unsigned)o[3]}; }
    LDS_WAIT(); asm volatile("" ::: "memory");
}
DI void mod_partial_item(const float* c, const float* wada, float* modp, int item, int lane) {
    const int kc = item & 15, nb = (item >> 4) % 48, l = item / (16 * 48);
    const int k0 = kc * 128, n0 = nb * 256 + 4 * lane;
    const float* Wl = wada + (size_t)l * 2048 * 12288;
    f32x4 acc[8];
#pragma unroll
    for (int b = 0; b < 8; ++b) acc[b] = (f32x4){0.f, 0.f, 0.f, 0.f};
#pragma unroll 1
    for (int sub = 0; sub < 2; ++sub) {
        float cb[8];
#pragma unroll
        for (int b = 0; b < 8; ++b) { const float x = c[b * 2048 + k0 + 64 * sub + lane]; cb[b] = x / (1.f + __expf(-x)); }
#pragma unroll 8
        for (int kk = 0; kk < 64; ++kk) { const f32x4 w = *(const f32x4*)(Wl + (size_t)(k0 + 64 * sub + kk) * 12288 + n0);
#pragma unroll
            for (int b = 0; b < 8; ++b) { const float s = __builtin_bit_cast(float, __builtin_amdgcn_readlane(__builtin_bit_cast(int, cb[b]), kk)); acc[b] += s * w; } }
    }
#pragma unroll
    for (int b = 0; b < 8; ++b) *(f32x4*)(modp + ((size_t)(kc * 2 + l) * 8 + b) * 12288 + n0) = acc[b];
}
template <bool F8>
DI void norm_row(const float* xrow, bf16_t* orow, unsigned char* orow8, const f32x4 (&Av)[8], const f32x4 (&Bv)[8], int lane) {
    const f32x4* xr = (const f32x4*)xrow + lane;
    f32x4 v[8]; float s = 0.f;
#pragma unroll
    for (int j = 0; j < 8; ++j) { v[j] = xr[64 * j]; s += (v[j][0] * v[j][0] + v[j][1] * v[j][1]) + (v[j][2] * v[j][2] + v[j][3] * v[j][3]); }
    const float rstd = 1.f / sqrtf(wave_sum(s) * (1.f / 2048.f) + RMS_EPS);
    u32x2* o8 = (u32x2*)orow + lane;
#pragma unroll
    for (int j = 0; j < 8; ++j) { const f32x4 h = v[j] * rstd * Av[j] + Bv[j]; u32x2 w; w.x = cvtpk(h[0], h[1]); w.y = cvtpk(h[2], h[3]); o8[64 * j] = w;
        if (F8) { int q = 0; q = __builtin_amdgcn_cvt_pk_fp8_f32(h[0], h[1], q, false); q = __builtin_amdgcn_cvt_pk_fp8_f32(h[2], h[3], q, true); ((int*)orow8)[lane + 64 * j] = q; } }
}
DI void final_row(float* xrow, const f32x4 (&Gv)[8], int lane) {
    f32x4* xr = (f32x4*)xrow + lane;
    f32x4 v[8]; float s = 0.f;
#pragma unroll
    for (int j = 0; j < 8; ++j) { v[j] = xr[64 * j]; s += (v[j][0] * v[j][0] + v[j][1] * v[j][1]) + (v[j][2] * v[j][2] + v[j][3] * v[j][3]); }
    const float rstd = 1.f / sqrtf(wave_sum(s) * (1.f / 2048.f) + RMS_EPS);
#pragma unroll
    for (int j = 0; j < 8; ++j) xr[64 * j] = v[j] * rstd * Gv[j];
}
DI void conv_task(const bf16_t* qkv, const float* cw, bf16_t* br, int row0, int lane) {
    const int ch = lane * 8;
    float w0[8], w1[8], w2[8];
#pragma unroll
    for (int j = 0; j < 8; ++j) { w0[j] = cw[ch + j]; w1[j] = cw[512 + ch + j]; w2[j] = cw[1024 + ch + j]; }
    float up2[8], up1[8];
    const bf16_t* rp = qkv + (size_t)row0 * LDQ + ch;
    auto load_u = [&](const bf16_t* r, float (&u)[8]) {
        const bf16x8 cg = *(const bf16x8*)(r + C_CG), xi = *(const bf16x8*)(r + C_XIN);
#pragma unroll
        for (int j = 0; j < 8; ++j) u[j] = bf2f((bf16_t)cg[j]) * bf2f((bf16_t)xi[j]);
    };
    if ((row0 & (SEQ - 1)) == 0) {
#pragma unroll
        for (int j = 0; j < 8; ++j) { up2[j] = 0.f; up1[j] = 0.f; }
    } else { load_u(rp - 2 * LDQ, up2); load_u(rp - LDQ, up1); }
    bf16_t* op = br + (size_t)row0 * 2048 + 1024 + ch;
#pragma unroll
    for (int i = 0; i < 8; ++i) { float u[8]; load_u(rp, u);
        const bf16x8 bg = *(const bf16x8*)(rp + C_BG);
        rp += LDQ; asm volatile("" : "+v"(rp));
        float y[8];
#pragma unroll
        for (int j = 0; j < 8; ++j) y[j] = bf2f((bf16_t)bg[j]) * (w0[j] * up2[j] + w1[j] * up1[j] + w2[j] * u[j]);
        u32x4 o; o.x = cvtpk(y[0], y[1]); o.y = cvtpk(y[2], y[3]); o.z = cvtpk(y[4], y[5]); o.w = cvtpk(y[6], y[7]);
        *(u32x4*)op = o; op += 2048; asm volatile("" : "+v"(op));
#pragma unroll
        for (int j = 0; j < 8; ++j) { up2[j] = up1[j]; up1[j] = u[j]; } }
}
DI void fcum_task(const bf16_t* qkvb  , float bf_h, int h, float* out  , int lane) {
    const bf16_t* p0 = qkvb + (size_t)(32 * lane) * LDQ + C_FD + h;
    float run = 0.f;
    { const bf16_t* p = p0;
#pragma unroll 1
      for (int i = 0; i < 32; ++i) { const float x = bf2f(*p) + bf_h; p += LDQ; run += fminf(x, 0.f) - log1pf(expf(-fabsf(x))); } }
    float incl = run;
#pragma unroll
    for (int o = 1; o < 64; o <<= 1) { const float y = __shfl_up(incl, o); if (lane >= o) incl += y; }
    float acc = incl - run;
    { const bf16_t* p = p0; float* op = out + 32 * lane;
#pragma unroll 1
      for (int i = 0; i < 32; ++i) { const float x = bf2f(*p) + bf_h; p += LDQ; acc += fminf(x, 0.f) - log1pf(expf(-fabsf(x))); op[i] = acc * LOG2E; } }
}
DI int rowsum16(int x) { x += __shfl_xor(x, 8); x += __shfl_xor(x, 4); x += __shfl_xor(x, 2); x += __shfl_xor(x, 1); return x; }
DI void select_task(const bf16_t* qkvb  , unsigned long long* mrow  , int t0, LAS unsigned long long* wl, int lane_in) {
    int lane = lane_in; asm volatile("" : "+v"(lane));
    const int fr = lane & 15, fq = lane >> 4, t = t0 + fq;
    const int nch = __builtin_amdgcn_readfirstlane((t0 + 3) / 512 + 1);
    const bf16_t* ap = qkvb + (size_t)(t0 + (fr >> 2)) * LDQ + C_IQ + (fr & 3) * 64 + fq * 8;
    const bf16x8 a0 = *(const bf16x8*)ap, a1 = *(const bf16x8*)(ap + 32);
    float w[4]; { const u32x2 ww = *(const u32x2*)(qkvb + (size_t)t * LDQ + C_IW);
        w[0] = __uint_as_float(ww.x << 16) * IDX_SCALE; w[1] = __uint_as_float(ww.x & 0xffff0000u) * IDX_SCALE; w[2] = __uint_as_float(ww.y << 16) * IDX_SCALE; w[3] = __uint_as_float(ww.y & 0xffff0000u) * IDX_SCALE; }
    unsigned u[128];
    const int tf = t - fr;
    const char* kbase = (const char*)qkvb + C_IK * 2;
    unsigned voff = (unsigned)(fr * LDQ + fq * 8) * 2u;
#pragma unroll
    for (int c = 0; c < 4; ++c) {
        if (c < nch) {
#pragma unroll
            for (int ii = 0; ii < 32; ++ii) { const int i = c * 32 + ii;
                const bf16x8 b0 = *(const bf16x8*)(kbase + voff), b1 = *(const bf16x8*)(kbase + voff + 64);
                voff += 16 * LDQ * 2; asm volatile("" : "+v"(voff));
                f32x4 acc = (f32x4){0.f, 0.f, 0.f, 0.f};
                acc = __builtin_amdgcn_mfma_f32_16x16x32_bf16(a0, b0, acc, 0, 0, 0);
                acc = __builtin_amdgcn_mfma_f32_16x16x32_bf16(a1, b1, acc, 0, 0, 0);
                const float sc = ((w[0] * fmaxf(acc[0], 0.f) + w[1] * fmaxf(acc[1], 0.f)) + w[2] * fmaxf(acc[2], 0.f)) + w[3] * fmaxf(acc[3], 0.f);
                unsigned bits = __float_as_uint(sc); if (bits == 0x80000000u) bits = 0u;
                const unsigned key = (bits & 0x80000000u) ? ~bits : (bits | 0x80000000u);
                u[i] = (16 * i <= tf) ? key : 0u; }
        } else {
#pragma unroll
            for (int ii = 0; ii < 32; ++ii) u[c * 32 + ii] = 0u;
        }
    }
#define CNT_GE(cnt, x, c) asm("v_cmp_ge_u32 vcc, %1, %2\n\tv_addc_co_u32 %0, vcc, 0, %0, vcc" : "+v"(cnt) : "v"(x), "v"(c) : "vcc")
#define CNT_GT(cnt, x, c) asm("v_cmp_gt_u32 vcc, %1, %2\n\tv_addc_co_u32 %0, vcc, 0, %0, vcc" : "+v"(cnt) : "v"(x), "v"(c) : "vcc")
#define FOR_CHUNKS(BODY) _Pragma("unroll") for (int c_ = 0; c_ < 4; ++c_) { if (c_ < nch) { _Pragma("unroll") for (int ii_ = 0; ii_ < 32; ++ii_) { const int i = c_ * 32 + ii_; BODY; } } }
    unsigned T = 0u;
#pragma unroll 1
    for (int bit = 31; bit >= 0; --bit) { const unsigned c = T | (1u << bit); int cnt = 0;
        FOR_CHUNKS(CNT_GE(cnt, u[i], c));
        cnt = rowsum16(cnt); if (cnt >= 256) T = c; }
    int cgt = 0, cge = 0;
    FOR_CHUNKS(CNT_GT(cgt, u[i], T); CNT_GE(cge, u[i], T));
    cgt = rowsum16(cgt); cge = rowsum16(cge);
    const int need = 256 - cgt; const bool tie = (cge - cgt) > need;
    int X0 = 4095;
    if (__any(tie)) { int x = 0; const unsigned notT = ~T;
#pragma unroll 1
        for (int bit = 10; bit >= 0; --bit) { const int c = x | (1 << bit); int g = 0; const int cf = c - fr;
            FOR_CHUNKS(unsigned tmp;
                asm("v_cmp_lt_i32 vcc, %6, %3\n\tv_cndmask_b32 %1, %4, %2, vcc\n\tv_cmp_eq_u32 vcc, %1, %5\n\tv_addc_co_u32 %0, vcc, 0, %0, vcc"
                    : "+v"(g), "=&v"(tmp) : "v"(u[i]), "v"(cf), "v"(notT), "v"(T), "n"(16 * i) : "vcc"));
            g = rowsum16(g); if (g < need) x = c; }
        if (tie) X0 = x; }
#undef CNT_GE
#undef CNT_GT
    const int xf = X0 - fr;
    FOR_CHUNKS(const bool sel = (u[i] > T) || (u[i] == T && 16 * i <= xf);
        const unsigned long long bal = __ballot(sel); if (lane == 0) wl[i] = bal;
        if ((i & 3) == 3) asm volatile("" ::: "memory"));
#undef FOR_CHUNKS
    LDS_WAIT(); asm volatile("" ::: "memory");
#pragma unroll
    for (int half = 0; half < 2; ++half) { const int j = fr + 16 * half; unsigned long long word = 0ull;
        if (j < nch * 8) {
#pragma unroll
            for (int i4 = 0; i4 < 4; ++i4) word |= ((wl[4 * j + i4] >> (16 * fq)) & 0xFFFFull) << (16 * i4); }
        mrow[(size_t)t * 32 + j] = word; }
    LDS_WAIT(); asm volatile("" ::: "memory");
}
DI void select_causal_task(unsigned long long* mrow, int t0, int lane) {
    const int fr = lane & 15, fq = lane >> 4, t = t0 + fq;
#pragma unroll
    for (int half = 0; half < 2; ++half) { const int j = fr + 16 * half; const int n = t - 64 * j + 1;
        const unsigned long long word = n >= 64 ? ~0ull : (n <= 0 ? 0ull : ((1ull << n) - 1ull));
        mrow[(size_t)t * 32 + j] = word; }
}
DI void select_any(const bf16_t* qkvb, unsigned long long* mrow, int t0, LAS unsigned long long* wl, int lane) {
    if (t0 + 3 < 256) select_causal_task(mrow, t0, lane);
    else select_task(qkvb, mrow, t0, wl, lane);
}

constexpr size_t MiB = 1u << 20;
constexpr size_t WS_CTL = 0, CTL_ZERO_BYTES = 1 * MiB;
constexpr size_t WS_MODF = 1 * MiB;
constexpr size_t WS_MODP = 2 * MiB;
constexpr size_t WS_FCUM = 14 * MiB;
constexpr size_t WS_MASK = 15 * MiB;
constexpr size_t WS_STASH = 20 * MiB;
constexpr size_t WS_W = 52 * MiB;
constexpr size_t OW_IN = 0, OW_IN8 = 16 * MiB  , OW_G = 26 * MiB, OW_B = 58 * MiB, OW_O = 66 * MiB, OW_1 = 74 * MiB, OW_2 = 106 * MiB, LW_BYTES = 138 * MiB;
constexpr size_t WS_H = WS_W + 2 * LW_BYTES;
constexpr size_t WS_BR = WS_H + 64 * MiB;
constexpr size_t WS_R1 = WS_BR + 64 * MiB;
constexpr size_t WS_H8 = WS_R1 + 256 * MiB;
constexpr size_t WS_END = WS_H8 + 32 * MiB;
constexpr int CW_BAR = 4096;
constexpr int CW_QUEUE = 16384;

constexpr int RING_OFF = 0, RING_BYTES = 131072;
constexpr int LDSCTL_OFF = RING_BYTES, MISC_OFF = LDSCTL_OFF + 320;
constexpr int LDS_BYTES = 147456;
static_assert(att::LDS_END <= RING_BYTES, "attention scratch inside the ring region");


constexpr int NWAVES = 8;
constexpr int N_PHASES = 23;
struct Args { const float* in[19]; float* out; unsigned char* ws; int ph_lo, ph_hi; };

typedef __attribute__((address_space(4))) const unsigned char* kargp_t;
DI kargp_t karg_base() { kargp_t kp = (kargp_t)__builtin_amdgcn_kernarg_segment_ptr(); asm volatile("" : "+s"(kp)); return kp; }
typedef const float* cfptr_t; typedef float* fptr_t; typedef unsigned char* ucptr_t;
DI const float* karg_in(int i) { return *(const __attribute__((address_space(4))) cfptr_t*)(karg_base() + 8 * i); }
DI float* karg_out() { return *(const __attribute__((address_space(4))) fptr_t*)(karg_base() + 8 * 19); }
DI unsigned char* karg_ws() { return *(const __attribute__((address_space(4))) ucptr_t*)(karg_base() + 8 * 20); }
#define ARG_IN(i) karg_in(i)

template <int MODE>
DI void attn_queue(LAS unsigned char* lds, volatile LAS unsigned* MISC, int qidx, int l, int tid, int lane) {
    unsigned char* ws = karg_ws();
    unsigned* qhead = (unsigned*)(ws + WS_CTL) + CW_QUEUE + 64 * qidx;
    bf16_t* QKV = (bf16_t*)(ws + WS_R1); bf16_t* BR = (bf16_t*)(ws + WS_BR);
    float lamv = 0.f, post = 0.f;
    if (MODE == 1) { const float* lq = ARG_IN(8) + l * 256; const float a = wave_sum(lq[lane] * lq[64 + lane]), b = wave_sum(lq[128 + lane] * lq[192 + lane]);
        const float lam_init = 0.8f - 0.6f * expf(-0.3f * (float)l); lamv = expf(a) - expf(b) + lam_init; post = 1.f - lam_init; }
    for (;;) {
        if (tid == 0) MISC[0] = __hip_atomic_fetch_add(qhead, 1u, RLX_AGENT);
        __syncthreads();
        const unsigned u = MISC[0];
        __syncthreads();
        if (u >= 256u) break;
        const int qb = 7 - (int)(u >> 5), bh = (int)(u & 31u), b = bh >> 2, h = bh & 3;
        att::UnitArgs A;
        const size_t rowb = (size_t)b * SEQ;
        const int cq = MODE == 0 ? C_QA : (MODE == 1 ? C_QB : C_QD), ck = MODE == 0 ? C_KA : (MODE == 1 ? C_KB : C_KD), cv = MODE == 0 ? C_VA : (MODE == 1 ? C_VB : C_VD);
        const int oc = MODE == 0 ? 0 : (MODE == 1 ? 512 : 1536);
        A.Qp = QKV + rowb * LDQ + cq + h * 128; A.Kp = QKV + rowb * LDQ + ck + h * 128; A.Vp = QKV + rowb * LDQ + cv + h * 128;
        A.Op = BR + rowb * 2048 + oc + h * 128; A.q0 = qb * 256;
        A.maskp = (const unsigned long long*)(ws + WS_MASK) + rowb * 32;
        A.fcum = (const float*)(ws + WS_FCUM) + (size_t)(b * 4 + h) * SEQ;
        A.relb = ARG_IN(10); A.relcol = (MODE == 1 ? 4 : 0) + h;
        A.lam = lamv; A.post = post; A.gsub = ARG_IN(9) + l * 128;
        A.stash = (float*)(ws + WS_STASH) + (size_t)blockIdx.x * 64 * 512;
        att::attn_unit<MODE>((LAS char*)lds, A);
    }
}

#define IN(k) (lo <= (k) && (k) < hi)
#define SEAM(k) do { if (IN((k) + 1)) xcd_barrier(bar); } while (0)
#define PH_PTRS int tid_p = threadIdx.x; asm volatile("" : "+v"(tid_p)); const int tid = tid_p, lane = tid & 63; (void)lane; unsigned char* ws = karg_ws(); float* xbuf = karg_out(); float* modf = (float*)(ws + WS_MODF); float* modp = (float*)(ws + WS_MODP); \
    bf16_t* Hb = (bf16_t*)(ws + WS_H); bf16_t* BR = (bf16_t*)(ws + WS_BR); bf16_t* R1 = (bf16_t*)(ws + WS_R1); \
    (void)xbuf; (void)modf; (void)modp; (void)Hb; (void)BR; (void)R1
#define PH_LAYER PH_PTRS; unsigned char* wl_ = ws + WS_W + (size_t)l * LW_BYTES; const float* modl = modf + (size_t)l * 8 * 12288; (void)wl_; (void)modl
template <int l, int LO, int HI>
DI void layer_phases(LAS unsigned char* lds, volatile LAS unsigned* MISC, const XcdBarrier& bar, int wave, int G, int bx, int gw, int NGW) {
    constexpr int lo = LO, hi = HI;
        const int pb = 2 + 10 * l;
        if (IN(pb + 0)) { PH_LAYER;
            const float* xs = (l == 0) ? ARG_IN(0) : (const float*)xbuf; const float* g1 = ARG_IN(4) + l * 2048;
#ifndef PROBE_REP_N1
#define PROBE_REP_N1 1
#endif
#pragma unroll 1
          for (int rep = 0; rep < PROBE_REP_N1; ++rep)
            for (int rb = gw; rb < M_TOK / 8; rb += NGW) { const int b = (rb * 8) / SEQ; f32x4 Av[8], Bv[8];
#pragma unroll
                for (int j = 0; j < 8; ++j) { const int c = 4 * lane + 256 * j; const f32x4 g = *(const f32x4*)(g1 + c), sc = *(const f32x4*)(modl + b * 12288 + 2048 + c); Av[j] = g * (sc + 1.f); Bv[j] = *(const f32x4*)(modl + b * 12288 + c); }
#pragma unroll 1
                for (int i = 0; i < 8; ++i) norm_row<true>(xs + (size_t)(rb * 8 + i) * 2048, Hb + (size_t)(rb * 8 + i) * 2048, ws + WS_H8 + (size_t)(rb * 8 + i) * 2048, Av, Bv, lane); }
            SEAM(pb + 0);
        }
        if (IN(pb + 1)) { PH_LAYER;
            { pg8::Gemm g{(const bf16_t*)(ws + WS_H8), (const bf16_t*)(wl_ + OW_IN8), M_TOK, N_IN8, 1024, 1024, 1024, 1 << 30, 0}; pg8::StaticOrder S; S.init(M_TOK, N_IN8, G, bx);
              pg8::EpiBf16s E{R1 + N_IN16, LDQ, 1.f / WG8_SCALE, QSCALE128 / WG8_SCALE, 0xC3u};
              pg8::gemm_phase<pg8::EpiBf16s, pg8::StaticOrder, true, true, true>(lds + RING_OFF, g, S, E); }
            { pg8::Gemm g{Hb, (const bf16_t*)(wl_ + OW_IN), M_TOK, N_IN16, 2048, 2048, 2048, 1 << 30, 0}; pg8::StaticOrder S; S.init(M_TOK, N_IN16, G, bx);
              pg8::EpiBf16<0> E{R1, LDQ};
              pg8::gemm_phase<pg8::EpiBf16<0>, pg8::StaticOrder, true, true>(lds + RING_OFF, g, S, E); }
            SEAM(pb + 1);
        }
        if (IN(pb + 2)) { PH_LAYER;
            LAS unsigned long long* wlq = (LAS unsigned long long*)(lds + RING_OFF) + wave * 128;
            unsigned long long* mask = (unsigned long long*)(ws + WS_MASK);
#ifndef PROBE_REP_M1
#define PROBE_REP_M1 1
#endif
#pragma unroll 1
          for (int rep = 0; rep < PROBE_REP_M1; ++rep)
            for (int k = gw; k < 2048; k += NGW) {
#pragma unroll 1
                for (int pass = 0; pass < 2; ++pass) { const int kk = pass ? 4095 - k : k; const int b = kk & 7, t0 = (kk >> 3) * 4;
#ifndef NO_SELECT
                    select_any(R1 + (size_t)b * SEQ * LDQ, mask + (size_t)b * SEQ * 32, t0, wlq, lane);
#endif
                } }
#ifndef NO_CONV
            for (int rb = gw; rb < M_TOK / 8; rb += NGW) conv_task(R1, ARG_IN(7) + l * 1536, BR, rb * 8, lane);
#endif
#ifndef NO_FCUM
            for (int k = gw; k < 32; k += NGW) { const int b = k >> 2, h = k & 3; fcum_task(R1 + (size_t)b * SEQ * LDQ, ARG_IN(6)[l * 4 + h], h, (float*)(ws + WS_FCUM) + (size_t)k * SEQ, lane); }
#endif
            SEAM(pb + 2);
        }
        if (IN(pb + 3)) { PH_LAYER;
#ifndef PROBE_REP_M2
#define PROBE_REP_M2 1
#endif
#pragma unroll 1
          for (int rep = 0; rep < PROBE_REP_M2; ++rep) {
            if (rep) xcd_barrier(bar);
            attn_queue<1>(lds + RING_OFF, MISC, 3 * l + 0 + 6 * rep, l, tid, lane);
            attn_queue<0>(lds + RING_OFF, MISC, 3 * l + 1 + 6 * rep, l, tid, lane);
            attn_queue<2>(lds + RING_OFF, MISC, 3 * l + 2 + 6 * rep, l, tid, lane);
          }
            SEAM(pb + 3);
        }
        if (IN(pb + 4)) { PH_LAYER;
            pg8::Gemm g{BR, (const bf16_t*)(wl_ + OW_B), M_TOK, 8192, 512, 2048, 512, 8, 512}; pg8::StaticOrder S; S.init(M_TOK, 8192, G, bx);
            pg8::EpiBf16<0> E{R1, 8192};

#ifndef NO_G2
#ifndef PROBE_REP_G2
#define PROBE_REP_G2 1
#endif
#pragma unroll 1
            for (int rep = 0; rep < PROBE_REP_G2; ++rep)
            pg8::gemm_phase<pg8::EpiBf16<0>, pg8::StaticOrder, true, true>(lds + RING_OFF, g, S, E);
#endif
            SEAM(pb + 4);
        }
        if (IN(pb + 5)) { PH_LAYER;
            pg8::Gemm g{(const bf16_t*)(ws + WS_H8), (const bf16_t*)(wl_ + OW_G), M_TOK, 8192, 1024, 1024, 1024, 1 << 30, 0}; pg8::StaticOrder S; S.init(M_TOK, 8192, G, bx);
            pg8::EpiGate E{R1, ARG_IN(12) + l * 8192, BR, 1.f / WG8_SCALE};

#ifndef NO_G3
#ifndef PROBE_REP_G3
#define PROBE_REP_G3 1
#endif
#pragma unroll 1
            for (int rep = 0; rep < PROBE_REP_G3; ++rep)
            pg8::gemm_phase<pg8::EpiGate, pg8::StaticOrder, true, true, true>(lds + RING_OFF, g, S, E);
#endif

            SEAM(pb + 5);
        }
        if (IN(pb + 6)) { PH_LAYER;
            pg8::Gemm g{BR, (const bf16_t*)(wl_ + OW_O), M_TOK, 2048, 2048, 2048, 2048, 1 << 30, 0}; pg8::StaticOrder S; S.init(M_TOK, 2048, G, bx);
            pg8::EpiResid E{(l == 0) ? ARG_IN(0) : (const float*)xbuf, xbuf, modl + 4096, 12288};

#ifndef NO_G4
#ifdef PROBE_NULL_G4
            { pg8::EpiNull EN{(float*)(ws + WS_FCUM)}; pg8::gemm_phase<pg8::EpiNull, pg8::StaticOrder, true, true>(lds + RING_OFF, g, S, EN); }
#endif
            pg8::gemm_phase<pg8::EpiResid, pg8::StaticOrder, true, true>(lds + RING_OFF, g, S, E);
#endif
            SEAM(pb + 6);
        }
        if (IN(pb + 7)) { PH_LAYER;
            const float* g2 = ARG_IN(15) + l * 2048;
            for (int rb = gw; rb < M_TOK / 8; rb += NGW) { const int b = (rb * 8) / SEQ; f32x4 Av[8], Bv[8];
#pragma unroll
                for (int j = 0; j < 8; ++j) { const int c = 4 * lane + 256 * j; const f32x4 g = *(const f32x4*)(g2 + c), sc = *(const f32x4*)(modl + b * 12288 + 8192 + c); Av[j] = g * (sc + 1.f); Bv[j] = *(const f32x4*)(modl + b * 12288 + 6144 + c); }
#pragma unroll 1
                for (int i = 0; i < 8; ++i) norm_row<false>(xbuf + (size_t)(rb * 8 + i) * 2048, Hb + (size_t)(rb * 8 + i) * 2048, nullptr, Av, Bv, lane); }
            SEAM(pb + 7);
        }
        if (IN(pb + 8)) { PH_LAYER;
            pg8::Gemm g{Hb, (const bf16_t*)(wl_ + OW_1), M_TOK, 8192, 2048, 2048, 2048, 1 << 30, 0}; pg8::StaticOrder S; S.init(M_TOK, 8192, G, bx);
            pg8::EpiBf16<2> E{R1, 8192};

#ifndef NO_G5
#ifdef PROBE_NULL_G5
            { pg8::EpiNull EN{(float*)(ws + WS_FCUM)}; pg8::gemm_phase<pg8::EpiNull, pg8::StaticOrder, true, true>(lds + RING_OFF, g, S, EN); }
#endif
#ifdef PROBE_SPLIT_G5
            { pg8::RangeOrder S1; S1.init(M_TOK, 8192, G, bx); S1.i0 = 0; S1.n = 4; pg8::RangeOrder S2; S2.init(M_TOK, 8192, G, bx); S2.i0 = 4; S2.n = 4;
              pg8::gemm_phase<pg8::EpiBf16<2>, pg8::RangeOrder, true, true>(lds + RING_OFF, g, S1, E);
              xcd_barrier(bar);
              pg8::gemm_phase<pg8::EpiBf16<2>, pg8::RangeOrder, true, true>(lds + RING_OFF, g, S2, E); }
#else
            pg8::gemm_phase<pg8::EpiBf16<2>, pg8::StaticOrder, true, true>(lds + RING_OFF, g, S, E);
#endif
#endif

            SEAM(pb + 8);
        }
        if (IN(pb + 9)) { PH_LAYER;
            pg8::Gemm g{R1, (const bf16_t*)(wl_ + OW_2), M_TOK, 2048, 8192, 8192, 8192, 1 << 30, 0}; pg8::StaticOrder S; S.init(M_TOK, 2048, G, bx);
            pg8::EpiResid E{xbuf, xbuf, modl + 10240, 12288};

#ifndef NO_G6
#ifdef PROBE_DUP_G6
            { pg8::EpiResid ED{xbuf, (float*)(ws + WS_H), modl + 10240, 12288}; pg8::gemm_phase<pg8::EpiResid, pg8::StaticOrder, true, true>(lds + RING_OFF, g, S, ED); }
#endif
#ifdef PROBE_NULL_G6
            { pg8::EpiNull EN{(float*)(ws + WS_FCUM)}; pg8::gemm_phase<pg8::EpiNull, pg8::StaticOrder, true, true>(lds + RING_OFF, g, S, EN); }
#endif
            pg8::gemm_phase<pg8::EpiResid, pg8::StaticOrder, true, true>(lds + RING_OFF, g, S, E);
#endif
            SEAM(pb + 9);
        }
}

template <int LO, int HI>
__global__ void __launch_bounds__(NWAVES * 64, 2) mk_fwd(Args args) {
    extern __shared__ __attribute__((aligned(16))) unsigned char lds_raw[];
    LAS unsigned char* lds = (LAS unsigned char*)lds_raw;
    volatile LAS unsigned* MISC = (volatile LAS unsigned*)(lds + MISC_OFF);
    const int tid0 = threadIdx.x, wave = __builtin_amdgcn_readfirstlane(tid0 >> 6);
    const int G = gridDim.x; const int bx = blockIdx.x; const int vcu = (G % 8 == 0) ? (bx % 8) * (G / 8) + bx / 8 : bx;
    const int gw = vcu * NWAVES + wave, NGW = G * NWAVES;
    for (int u = tid0; u < (LDS_BYTES - LDSCTL_OFF) / 4; u += NWAVES * 64) ((LAS unsigned*)(lds + LDSCTL_OFF))[u] = 0u;
    __syncthreads();
    constexpr int lo = LO, hi = HI; (void)args;
    XcdBarrier bar; bar.bar = (unsigned*)(karg_ws() + WS_CTL) + CW_BAR; bar.x = 0; bar.st = nullptr;
    if constexpr (hi - lo > 1) bar = xcd_barrier_post((unsigned*)(karg_ws() + WS_CTL) + CW_BAR, MISC + 8);

    if (IN(0)) { PH_PTRS;
        LAS float* scr = (LAS float*)(lds + RING_OFF + wave * 16384);
#ifndef PROBE_REP_P0
#define PROBE_REP_P0 1
#endif
#pragma unroll 1
        for (int rep = 0; rep < PROBE_REP_P0; ++rep) {
        constexpr int I_IN = 32 * 208, I_G = 32 * 256, I_B = 4 * 8 * 64, I_O = 32 * 64, I_1 = 32 * 256, I_2 = 128 * 64, I_L = I_IN + I_G + I_B + I_O + I_1 + I_2;
        for (int it = gw; it < 2 * I_L; it += NGW) {
            const int l = it / I_L; int r = it % I_L;
            unsigned char* wl_ = ws + WS_W + (size_t)l * LW_BYTES;
            if (r < 32 * 128) { transpose_item(ARG_IN(5) + (size_t)l * 2048 * 6472, 2048, 6472, 128, (bf16_t*)(wl_ + OW_IN), MapWin(), scr, r, lane); continue; } r -= 32 * 128;
            if (r < 32 * 80) { transpose_item8(ARG_IN(5) + (size_t)l * 2048 * 6472, 2048, 6472, 80, (unsigned char*)(wl_ + OW_IN8), MapWin(), N_IN16, scr, r, lane); continue; } r -= 32 * 80;
            if (r < I_G) { transpose_item8(ARG_IN(11) + (size_t)l * 2048 * 8192, 2048, 8192, 256, (unsigned char*)(wl_ + OW_G), MapGate(), 0, scr, r, lane); continue; } r -= I_G;
            const float* W; int K, Ns, nblk; bf16_t* WT;
            if (r < I_B) { const int g = r / 512; r -= g * 512; W = ARG_IN(13) + (size_t)(l * 4 + g) * 512 * 2048; K = 512; Ns = 2048; nblk = 64; WT = (bf16_t*)(wl_ + OW_B) + (size_t)g * 2048 * 512; }
            else { r -= I_B;
                if (r < I_O) { W = ARG_IN(14) + (size_t)l * 2048 * 2048; K = 2048; Ns = 2048; nblk = 64; WT = (bf16_t*)(wl_ + OW_O); }
                else { r -= I_O;
                    if (r < I_1) { W = ARG_IN(16) + (size_t)l * 2048 * 8192; K = 2048; Ns = 8192; nblk = 256; WT = (bf16_t*)(wl_ + OW_1); }
                    else { r -= I_1; W = ARG_IN(17) + (size_t)l * 8192 * 2048; K = 8192; Ns = 2048; nblk = 64; WT = (bf16_t*)(wl_ + OW_2); } } }
            transpose_item(W, K, Ns, nblk, WT, MapPlain(), scr, r, lane);
        }
        for (int it = gw; it < 2 * 48 * 16; it += NGW) mod_partial_item(ARG_IN(1), ARG_IN(2), modp, it, lane);
        }
        SEAM(0);
    }
    if (IN(1)) { PH_PTRS;
        for (int i = bx * 512 + tid; i < 2 * 8 * 12288; i += G * 512) { const int n = i % 12288, l = i / (8 * 12288);
            float s = ARG_IN(3)[l * 12288 + n];
#pragma unroll
            for (int kc = 0; kc < 16; ++kc) s += modp[(size_t)kc * (2 * 8 * 12288) + i];
            modf[i] = s; }
        SEAM(1);
    }
    constexpr int L_LO = (LO <= 2) ? 0 : (LO - 2) / 10, L_HI = (HI >= 22) ? NLAYER : (HI - 2 + 9) / 10;
    if constexpr (L_LO <= 0 && 0 < L_HI) layer_phases<0, LO, HI>(lds, MISC, bar, wave, G, bx, gw, NGW);
    if constexpr (L_LO <= 1 && 1 < L_HI) layer_phases<1, LO, HI>(lds, MISC, bar, wave, G, bx, gw, NGW);
    if (IN(22)) { PH_PTRS;
        f32x4 Gv[8];
#pragma unroll
        for (int j = 0; j < 8; ++j) Gv[j] = *(const f32x4*)(ARG_IN(18) + 4 * lane + 256 * j);
        for (int rb = gw; rb < M_TOK / 8; rb += NGW) {
#pragma unroll 1
            for (int i = 0; i < 8; ++i) final_row(xbuf + (size_t)(rb * 8 + i) * 2048, Gv, lane); }
    }
}

#if !MK_ONE_LAUNCH
template <int P> static void set_attr_from() { if constexpr (P < N_PHASES) { (void)hipFuncSetAttribute((const void*)mk_fwd<P, P + 1>, hipFuncAttributeMaxDynamicSharedMemorySize, LDS_BYTES); set_attr_from<P + 1>(); } }
template <int P> static void launch_from(int grid, hipStream_t stream, Args a) {
    if constexpr (P < N_PHASES) { a.ph_lo = P; a.ph_hi = P + 1; hipLaunchKernelGGL((mk_fwd<P, P + 1>), dim3(grid), dim3(NWAVES * 64), LDS_BYTES, stream, a); launch_from<P + 1>(grid, stream, a); } }
#endif
extern "C" void kernel_launch(void* const* d_in, const int* in_sizes, int n_in, void* d_out, int out_size, void* d_ws, size_t ws_size, hipStream_t stream) {
    static int grid = 0;
    if (grid == 0) {
        if (n_in != 19 || in_sizes[0] != M_TOK * DM || out_size != M_TOK * DM || ws_size < WS_END) {
            fprintf(stderr, "kernel_launch: shape / workspace mismatch (n_in %d, in0 %d, out %d, ws %zu, need %zu); nothing launched\n", n_in, n_in > 0 ? in_sizes[0] : -1, out_size, ws_size, (size_t)WS_END); grid = -1; return; }
        int dev = 0, cus = 0, per_cu = 0;
        if (hipGetDevice(&dev) != hipSuccess || hipDeviceGetAttribute(&cus, hipDeviceAttributeMultiprocessorCount, dev) != hipSuccess) { fprintf(stderr, "kernel_launch: device query failed\n"); grid = -1; return; }
#if MK_ONE_LAUNCH
        if (hipFuncSetAttribute((const void*)mk_fwd<0, N_PHASES>, hipFuncAttributeMaxDynamicSharedMemorySize, LDS_BYTES) != hipSuccess) { fprintf(stderr, "kernel_launch: hipFuncSetAttribute failed\n"); grid = -1; return; }
        if (hipOccupancyMaxActiveBlocksPerMultiprocessor(&per_cu, (const void*)mk_fwd<0, N_PHASES>, NWAVES * 64, LDS_BYTES) != hipSuccess || per_cu < 1) fprintf(stderr, "kernel_launch: occupancy query reports %d workgroups per CU\n", per_cu);
#else
        set_attr_from<0>();
#endif
        (void)hipGetLastError();
        grid = cus;
    }
    if (grid < 0) return;
    if (hipMemsetAsync((char*)d_ws + WS_CTL, 0, CTL_ZERO_BYTES, stream) != hipSuccess) { fprintf(stderr, "kernel_launch: memset failed\n"); return; }
    Args a{};
    for (int i = 0; i < 19; ++i) a.in[i] = (const float*)d_in[i];
    a.out = (float*)d_out; a.ws = (unsigned char*)d_ws;
#if MK_ONE_LAUNCH
    a.ph_lo = 0; a.ph_hi = N_PHASES;
    hipLaunchKernelGGL((mk_fwd<0, N_PHASES>), dim3(grid), dim3(NWAVES * 64), LDS_BYTES, stream, a);
#else
    launch_from<0>(grid, stream, a);
#endif
    const hipError_t le = hipPeekAtLastError();
    if (le != hipSuccess) fprintf(stderr, "kernel_launch: launch failed: %s\n", hipGetErrorName(le));
}
```

```cpp
#define ATT_V1 1
#include <hip/hip_runtime.h>
#include <cstdio>
#include <cstdint>

#ifndef MK_ONE_LAUNCH
#define MK_ONE_LAUNCH 1
#endif

#define DI __device__ __forceinline__
#define LAS __attribute__((address_space(3)))
#define GAS __attribute__((address_space(1)))

namespace pg8 {
#define PG8_LAS __attribute__((address_space(3)))
typedef unsigned short bf16_t;
typedef short bf16x8 __attribute__((ext_vector_type(8)));
typedef float f32x4 __attribute__((ext_vector_type(4)));
typedef float f32x2 __attribute__((ext_vector_type(2)));
typedef unsigned u32x4 __attribute__((ext_vector_type(4)));
typedef unsigned u32x2 __attribute__((ext_vector_type(2)));
typedef int i32x8a __attribute__((ext_vector_type(8), aligned(16)));
constexpr int BM = 256, BK = 64, HALF = 128, HTB = HALF * BK * 2  , STAGE_BYTES = 8 * HTB, NXCD = 8, WGM = 8;

__host__ __device__ __forceinline__ int lds_byte(int r, int c) { const int st = (r >> 4) * 2 + (c >> 5), rr = r & 15, cc = c & 31, ob = rr * 64 + cc * 2; return st * 1024 + (ob ^ (((ob >> 9) & 1) << 5)); }
__host__ __device__ __forceinline__ void stage_rc(int b, int& R, int& C) { const int st = b / 1024, sb = b % 1024, swz = sb ^ (((sb >> 9) & 1) << 5); R = (st >> 1) * 16 + swz / 64; C = (st & 1) * 32 + (swz % 64) / 2; }
__host__ __device__ __forceinline__ int perm32(int rho) { const int n = rho >> 4, i = rho & 15; return 8 * (i >> 2) + 4 * n + (i & 3); }

struct Unit { int pm, pn; };
struct Gemm { const bf16_t* A; const bf16_t* Bt; int M, N, K, lda, ldb, agdiv, agoff; };

struct StaticOrder {
    int nM, nN, nwg, G, c; bool rev;
    __host__ __device__ void init(int M, int N, int G_, int c_) { nM = M / BM; nN = N / BM; nwg = nM * nN; G = G_; c = c_; rev = false; }
    __host__ __device__ bool next(int i, Unit& u) const {
        const long L = (long)i * G + c; if (L >= nwg) return false;
        int wgid = (int)L; { const int q = nwg / NXCD, r = nwg % NXCD, xcd = wgid % NXCD, off = wgid / NXCD; wgid = (xcd < r ? xcd * (q + 1) : r * (q + 1) + (xcd - r) * q) + off; }
        const int nig = WGM * nN, gid = wgid / nig, fm = gid * WGM, gsz = (nM - fm) < WGM ? (nM - fm) : WGM;
        u.pm = fm + ((wgid % nig) % gsz); u.pn = (wgid % nig) / gsz; if (rev) u.pm = nM - 1 - u.pm; return true;
    }
    __device__ __forceinline__ void a_ready(const Unit&) const {}
    __device__ __forceinline__ void done(const Unit&) const {}
};

struct RangeOrder : StaticOrder {
    int i0, n;
    __host__ __device__ bool next(int i, Unit& u) const { if (i >= n) return false; return StaticOrder::next(i + i0, u); }
};
__device__ __forceinline__ unsigned cvt_pk_bf16(float lo, float hi) { unsigned r; asm volatile("v_cvt_pk_bf16_f32 %0, %1, %2" : "=v"(r) : "v"(lo), "v"(hi)); return r; }

template <int ACT> struct EpiBf16 {
    static constexpr bool PERM = true, AFTER_DRAIN = false;
    bf16_t* O; int ldc;
    __device__ __forceinline__ void operator()(const f32x4 (&acc)[2][2][4][2], const Unit& u, int wr, int wc, int fr, int fq) const {
        const int row0 = u.pm * BM + wr * 64 + fr; const int col0 = u.pn * BM + wc * 32 + 8 * fq;
#pragma unroll
        for (int ai = 0; ai < 2; ++ai)
#pragma unroll
            for (int m = 0; m < 4; ++m) { bf16_t* rowp = O + (size_t)(row0 + ai * HALF + m * 16) * ldc + col0;
#pragma unroll
                for (int bj = 0; bj < 2; ++bj) { f32x4 v0 = acc[ai][bj][m][0], v1 = acc[ai][bj][m][1];
                    if (ACT == 2) {
#pragma unroll
                        for (int j = 0; j < 4; ++j) { const float a = fmaxf(v0[j], 0.f), b = fmaxf(v1[j], 0.f); v0[j] = a * a; v1[j] = b * b; } }
                    u32x4 w; w.x = cvt_pk_bf16(v0[0], v0[1]); w.y = cvt_pk_bf16(v0[2], v0[3]); w.z = cvt_pk_bf16(v1[0], v1[1]); w.w = cvt_pk_bf16(v1[2], v1[3]);
                    *(u32x4*)(rowp + bj * HALF) = w; } }
    }
};
struct EpiNull {
    static constexpr bool PERM = true, AFTER_DRAIN = false;
    float* sink;
    __device__ __forceinline__ void operator()(const f32x4 (&acc)[2][2][4][2], const Unit& u, int wr, int wc, int fr, int fq) const {
        f32x4 s = (f32x4){0.f, 0.f, 0.f, 0.f};
#pragma unroll
        for (int ai = 0; ai < 2; ++ai)
#pragma unroll
            for (int bj = 0; bj < 2; ++bj)
#pragma unroll
                for (int m = 0; m < 4; ++m)
#pragma unroll
                    for (int n = 0; n < 2; ++n) s += acc[ai][bj][m][n];
        if (s[0] + s[1] + s[2] + s[3] == 1.2345678e33f) sink[u.pm] = s[0];
    }
};
struct EpiPtile {
    static constexpr bool PERM = true, AFTER_DRAIN = false; static constexpr int NVM = 16;
    bf16_t* O;
    __device__ __forceinline__ void operator()(const f32x4 (&acc)[2][2][4][2], const Unit& u, int wr, int wc, int fr, int fq) const {
        const int g = u.pn >> 3;
#pragma unroll
        for (int bj = 0; bj < 2; ++bj) { const int d = (u.pn & 7) * BM + bj * HALF + wc * 32 + 8 * fq;
            bf16_t* blk = O + (((size_t)(u.pm * 32 + (d >> 6)) * 4 + g) * 4 + ((d >> 4) & 3)) * (256 * 16) + (d & 15);
#pragma unroll
            for (int ai = 0; ai < 2; ++ai)
#pragma unroll
                for (int m = 0; m < 4; ++m) { const f32x4 v0 = acc[ai][bj][m][0], v1 = acc[ai][bj][m][1];
                    u32x4 w; w.x = cvt_pk_bf16(v0[0], v0[1]); w.y = cvt_pk_bf16(v0[2], v0[3]); w.z = cvt_pk_bf16(v1[0], v1[1]); w.w = cvt_pk_bf16(v1[2], v1[3]);
                    *(u32x4*)(blk + (size_t)(ai * HALF + wr * 64 + m * 16 + fr) * 16) = w; } }
    }
};
struct EpiBf16s {
    static constexpr bool PERM = true, AFTER_DRAIN = false;
    bf16_t* O; int ldc; float sd, sq; unsigned qmask;
    __device__ __forceinline__ void operator()(const f32x4 (&acc)[2][2][4][2], const Unit& u, int wr, int wc, int fr, int fq) const {
        const int row0 = u.pm * BM + wr * 64 + fr; const int col0 = u.pn * BM + wc * 32 + 8 * fq; const float sc = ((qmask >> u.pn) & 1u) ? sq : sd;
#pragma unroll
        for (int ai = 0; ai < 2; ++ai)
#pragma unroll
            for (int m = 0; m < 4; ++m) { bf16_t* rowp = O + (size_t)(row0 + ai * HALF + m * 16) * ldc + col0;
#pragma unroll
                for (int bj = 0; bj < 2; ++bj) { const f32x4 v0 = acc[ai][bj][m][0] * sc, v1 = acc[ai][bj][m][1] * sc;
                    u32x4 w; w.x = cvt_pk_bf16(v0[0], v0[1]); w.y = cvt_pk_bf16(v0[2], v0[3]); w.z = cvt_pk_bf16(v1[0], v1[1]); w.w = cvt_pk_bf16(v1[2], v1[3]);
                    *(u32x4*)(rowp + bj * HALF) = w; } }
    }
};
struct EpiBf16ik {
    static constexpr bool PERM = true, AFTER_DRAIN = false;
    bf16_t* O; int ldc; bf16_t* IK;
    __device__ __forceinline__ void operator()(const f32x4 (&acc)[2][2][4][2], const Unit& u, int wr, int wc, int fr, int fq) const {
        const int row0 = u.pm * BM + wr * 64 + fr; const int col0 = u.pn * BM + wc * 32 + 8 * fq;
        const bool ikt = (u.pn == 15) && (wc < 2);
#pragma unroll
        for (int ai = 0; ai < 2; ++ai)
#pragma unroll
            for (int m = 0; m < 4; ++m) { const int row = row0 + ai * HALF + m * 16; bf16_t* rowp = O + (size_t)row * ldc + col0;
#pragma unroll
                for (int bj = 0; bj < 2; ++bj) { const f32x4 v0 = acc[ai][bj][m][0], v1 = acc[ai][bj][m][1];
                    u32x4 w; w.x = cvt_pk_bf16(v0[0], v0[1]); w.y = cvt_pk_bf16(v0[2], v0[3]); w.z = cvt_pk_bf16(v1[0], v1[1]); w.w = cvt_pk_bf16(v1[2], v1[3]);
                    *(u32x4*)(rowp + bj * HALF) = w;
                    if (bj == 0 && ikt) *(u32x4*)(IK + ((size_t)(row >> 4) * 2 + wc) * 512 + (fq * 16 + fr) * 8) = w; } }
    }
};
struct EpiResid {
    static constexpr bool PERM = false, AFTER_DRAIN = false;
    const float* xin; float* xout; const float* gate; int gstride;
    __device__ __forceinline__ void operator()(const f32x4 (&acc)[2][2][4][2], const Unit& u, int wr, int wc, int fr, int fq) const {
        const int b = u.pm >> 3; const int col0 = u.pn * BM + wc * 32 + 4 * fq;
        f32x4 gv[2][2];
#pragma unroll
        for (int bj = 0; bj < 2; ++bj)
#pragma unroll
            for (int n = 0; n < 2; ++n) gv[bj][n] = *(const f32x4*)(gate + (size_t)b * gstride + col0 + bj * HALF + n * 16);
#pragma unroll
        for (int ai = 0; ai < 2; ++ai)
#pragma unroll
            for (int m = 0; m < 4; ++m) { const size_t off = (size_t)(u.pm * BM + ai * HALF + wr * 64 + m * 16 + fr) * 2048 + col0;
#pragma unroll
                for (int bj = 0; bj < 2; ++bj)
#pragma unroll
                    for (int n = 0; n < 2; ++n) { const f32x4 x = *(const f32x4*)(xin + off + bj * HALF + n * 16);
                        *(f32x4*)(xout + off + bj * HALF + n * 16) = x + gv[bj][n] * acc[ai][bj][m][n]; }
                if (m == 3) asm volatile("" ::: "memory"); }
    }
};
template <bool XF32> struct EpiResidB {
    static constexpr bool PERM = true, AFTER_DRAIN = false;
    const void* xin; bf16_t* xout; const float* gate; int gstride;
    __device__ __forceinline__ void operator()(const f32x4 (&acc)[2][2][4][2], const Unit& u, int wr, int wc, int fr, int fq) const {
        const int b = u.pm >> 3; const int col0 = u.pn * BM + wc * 32 + 8 * fq;
        f32x4 gv[2][2];
#pragma unroll
        for (int bj = 0; bj < 2; ++bj)
#pragma unroll
            for (int n = 0; n < 2; ++n) gv[bj][n] = *(const f32x4*)(gate + (size_t)b * gstride + col0 + bj * HALF + n * 4);
#pragma unroll
        for (int ai = 0; ai < 2; ++ai)
#pragma unroll
            for (int m = 0; m < 4; ++m) { const size_t off = (size_t)(u.pm * BM + ai * HALF + wr * 64 + m * 16 + fr) * 2048 + col0;
#pragma unroll
                for (int bj = 0; bj < 2; ++bj) { f32x4 x0, x1;
                    if (XF32) { x0 = *(const f32x4*)((const float*)xin + off + bj * HALF); x1 = *(const f32x4*)((const float*)xin + off + bj * HALF + 4); }
                    else { const u32x4 xw = *(const u32x4*)((const bf16_t*)xin + off + bj * HALF);
                        x0 = (f32x4){__uint_as_float(xw.x << 16), __uint_as_float(xw.x & 0xffff0000u), __uint_as_float(xw.y << 16), __uint_as_float(xw.y & 0xffff0000u)};
                        x1 = (f32x4){__uint_as_float(xw.z << 16), __uint_as_float(xw.z & 0xffff0000u), __uint_as_float(xw.w << 16), __uint_as_float(xw.w & 0xffff0000u)}; }
                    const f32x4 y0 = x0 + gv[bj][0] * acc[ai][bj][m][0], y1 = x1 + gv[bj][1] * acc[ai][bj][m][1];
                    u32x4 w; w.x = cvt_pk_bf16(y0[0], y0[1]); w.y = cvt_pk_bf16(y0[2], y0[3]); w.z = cvt_pk_bf16(y1[0], y1[1]); w.w = cvt_pk_bf16(y1[2], y1[3]);
                    *(u32x4*)(xout + off + bj * HALF) = w; }
                if (m == 3) asm volatile("" ::: "memory"); }
    }
};
struct EpiGate {
    static constexpr bool PERM = false, AFTER_DRAIN = false;
    const bf16_t* P; const float* bgate; bf16_t* O; float ascale;
    __device__ __forceinline__ void operator()(const f32x4 (&acc)[2][2][4][2], const Unit& u, int wr, int wc, int fr, int fq) const {
        const int d0 = u.pn * 64 + wc * 16 + 4 * fq;
        f32x4 bv[2][2];
#pragma unroll
        for (int bj = 0; bj < 2; ++bj)
#pragma unroll
            for (int n = 0; n < 2; ++n) bv[bj][n] = *(const f32x4*)(bgate + (2 * bj + n) * 2048 + d0);
#pragma unroll
        for (int ai = 0; ai < 2; ++ai)
#pragma unroll
            for (int m = 0; m < 4; ++m) { const size_t row = (size_t)(u.pm * BM + ai * HALF + wr * 64 + m * 16 + fr);
                f32x4 s = (f32x4){0.f, 0.f, 0.f, 0.f};
#pragma unroll
                for (int bj = 0; bj < 2; ++bj)
#pragma unroll
                    for (int n = 0; n < 2; ++n) { const u32x2 pw = *(const u32x2*)(P + ((((size_t)(u.pm * 32 + u.pn) * 4 + (2 * bj + n)) * 4 + wc) * 256 + (ai * HALF + wr * 64 + m * 16 + fr)) * 16 + 4 * fq);
                        const f32x4 pv = (f32x4){__uint_as_float(pw.x << 16), __uint_as_float(pw.x & 0xffff0000u), __uint_as_float(pw.y << 16), __uint_as_float(pw.y & 0xffff0000u)};
                        const f32x4 x = acc[ai][bj][m][n] * ascale + bv[bj][n];
#pragma unroll
                        for (int j = 0; j < 4; ++j) { const float sg = __builtin_amdgcn_rcpf(1.f + __builtin_amdgcn_exp2f(-1.4426950408889634f * x[j])); s[j] += sg * pv[j]; } }
                u32x2 w; w.x = cvt_pk_bf16(s[0], s[1]); w.y = cvt_pk_bf16(s[2], s[3]);
                *(u32x2*)(O + row * 2048 + d0) = w;
                if (m & 1) asm volatile("" ::: "memory"); }
    }
};

template <class Epi, class Sched, bool ALIGN_EPI = false, bool SP2 = false, bool FP8 = false>
__device__ __forceinline__ void gemm_phase(PG8_LAS unsigned char* lds, const Gemm g, const Sched& S, const Epi& E) {
    int tid_l = threadIdx.x; asm volatile("" : "+v"(tid_l));
    const int tid = tid_l, wid = __builtin_amdgcn_readfirstlane(tid >> 6), lane = tid & 63, wr = wid >> 2, wc = wid & 3, fr = lane & 15, fq = lane >> 4;
    const int K = g.K, nt = K / BK;
    unsigned voffA[2], voffB[2];
#pragma unroll
    for (int i = 0; i < 2; ++i) { int R, C; stage_rc(tid * 16 + i * 8192, R, C); const int Rb = Epi::PERM ? ((R & ~31) + perm32(R & 31)) : R;
        voffA[i] = (unsigned)(R * g.lda + C) * 2u; voffB[i] = (unsigned)(Rb * g.ldb + C) * 2u; }
    const size_t kstep = (size_t)(BK * 2);
    const size_t hstepA = (size_t)HALF * g.lda * 2, hstepB = (size_t)HALF * g.ldb * 2;
    const size_t tstepA = 2 * hstepA, tstepB = 2 * hstepB;
    const unsigned ldsw = (unsigned)wid * 1024u;
    const int aoff = FP8 ? lds_byte(wr * 64 + fr, fq * 16) : lds_byte(wr * 64 + fr, fq * 8), boff = FP8 ? lds_byte(wc * 32 + fr, fq * 16) : lds_byte(wc * 32 + fr, fq * 8);
#define PG8_SA(b, h) (((b) * 2 + (h)) * HTB)
#define PG8_SB(b, h) ((4 + (b) * 2 + (h)) * HTB)
#define PG8_STAGE(bufoff, gbase, voff) do { _Pragma("unroll") for (int _i = 0; _i < 2; ++_i) \
        __builtin_amdgcn_global_load_lds((const unsigned*)((const char*)(gbase) + (voff)[_i]), (PG8_LAS unsigned*)(lds + (bufoff) + ldsw + _i * 8192), 16, 0, 0); } while (0)
#define PG8_LDA(dst, b, h) do { if constexpr (FP8) { _Pragma("unroll") for (int m = 0; m < 4; ++m) dst##8[m] = *(const PG8_LAS i32x8a*)(lds + PG8_SA(b, h) + aoff + m * 2048); } \
        else { _Pragma("unroll") for (int m = 0; m < 4; ++m) _Pragma("unroll") for (int k = 0; k < 2; ++k) dst[m][k] = *(const PG8_LAS bf16x8*)(lds + PG8_SA(b, h) + aoff + m * 2048 + k * 1024); } } while (0)
#define PG8_LDB(dst, b, h) do { if constexpr (FP8) { _Pragma("unroll") for (int n = 0; n < 2; ++n) dst##8[n] = *(const PG8_LAS i32x8a*)(lds + PG8_SB(b, h) + boff + n * 2048); } \
        else { _Pragma("unroll") for (int n = 0; n < 2; ++n) _Pragma("unroll") for (int k = 0; k < 2; ++k) dst[n][k] = *(const PG8_LAS bf16x8*)(lds + PG8_SB(b, h) + boff + n * 2048 + k * 1024); } } while (0)
#define PG8_MMA(ai, bj, At, Bt) do { __builtin_amdgcn_s_setprio(1); \
        if constexpr (FP8) { _Pragma("unroll") for (int m = 0; m < 4; ++m) _Pragma("unroll") for (int n = 0; n < 2; ++n) \
            asm volatile("v_mfma_scale_f32_16x16x128_f8f6f4 %0, %1, %2, %0, %3, %3 op_sel_hi:[0,0,0]" : "+v"(acc[ai][bj][m][n]) : "v"(Bt##8[n]), "v"(At##8[m]), "v"(sc1)); } \
        else { _Pragma("unroll") for (int m = 0; m < 4; ++m) _Pragma("unroll") for (int n = 0; n < 2; ++n) _Pragma("unroll") for (int k = 0; k < 2; ++k) \
            acc[ai][bj][m][n] = __builtin_amdgcn_mfma_f32_16x16x32_bf16(Bt[n][k], At[m][k], acc[ai][bj][m][n], 0, 0, 0); } \
        __builtin_amdgcn_s_setprio(0); } while (0)
#define PG8_WAIT_V(n) asm volatile("s_waitcnt vmcnt(" #n ")" ::: "memory")
#define PG8_WAIT_L(n) asm volatile("s_waitcnt lgkmcnt(" #n ")" ::: "memory")
#define PG8_BAR __builtin_amdgcn_s_barrier()
#define PG8_SCHED __builtin_amdgcn_sched_barrier(0)
    Unit cur, nxt; int ui = 0;
    if (!S.next(0, cur)) return;
    f32x4 acc[2][2][4][2];
#pragma unroll
    for (int a = 0; a < 2; ++a)
#pragma unroll
        for (int b = 0; b < 2; ++b)
#pragma unroll
            for (int m = 0; m < 4; ++m)
#pragma unroll
                for (int n = 0; n < 2; ++n) acc[a][b][m][n] = (f32x4){0.f, 0.f, 0.f, 0.f};
    bf16x8 At[4][2], B0[2][2], B1[2][2];
    i32x8a At8[4], B08[2], B18[2];
    int sc1 = 0x7F7F7F7F; asm volatile("" : "+v"(sc1));
    const char* cA = (const char*)g.A + (size_t)cur.pm * tstepA + (size_t)(cur.pn / g.agdiv) * (size_t)g.agoff * 2; const char* cB = (const char*)g.Bt + (size_t)cur.pn * tstepB;
    S.a_ready(cur);
    if constexpr (SP2) {
        PG8_STAGE(PG8_SB(0, 0), cB, voffB); PG8_STAGE(PG8_SB(0, 1), cB + hstepB, voffB); PG8_STAGE(PG8_SA(0, 0), cA, voffA); PG8_STAGE(PG8_SA(0, 1), cA + hstepA, voffA);
        if (wr == 1) PG8_BAR;
        PG8_WAIT_V(2); PG8_BAR;
        PG8_STAGE(PG8_SB(1, 0), cB + kstep, voffB); PG8_STAGE(PG8_SA(1, 0), cA + kstep, voffA); PG8_STAGE(PG8_SB(1, 1), cB + hstepB + kstep, voffB);
        PG8_WAIT_V(6); PG8_BAR;
    } else {
        PG8_STAGE(PG8_SB(0, 0), cB, voffB); PG8_STAGE(PG8_SA(0, 0), cA, voffA); PG8_STAGE(PG8_SB(0, 1), cB + hstepB, voffB); PG8_STAGE(PG8_SA(0, 1), cA + hstepA, voffA);
        if (wr == 1) PG8_BAR;
        PG8_WAIT_V(4); PG8_BAR;
        PG8_STAGE(PG8_SB(1, 0), cB + kstep, voffB); PG8_STAGE(PG8_SA(1, 0), cA + kstep, voffA); PG8_STAGE(PG8_SB(1, 1), cB + hstepB + kstep, voffB);
        PG8_WAIT_V(6); PG8_BAR;
    }
    for (;;) {
        const bool has_next = S.next(ui + 1, nxt);
        const char* nA = has_next ? (const char*)g.A + (size_t)nxt.pm * tstepA + (size_t)(nxt.pn / g.agdiv) * (size_t)g.agoff * 2 : cA; const char* nB = has_next ? (const char*)g.Bt + (size_t)nxt.pn * tstepB : cB;
        for (int t = 0; t < nt; t += 2) {
            const bool last = (t == nt - 2);
            const char* a1 = cA + (size_t)(t + 1) * kstep;
            const char* a2 = last ? nA : cA + (size_t)(t + 2) * kstep; const char* b2 = last ? nB : cB + (size_t)(t + 2) * kstep;
            const char* a3 = a2 + kstep; const char* b3 = b2 + kstep;
            if (last && has_next) S.a_ready(nxt);
            if constexpr (SP2) {
            PG8_LDB(B0, 0, 0); PG8_LDB(B1, 0, 1); PG8_SCHED; PG8_LDA(At, 0, 0); PG8_STAGE(PG8_SA(1, 1), a1 + hstepA, voffA);
            PG8_WAIT_V(8); PG8_WAIT_L(0); PG8_BAR; PG8_MMA(0, 0, At, B0); PG8_MMA(0, 1, At, B1); PG8_BAR; PG8_SCHED;
            PG8_LDA(At, 0, 1); PG8_STAGE(PG8_SB(0, 0), b2, voffB); PG8_STAGE(PG8_SB(0, 1), b2 + hstepB, voffB); PG8_STAGE(PG8_SA(0, 0), a2, voffA);
            PG8_WAIT_V(8); PG8_WAIT_L(0); PG8_BAR; PG8_MMA(1, 0, At, B0); PG8_MMA(1, 1, At, B1); PG8_BAR; PG8_SCHED;
            PG8_LDB(B0, 1, 0); PG8_LDB(B1, 1, 1); PG8_SCHED; PG8_LDA(At, 1, 0); PG8_STAGE(PG8_SA(0, 1), a2 + hstepA, voffA);
            PG8_WAIT_V(8); PG8_WAIT_L(0); PG8_BAR; PG8_MMA(0, 0, At, B0); PG8_MMA(0, 1, At, B1); PG8_BAR; PG8_SCHED;
            PG8_LDA(At, 1, 1); PG8_STAGE(PG8_SB(1, 0), b3, voffB); PG8_STAGE(PG8_SB(1, 1), b3 + hstepB, voffB); PG8_STAGE(PG8_SA(1, 0), a3, voffA);
            PG8_WAIT_V(8); PG8_WAIT_L(0); PG8_BAR; PG8_MMA(1, 0, At, B0); PG8_MMA(1, 1, At, B1); PG8_BAR; PG8_SCHED;
            } else {
            PG8_LDB(B0, 0, 0); PG8_SCHED; PG8_LDA(At, 0, 0); PG8_STAGE(PG8_SA(1, 1), a1 + hstepA, voffA);
            PG8_WAIT_L(8); PG8_BAR; PG8_WAIT_L(0); PG8_MMA(0, 0, At, B0); PG8_BAR; PG8_SCHED;
            PG8_LDB(B1, 0, 1); PG8_STAGE(PG8_SB(0, 0), b2, voffB);
            PG8_BAR; PG8_WAIT_L(0); PG8_MMA(0, 1, At, B1); PG8_BAR;
            PG8_LDA(At, 0, 1); PG8_STAGE(PG8_SA(0, 0), a2, voffA);
            PG8_BAR; PG8_WAIT_L(0); PG8_MMA(1, 0, At, B0); PG8_BAR; PG8_SCHED;
            PG8_STAGE(PG8_SB(0, 1), b2 + hstepB, voffB);
            PG8_WAIT_V(6); PG8_BAR; PG8_MMA(1, 1, At, B1); PG8_BAR;
            PG8_LDB(B0, 1, 0); PG8_SCHED; PG8_LDA(At, 1, 0); PG8_STAGE(PG8_SA(0, 1), a2 + hstepA, voffA);
            PG8_WAIT_L(8); PG8_BAR; PG8_WAIT_L(0); PG8_MMA(0, 0, At, B0); PG8_BAR; PG8_SCHED;
            PG8_LDB(B1, 1, 1); PG8_STAGE(PG8_SB(1, 0), b3, voffB);
            PG8_BAR; PG8_WAIT_L(0); PG8_MMA(0, 1, At, B1); PG8_BAR;
            PG8_LDA(At, 1, 1); PG8_STAGE(PG8_SA(1, 0), a3, voffA);
            PG8_BAR; PG8_WAIT_L(0); PG8_MMA(1, 0, At, B0); PG8_BAR; PG8_SCHED;
            PG8_STAGE(PG8_SB(1, 1), b3 + hstepB, voffB);
            PG8_WAIT_V(6); PG8_BAR; PG8_MMA(1, 1, At, B1); PG8_BAR;
            }
        }
        if constexpr (ALIGN_EPI) { if (wr == 0) PG8_BAR; }
        if constexpr (FP8) asm volatile("s_nop 15\n\ts_nop 7" ::: "memory");
        if constexpr (!Epi::AFTER_DRAIN) { E(acc, cur, wr, wc, fr, fq); S.done(cur); }
        if (!has_next) break;
#pragma unroll
        for (int a = 0; a < 2; ++a)
#pragma unroll
            for (int b = 0; b < 2; ++b)
#pragma unroll
                for (int m = 0; m < 4; ++m)
#pragma unroll
                    for (int n = 0; n < 2; ++n) acc[a][b][m][n] = (f32x4){0.f, 0.f, 0.f, 0.f};
        cur = nxt; cA = nA; cB = nB; ++ui;
        if constexpr (ALIGN_EPI) { if (wr == 1) PG8_BAR; }
    }
    PG8_WAIT_V(0);
    if constexpr (!ALIGN_EPI) { if (wr == 0) PG8_BAR; }
    PG8_BAR;
    if constexpr (Epi::AFTER_DRAIN) { E.fused(acc, cur, wr, wc, fr, fq, lds, wid, lane); S.done(cur); }
#undef PG8_SA
#undef PG8_SB
#undef PG8_STAGE
#undef PG8_LDA
#undef PG8_LDB
#undef PG8_MMA
#undef PG8_WAIT_V
#undef PG8_WAIT_L
#undef PG8_BAR
#undef PG8_SCHED
}
}

constexpr int NB = 8, SEQ = 2048, DM = 2048, M_TOK = NB * SEQ, DFF = 8192, NLAYER = 2;
constexpr int LDQ = 6656;
constexpr int C_QB = 0, C_KB = 512, C_VB = 1024, C_VD = 1536, C_BG = 2048, C_CG = 2560, C_XIN = 3072, C_IQ = 3584, C_IK = 3840, C_IW = 3904, C_FD = 3908,
              C_QA = 4096, C_KA = 4608, C_VA = 5120, C_QD = 5632, C_KD = 6144;
constexpr int N_IN16 = 4096, N_IN8 = LDQ - N_IN16;
constexpr float LOG2E = 1.4426950408889634f;
constexpr float IDX_SCALE = 0.0625f;
constexpr float RMS_EPS = 1e-6f;

typedef unsigned short bf16_t;
typedef short bf16x8 __attribute__((ext_vector_type(8)));
typedef short s16x4 __attribute__((ext_vector_type(4)));
typedef float f32x16 __attribute__((ext_vector_type(16)));
typedef float f32x8 __attribute__((ext_vector_type(8)));
typedef float f32x4 __attribute__((ext_vector_type(4)));
typedef float f32x2 __attribute__((ext_vector_type(2)));
typedef unsigned u32x4 __attribute__((ext_vector_type(4)));
typedef unsigned u32x2 __attribute__((ext_vector_type(2)));

DI float bf2f(bf16_t v) { return __uint_as_float((unsigned)v << 16); }
DI unsigned cvtpk(float lo, float hi) { unsigned r; asm volatile("v_cvt_pk_bf16_f32 %0, %1, %2" : "=v"(r) : "v"(lo), "v"(hi)); return r; }
DI float wave_sum(float v) {
#pragma unroll
    for (int o = 1; o < 64; o <<= 1) v += __shfl_xor(v, o);
    return v;
}

namespace att {
constexpr int SHM_V = 16384, SHM_K = 16384;
constexpr int OFF_V = 0, OFF_K = 2 * SHM_V, OFF_WS = OFF_K + 2 * SHM_K, OFF_TAB = OFF_WS + 8 * 64 * 4, OFF_FK = OFF_TAB + 512, OFF_KN = OFF_FK + 8192, LDS_END = OFF_KN + 128;
#define KSWZ(row, colB) ((row) * 256 + ((colB) ^ (((row) & 7) << 4)))
#define SBAR() __builtin_amdgcn_sched_barrier(0)
DI int v_st(int k, int c) { const int kk = (k & ~0xC) | ((k & 4) << 1) | ((k & 8) >> 1); return ((kk >> 3) * 4 + (c >> 5)) * 512 + ((kk & 7) * 32 + (c & 31)) * 2; }
DI int v_rd_base(int lane) { return ((lane & 3) << 3) | (((lane >> 2) & 3) << 6) | (((lane >> 4) & 1) << 5) | (((lane >> 5) & 1) << 8); }
constexpr int v_rd_off(int d0, int ks, int half) { return d0 * 512 + ks * 4096 + half * 2048; }
DI int crow(int r, int hi) { return (r & 3) + 8 * (r >> 2) + 4 * hi; }

template <int KB, int D0LO, int D0HI>
DI void qkt(f32x16& p0, f32x16& p1, LAS const char* K_lds, int r32, int hi, const bf16x8* qr) {
#pragma unroll
    for (int r = 0; r < 16; ++r) { p0[r] = 0.f; p1[r] = 0.f; }
    LAS const char* kb[4];
#pragma unroll
    for (int dd = 0; dd < 4; ++dd) kb[dd] = K_lds + KB * SHM_K + KSWZ(r32, (dd * 16 + hi * 8) * 2);
#pragma unroll
    for (int d0 = D0LO; d0 < D0HI; ++d0) { LAS const char* a = kb[d0 & 3] + (d0 >> 2) * 128;
        const bf16x8 b0 = *(LAS const bf16x8*)a;
        const bf16x8 b1 = *(LAS const bf16x8*)(a + 32 * 256);
        p0 = __builtin_amdgcn_mfma_f32_32x32x16_bf16(b0, qr[d0 - D0LO], p0, 0, 0, 0);
        p1 = __builtin_amdgcn_mfma_f32_32x32x16_bf16(b1, qr[d0 - D0LO], p1, 0, 0, 0); }
}
template <int VB>
DI void pv_tile(f32x16* o, int vb0, bf16x8 pa0, bf16x8 pa1, bf16x8 pa2, bf16x8 pa3) {
#define TRRD(dst, off) asm volatile("ds_read_b64_tr_b16 %0, %1 offset:%2" : "=&v"(dst) : "v"(vb0), "i"(off) : "memory")
#define PV_D0(d0) do { s16x4 l0, l1, l2, l3, h0, h1, h2, h3; constexpr int b_ = VB * SHM_V + v_rd_off(d0, 0, 0);     \
        TRRD(l0, b_); TRRD(h0, b_ + 2048); TRRD(l1, b_ + 4096); TRRD(h1, b_ + 6144); TRRD(l2, b_ + 8192); TRRD(h2, b_ + 10240); TRRD(l3, b_ + 12288); TRRD(h3, b_ + 14336); \
        asm volatile("s_waitcnt lgkmcnt(0)" ::: "memory"); SBAR();   \
        o[d0] = __builtin_amdgcn_mfma_f32_32x32x16_bf16(pa0, (bf16x8){l0[0], l0[1], l0[2], l0[3], h0[0], h0[1], h0[2], h0[3]}, o[d0], 0, 0, 0);   \
        o[d0] = __builtin_amdgcn_mfma_f32_32x32x16_bf16(pa1, (bf16x8){l1[0], l1[1], l1[2], l1[3], h1[0], h1[1], h1[2], h1[3]}, o[d0], 0, 0, 0);   \
        o[d0] = __builtin_amdgcn_mfma_f32_32x32x16_bf16(pa2, (bf16x8){l2[0], l2[1], l2[2], l2[3], h2[0], h2[1], h2[2], h2[3]}, o[d0], 0, 0, 0);   \
        o[d0] = __builtin_amdgcn_mfma_f32_32x32x16_bf16(pa3, (bf16x8){l3[0], l3[1], l3[2], l3[3], h3[0], h3[1], h3[2], h3[3]}, o[d0], 0, 0, 0); } while (0)
    PV_D0(0); PV_D0(1); PV_D0(2); PV_D0(3);
#undef PV_D0
#undef TRRD
}
DI int t5_bucket(int n) {
    if (n < 16) return n;
    int b = 16;
    b += (n >= 19); b += (n >= 21); b += (n >= 24); b += (n >= 27); b += (n >= 31); b += (n >= 35); b += (n >= 40); b += (n >= 46);
    b += (n >= 52); b += (n >= 59); b += (n >= 67); b += (n >= 77); b += (n >= 87); b += (n >= 99); b += (n >= 113);
    return b;
}

DI float row16_sum(float x) {
    x += __int_as_float(__builtin_amdgcn_update_dpp(0, __float_as_int(x), 0xB1, 0xF, 0xF, true));
    x += __int_as_float(__builtin_amdgcn_update_dpp(0, __float_as_int(x), 0x4E, 0xF, 0xF, true));
    x += __int_as_float(__builtin_amdgcn_update_dpp(0, __float_as_int(x), 0x141, 0xF, 0xF, true));
    x += __int_as_float(__builtin_amdgcn_update_dpp(0, __float_as_int(x), 0x140, 0xF, 0xF, true));
    return x;
}
struct UnitArgs {
    const bf16_t* Qp; const bf16_t* Kp; const bf16_t* Vp; bf16_t* Op; int q0;
    const unsigned long long* maskp;
    const float* fcum;
    const float* relb; int relcol;
    float lam, post;
    const float* gsub;
    float* stash;
    int variant;
};

template <int MODE>
DI void attn_unit(LAS char* lds, const UnitArgs& A) {
    int tid_l = threadIdx.x; asm volatile("" : "+v"(tid_l));
    const int tid = tid_l, wid = __builtin_amdgcn_readfirstlane(tid >> 6), lane = tid & 63, r32 = lane & 31, hi = lane >> 5;
    const int q0 = A.q0, NT = (q0 + 256) / 64;
    LAS char* V_lds = lds + OFF_V; LAS char* K_lds = lds + OFF_K;
    LAS float* wsf = (LAS float*)(lds + OFF_WS) + wid * 64; LAS float* li_l = wsf; LAS float* al_l = wsf + 32;
    LAS float* tab = (LAS float*)(lds + OFF_TAB); LAS float* fk = (LAS float*)(lds + OFF_FK);
    const int qlo = q0 + wid * 32, qpos = qlo + r32;
    const int sr = tid >> 4, sc = (tid & 15) * 8;
    const int vst0 = v_st(sr, sc), vst1 = v_st(32 + sr, sc), kws = KSWZ(sr, sc * 2);
    const int vb0 = (int)(unsigned)(uintptr_t)V_lds + v_rd_base(lane);
    if (MODE == 0 || MODE == 1) { if (tid < 128) { const int bk = t5_bucket(tid); tab[tid] = (A.relb[bk * 8 + A.relcol] - A.relb[31 * 8 + A.relcol]) * LOG2E; } }
    float fqv = 0.f;
    if (MODE == 2) { for (int i = tid; i < q0 + 256; i += 512) fk[i] = A.fcum[i]; fqv = A.fcum[qpos]; }
    LAS unsigned* kn2 = (LAS unsigned*)(lds + OFF_KN);
    float qn = 0.f, sqq = 0.f;
    if (MODE == 2) { if (tid < 32) kn2[tid] = 0u; __syncthreads(); }
    constexpr int NPASS = (MODE == 1) ? 2 : 1, NQ = (MODE == 1) ? 4 : 8;
#pragma unroll 1
    for (int pass = 0; pass < NPASS; ++pass) {
        bf16x8 qr[NQ];
#pragma unroll
        for (int d = 0; d < NQ; ++d) qr[d] = *(const bf16x8*)(A.Qp + (size_t)(qpos) * LDQ + (MODE == 1 ? pass * 64 : 0) + d * 16 + hi * 8);
        if (MODE == 2) { float s2 = 0.f, sd = 0.f;
#pragma unroll
            for (int d = 0; d < NQ; ++d) { const bf16x8 kk = *(const bf16x8*)(A.Kp + (size_t)(qpos) * LDQ + d * 16 + hi * 8);
#pragma unroll
                for (int j = 0; j < 8; ++j) { const float qf = bf2f((bf16_t)qr[d][j]), kf = bf2f((bf16_t)kk[j]); s2 += qf * qf; sd += qf * kf; } }
            s2 += __shfl_xor(s2, 32); sd += __shfl_xor(sd, 32);
            qn = sqrtf(s2) * 1.001f; sqq = sd - 0.05f; }
        bf16x8 st_k0, st_k1, st_v0, st_v1;
#define KNORM(tix) do { if (MODE == 2) { float n0_ = 0.f, n1_ = 0.f; \
            _Pragma("unroll") for (int j = 0; j < 8; ++j) { const float a_ = bf2f((bf16_t)st_k0[j]), b_ = bf2f((bf16_t)st_k1[j]); n0_ += a_ * a_; n1_ += b_ * b_; } \
            n0_ = row16_sum(n0_); n1_ = row16_sum(n1_); \
            if ((tid & 15) == 0) (void)__hip_atomic_fetch_max(kn2 + (tix), __float_as_uint(fmaxf(n0_, n1_)), __ATOMIC_RELAXED, __HIP_MEMORY_SCOPE_WORKGROUP); } } while (0)
#define SLOAD(k0_) do { const int k0 = (A.variant == 1) ? 0 : (k0_); st_v0 = *(const bf16x8*)(A.Vp + (size_t)((k0) + sr) * LDQ + sc); st_v1 = *(const bf16x8*)(A.Vp + (size_t)((k0) + 32 + sr) * LDQ + sc); \
                       st_k0 = *(const bf16x8*)(A.Kp + (size_t)((k0) + sr) * LDQ + sc); st_k1 = *(const bf16x8*)(A.Kp + (size_t)((k0) + 32 + sr) * LDQ + sc); } while (0)
#define SWRITE(bf) do { *(LAS bf16x8*)(V_lds + (bf) * SHM_V + vst0) = st_v0; *(LAS bf16x8*)(V_lds + (bf) * SHM_V + vst1) = st_v1; \
                        *(LAS bf16x8*)(K_lds + (bf) * SHM_K + kws) = st_k0; *(LAS bf16x8*)(K_lds + (bf) * SHM_K + kws + 32 * 256) = st_k1; } while (0)
        SLOAD(0); SWRITE(0); KNORM(0);
        __syncthreads();
        float m_reg = -1e30f, l_reg = 0.f; f32x16 o[4];
#pragma unroll
        for (int d = 0; d < 4; ++d)
#pragma unroll
            for (int r = 0; r < 16; ++r) o[d][r] = 0.f;
        f32x16 p0, p1; bf16x8 pa0, pa1, pa2, pa3;
        unsigned long long mw_next = 0ull; if (MODE == 0) mw_next = A.maskp[(size_t)qpos * 32];
#define STEP(t, KB) do { const int t_ = (t); const bool more_ = (t_ + 1 < NT); const int kbase = t_ * 64; \
        const unsigned long long mw_ = mw_next; if (MODE == 0) { if (more_) mw_next = A.maskp[(size_t)qpos * 32 + t_ + 1]; } \
        if (more_) SLOAD(kbase + 64); \
        bool far_ = false; if (MODE == 2) { const float kn_ = sqrtf(__uint_as_float(kn2[t_])) * 1.001f; far_ = __all(qn * kn_ + (fqv - fk[kbase + 63]) - sqq < -100.f); } \
        if (kbase <= qlo + 31 && !far_) {        \
        if (A.variant == 4) { _Pragma("unroll") for (int r = 0; r < 16; ++r) { p0[r] = 0.f; p1[r] = 0.f; } } else { \
        if (MODE == 1) { if (pass == 0) qkt<KB, 0, 4>(p0, p1, K_lds, r32, hi, qr); else qkt<KB, 4, 8>(p0, p1, K_lds, r32, hi, qr); } \
        else qkt<KB, 0, 8>(p0, p1, K_lds, r32, hi, qr); } \
        if (A.variant != 2) { \
        if (MODE == 0 || MODE == 1) { if (kbase + 63 + 113 > qlo) { const int dq_ = qpos - kbase - 4 * hi; \
            _Pragma("unroll") for (int r = 0; r < 16; ++r) { const int c_ = (r & 3) + 8 * (r >> 2); int i0 = dq_ - c_, i1 = dq_ - c_ - 32; \
                i0 = i0 < 0 ? 0 : (i0 > 127 ? 127 : i0); i1 = i1 < 0 ? 0 : (i1 > 127 ? 127 : i1); p0[r] += tab[i0]; p1[r] += tab[i1]; } } } \
        if (MODE == 2) { _Pragma("unroll") for (int g = 0; g < 4; ++g) { const f32x4 f0 = *(LAS const f32x4*)(fk + kbase + 8 * g + 4 * hi), f1 = *(LAS const f32x4*)(fk + kbase + 32 + 8 * g + 4 * hi); \
                _Pragma("unroll") for (int j = 0; j < 4; ++j) { p0[4 * g + j] += fqv - f0[j]; p1[4 * g + j] += fqv - f1[j]; } } } \
        if (kbase + 63 > qlo) { const int dq_ = qpos - kbase - 4 * hi; const float NEG_ = -__builtin_inff(); \
            _Pragma("unroll") for (int r = 0; r < 16; ++r) { const int c_ = (r & 3) + 8 * (r >> 2); if (dq_ - c_ < 0) p0[r] = NEG_; if (dq_ - c_ - 32 < 0) p1[r] = NEG_; } } \
        if (MODE == 0) { const int wl_ = (int)((unsigned)mw_ >> (4 * hi)), wh_ = (int)((unsigned)(mw_ >> 32) >> (4 * hi)); \
            _Pragma("unroll") for (int r = 0; r < 16; ++r) { const int c_ = (r & 3) + 8 * (r >> 2); \
                const unsigned m0_ = (unsigned)__builtin_amdgcn_sbfe(wl_, c_, 1), m1_ = (unsigned)__builtin_amdgcn_sbfe(wh_, c_, 1);     \
                p0[r] = __uint_as_float((__float_as_uint(p0[r]) & m0_) | (0xff800000u & ~m0_)); p1[r] = __uint_as_float((__float_as_uint(p1[r]) & m1_) | (0xff800000u & ~m1_)); } } \
        } \
        float pmax_ = p0[0]; _Pragma("unroll") for (int r = 1; r < 16; ++r) pmax_ = fmaxf(pmax_, p0[r]); _Pragma("unroll") for (int r = 0; r < 16; ++r) pmax_ = fmaxf(pmax_, p1[r]); \
        { auto rr = __builtin_amdgcn_permlane32_swap(__float_as_uint(pmax_), __float_as_uint(pmax_), false, false); pmax_ = fmaxf(__uint_as_float(rr[0]), __uint_as_float(rr[1])); } \
        float mn_ = m_reg, alpha_ = 1.f; \
        if (!__all(pmax_ - m_reg <= 8.f)) { mn_ = fmaxf(m_reg, pmax_); alpha_ = __builtin_amdgcn_exp2f(m_reg - mn_); m_reg = mn_; } \
        p0 = p0 - mn_; p1 = p1 - mn_;                        \
        _Pragma("unroll") for (int r = 0; r < 16; ++r) p0[r] = __builtin_amdgcn_exp2f(p0[r]); \
        _Pragma("unroll") for (int r = 0; r < 16; ++r) p1[r] = __builtin_amdgcn_exp2f(p1[r]); \
        float ps_; { const f32x16 s16_ = p0 + p1; const f32x8 s8_ = s16_.lo + s16_.hi; const f32x4 s4_ = s8_.lo + s8_.hi; ps_ = (s4_[0] + s4_[1]) + (s4_[2] + s4_[3]); } \
        { auto rr = __builtin_amdgcn_permlane32_swap(__float_as_uint(ps_), __float_as_uint(ps_), false, false); ps_ = __uint_as_float(rr[0]) + __uint_as_float(rr[1]); } \
        l_reg = l_reg * alpha_ + ps_; \
        PK4(p0, 0, pa0); PK4(p0, 8, pa1); PK4(p1, 0, pa2); PK4(p1, 8, pa3); \
        if (__any(alpha_ < 1.f)) { if (hi == 0) al_l[r32] = alpha_; asm volatile("s_waitcnt lgkmcnt(0)" ::: "memory"); \
            _Pragma("unroll") for (int d_ = 0; d_ < 4; ++d_) _Pragma("unroll") for (int r = 0; r < 16; ++r) o[d_][r] *= al_l[crow(r, hi)]; } \
        SBAR(); if (A.variant != 3) pv_tile<KB>(o, vb0, pa0, pa1, pa2, pa3); } \
        if (A.variant != 5) { if (more_) { asm volatile("s_waitcnt vmcnt(0)" ::: "memory"); SWRITE((KB) ^ 1); KNORM(t_ + 1); } \
        __syncthreads(); } } while (0)
#define PK4(P, B_, OUT) do { unsigned a0 = cvtpk(P[B_+0], P[B_+1]), a1 = cvtpk(P[B_+2], P[B_+3]);                          \
        unsigned b0 = cvtpk(P[B_+4], P[B_+5]), b1 = cvtpk(P[B_+6], P[B_+7]);                                             \
        auto r0 = __builtin_amdgcn_permlane32_swap(a0, b0, false, false); auto r1 = __builtin_amdgcn_permlane32_swap(a1, b1, false, false); \
        u32x4 w = {r0[0], r1[0], r0[1], r1[1]}; OUT = __builtin_bit_cast(bf16x8, w); } while (0)
#pragma unroll 1
        for (int t = 0; t < NT; t += 2) { STEP(t, 0); STEP(t + 1, 1); }
#undef STEP
#undef PK4
#undef SLOAD
#undef SWRITE
#undef KNORM
        if (hi == 0) li_l[r32] = l_reg; asm volatile("s_waitcnt lgkmcnt(0)" ::: "memory");
        float rli[16];
#pragma unroll
        for (int r = 0; r < 16; ++r) rli[r] = __builtin_amdgcn_rcpf(li_l[crow(r, hi)]);
        bf16_t* Ow = A.Op + (size_t)(qlo) * 2048; asm volatile("" : "+v"(Ow));
        if (MODE != 1) {
#pragma unroll
            for (int r = 0; r < 16; ++r) { const int orow = crow(r, hi);
#pragma unroll
                for (int d0 = 0; d0 < 4; ++d0) { const float v = o[d0][r] * rli[r]; const float vn = __shfl_xor(v, 1);
                    if ((r32 & 1) == 0) *(unsigned*)(Ow + (size_t)orow * 2048 + d0 * 32 + r32) = cvtpk(v, vn); } }
        } else if (pass == 0) {
#pragma unroll
            for (int d0 = 0; d0 < 4; ++d0)
#pragma unroll
                for (int r = 0; r < 16; r += 4) *(f32x4*)(A.stash + tid * 64 + d0 * 16 + r) = (f32x4){o[d0][r] * rli[r], o[d0][r + 1] * rli[r + 1], o[d0][r + 2] * rli[r + 2], o[d0][r + 3] * rli[r + 3]};
        } else {
            float ss[16];
#pragma unroll
            for (int d0 = 0; d0 < 4; ++d0)
#pragma unroll
                for (int r = 0; r < 16; r += 4) { const f32x4 sv = *(const f32x4*)(A.stash + tid * 64 + d0 * 16 + r);
#pragma unroll
                    for (int j = 0; j < 4; ++j) o[d0][r + j] = sv[j] - A.lam * (o[d0][r + j] * rli[r + j]); }
#pragma unroll
            for (int r = 0; r < 16; ++r) { float s = 0.f;
#pragma unroll
                for (int d0 = 0; d0 < 4; ++d0) { const float v = o[d0][r]; s += v * v; }
                s += __shfl_xor(s, 1); s += __shfl_xor(s, 2); s += __shfl_xor(s, 4); s += __shfl_xor(s, 8); s += __shfl_xor(s, 16);
                ss[r] = __builtin_amdgcn_rsqf(s * (1.f / 128.f) + RMS_EPS) * A.post;
                if ((r & 3) == 3) asm volatile("" ::: "memory"); }
#pragma unroll
            for (int d0 = 0; d0 < 4; ++d0) { const float gs = A.gsub[d0 * 32 + r32];
#pragma unroll
                for (int r = 0; r < 16; ++r) { const int orow = crow(r, hi); const float v = o[d0][r] * ss[r] * gs; const float vn = __shfl_xor(v, 1);
                    if ((r32 & 1) == 0) *(unsigned*)(Ow + (size_t)orow * 2048 + d0 * 32 + r32) = cvtpk(v, vn); } }
        }
        __syncthreads();
    }
}

template <int MODE>
DI void tile_hooks(f32x16& p0, f32x16& p1, int kbase, int qlo, int qpos, int hi, LAS const float* tab, LAS const float* fk, float fqv, unsigned long long mw) {
    if (MODE == 0 || MODE == 1) { if (kbase + 63 + 113 > qlo) { const int dq_ = qpos - kbase - 4 * hi;
#pragma unroll
        for (int r = 0; r < 16; ++r) { const int c_ = (r & 3) + 8 * (r >> 2); int i0 = dq_ - c_, i1 = dq_ - c_ - 32;
            i0 = i0 < 0 ? 0 : (i0 > 127 ? 127 : i0); i1 = i1 < 0 ? 0 : (i1 > 127 ? 127 : i1); p0[r] += tab[i0]; p1[r] += tab[i1]; } } }
    if (MODE == 2) {
#pragma unroll
        for (int g = 0; g < 4; ++g) { const f32x4 f0 = *(LAS const f32x4*)(fk + kbase + 8 * g + 4 * hi), f1 = *(LAS const f32x4*)(fk + kbase + 32 + 8 * g + 4 * hi);
#pragma unroll
            for (int j = 0; j < 4; ++j) { p0[4 * g + j] += fqv - f0[j]; p1[4 * g + j] += fqv - f1[j]; } } }
    if (kbase + 63 > qlo) { const int dq_ = qpos - kbase - 4 * hi; const float NEG_ = -__builtin_inff();
#pragma unroll
        for (int r = 0; r < 16; ++r) { const int c_ = (r & 3) + 8 * (r >> 2); if (dq_ - c_ < 0) p0[r] = NEG_; if (dq_ - c_ - 32 < 0) p1[r] = NEG_; } }
    if (MODE == 0) { const unsigned wl_ = (unsigned)mw >> (4 * hi), wh_ = (unsigned)(mw >> 32) >> (4 * hi); const float NEG_ = -__builtin_inff();
#pragma unroll
        for (int r = 0; r < 16; ++r) { const int c_ = (r & 3) + 8 * (r >> 2); if (!((wl_ >> c_) & 1u)) p0[r] = NEG_; if (!((wh_ >> c_) & 1u)) p1[r] = NEG_; } }
}
DI void partialSM(f32x16& p0, f32x16& p1, float& m_reg, float& mn, float& alpha) {
    float pmax = p0[0];
#pragma unroll
    for (int r = 1; r < 16; ++r) pmax = fmaxf(pmax, p0[r]);
#pragma unroll
    for (int r = 0; r < 16; ++r) pmax = fmaxf(pmax, p1[r]);
    { auto rr = __builtin_amdgcn_permlane32_swap(__float_as_uint(pmax), __float_as_uint(pmax), false, false); pmax = fmaxf(__uint_as_float(rr[0]), __uint_as_float(rr[1])); }
    if (__builtin_expect(__all(pmax - m_reg <= 8.f), 1)) { mn = m_reg; alpha = 1.f; }
    else { mn = fmaxf(m_reg, pmax); alpha = __builtin_amdgcn_exp2f(m_reg - mn); m_reg = mn; }
#pragma unroll
    for (int r = 0; r < 16; ++r) { p0[r] -= mn; p1[r] -= mn; }
#pragma unroll
    for (int r = 0; r < 16; ++r) p0[r] = __builtin_amdgcn_exp2f(p0[r]);
}
DI void finishSM(f32x16& p0, f32x16& p1, float alpha, float& l_reg, bf16x8& pa0, bf16x8& pa1, bf16x8& pa2, bf16x8& pa3) {
#pragma unroll
    for (int r = 0; r < 16; ++r) p1[r] = __builtin_amdgcn_exp2f(p1[r]);
    float ps = 0.f;
#pragma unroll
    for (int r = 0; r < 16; ++r) ps += p0[r];
#pragma unroll
    for (int r = 0; r < 16; ++r) ps += p1[r];
    { auto rr = __builtin_amdgcn_permlane32_swap(__float_as_uint(ps), __float_as_uint(ps), false, false); ps = __uint_as_float(rr[0]) + __uint_as_float(rr[1]); }
    l_reg = l_reg * alpha + ps;
#define PK4(P, B_, OUT) do { unsigned a0 = cvtpk(P[B_+0], P[B_+1]), a1 = cvtpk(P[B_+2], P[B_+3]);                          \
        unsigned b0 = cvtpk(P[B_+4], P[B_+5]), b1 = cvtpk(P[B_+6], P[B_+7]);                                             \
        auto r0 = __builtin_amdgcn_permlane32_swap(a0, b0, false, false); auto r1 = __builtin_amdgcn_permlane32_swap(a1, b1, false, false); \
        u32x4 w = {r0[0], r1[0], r0[1], r1[1]}; OUT = __builtin_bit_cast(bf16x8, w); } while (0)
    PK4(p0, 0, pa0); PK4(p0, 8, pa1); PK4(p1, 0, pa2); PK4(p1, 8, pa3);
#undef PK4
}

template <int MODE, int PASS>
DI void attn_pass_p(LAS char* lds, const UnitArgs& A) {
    int tid_l = threadIdx.x; asm volatile("" : "+v"(tid_l));
    const int tid = tid_l, wid = __builtin_amdgcn_readfirstlane(tid >> 6), lane = tid & 63, r32 = lane & 31, hi = lane >> 5;
    const int q0 = A.q0, NT = (q0 + 256) / 64;
    LAS char* V_lds = lds + OFF_V; LAS char* K_lds = lds + OFF_K;
    LAS float* wsf = (LAS float*)(lds + OFF_WS) + wid * 64; LAS float* li_l = wsf; LAS float* al_l = wsf + 32;
    LAS float* tab = (LAS float*)(lds + OFF_TAB); LAS float* fk = (LAS float*)(lds + OFF_FK);
    const int qlo = q0 + wid * 32, qpos = qlo + r32;
    const int sr = tid >> 4, sc = (tid & 15) * 8;
    const int vst0 = v_st(sr, sc), vst1 = v_st(32 + sr, sc), kws = KSWZ(sr, sc * 2);
    const int vb0 = (int)(unsigned)(uintptr_t)V_lds + v_rd_base(lane);
    const unsigned soff = (unsigned)(sr * LDQ + sc) * 2u;
    float fqv = 0.f;
    if (MODE == 2) fqv = A.fcum[qpos];
    constexpr int NQ = (MODE == 1) ? 4 : 8; constexpr int pass = PASS;
    {
        bf16x8 qr[NQ];
#pragma unroll
        for (int d = 0; d < NQ; ++d) qr[d] = *(const bf16x8*)(A.Qp + (size_t)(qpos) * LDQ + (MODE == 1 ? pass * 64 : 0) + d * 16 + hi * 8);
        bf16x8 st_k0, st_k1, st_v0, st_v1;
        unsigned long long mwC = 0ull;
#define VMW() asm volatile("s_waitcnt vmcnt(0)" ::: "memory")
#define SLOAD(k0) do { const char* vb_ = (const char*)A.Vp + (size_t)(k0) * (LDQ * 2); const char* kb_ = (const char*)A.Kp + (size_t)(k0) * (LDQ * 2);     \
                       st_v0 = *(const bf16x8*)(vb_ + soff); st_v1 = *(const bf16x8*)(vb_ + soff + 32 * LDQ * 2); st_k0 = *(const bf16x8*)(kb_ + soff); st_k1 = *(const bf16x8*)(kb_ + soff + 32 * LDQ * 2); } while (0)
#define SWRITE_K(bf) do { *(LAS bf16x8*)(K_lds + (bf) * SHM_K + kws) = st_k0; *(LAS bf16x8*)(K_lds + (bf) * SHM_K + kws + 32 * 256) = st_k1; } while (0)
#define SWRITE_V(bf) do { *(LAS bf16x8*)(V_lds + (bf) * SHM_V + vst0) = st_v0; *(LAS bf16x8*)(V_lds + (bf) * SHM_V + vst1) = st_v1; } while (0)
#define MLOAD(t) do { if (MODE == 0) mwC = A.maskp[(size_t)qpos * 32 + (t)]; } while (0)
#define QKT(KB, P0, P1) do { if (MODE == 1) { if (pass == 0) qkt<KB, 0, 4>(P0, P1, K_lds, r32, hi, qr); else qkt<KB, 4, 8>(P0, P1, K_lds, r32, hi, qr); } else qkt<KB, 0, 8>(P0, P1, K_lds, r32, hi, qr); } while (0)
#define RESC(a) do { if (__any((a) < 1.f)) { if (hi == 0) al_l[r32] = (a); asm volatile("s_waitcnt lgkmcnt(0)" ::: "memory"); \
            _Pragma("unroll") for (int d_ = 0; d_ < 4; ++d_) _Pragma("unroll") for (int r = 0; r < 16; ++r) o[d_][r] *= al_l[crow(r, hi)]; } } while (0)
        MLOAD(0); SLOAD(0); VMW(); SWRITE_K(0);
        __syncthreads();
        float m_reg = -1e30f, l_reg = 0.f; f32x16 o[4];
#pragma unroll
        for (int d = 0; d < 4; ++d)
#pragma unroll
            for (int r = 0; r < 16; ++r) o[d][r] = 0.f;
        f32x16 pA0, pA1, pB0, pB1; float mnA, mnB, alA, alB; bf16x8 pa0, pa1, pa2, pa3;
        SWRITE_V(0); SBAR();
        SLOAD(64);
        SBAR(); QKT(0, pA0, pA1);
        tile_hooks<MODE>(pA0, pA1, 0, qlo, qpos, hi, tab, fk, fqv, mwC); MLOAD(1); partialSM(pA0, pA1, m_reg, mnA, alA);
        VMW(); SWRITE_V(1); SWRITE_K(1);
        __syncthreads();
#define HALF_STEP(PX0, PX1, mnX, alX, PY0, PY1, alY, t, KB, VB, SB) do { \
        SBAR(); QKT(KB, PX0, PX1); \
        finishSM(PY0, PY1, alY, l_reg, pa0, pa1, pa2, pa3); SBAR(); \
        if ((t) + 1 < NT) { SLOAD(((t) + 1) * 64); SBAR(); } \
        pv_tile<VB>(o, vb0, pa0, pa1, pa2, pa3); \
        tile_hooks<MODE>(PX0, PX1, (t) * 64, qlo, qpos, hi, tab, fk, fqv, mwC); if ((t) + 1 < NT) MLOAD((t) + 1); partialSM(PX0, PX1, m_reg, mnX, alX); \
        __syncthreads(); \
        if ((t) + 1 < NT) { VMW(); SWRITE_V(SB); SWRITE_K(SB); } \
        RESC(alX); __syncthreads(); } while (0)
#pragma unroll 1
        for (int t = 1; t + 1 < NT; t += 2) {
            HALF_STEP(pB0, pB1, mnB, alB, pA0, pA1, alA, t, 1, 0, 0);
            HALF_STEP(pA0, pA1, mnA, alA, pB0, pB1, alB, t + 1, 0, 1, 1);
        }
        SBAR(); QKT(1, pB0, pB1); SBAR();
        finishSM(pA0, pA1, alA, l_reg, pa0, pa1, pa2, pa3); SBAR();
        pv_tile<0>(o, vb0, pa0, pa1, pa2, pa3);
        tile_hooks<MODE>(pB0, pB1, (NT - 1) * 64, qlo, qpos, hi, tab, fk, fqv, mwC); partialSM(pB0, pB1, m_reg, mnB, alB);
        RESC(alB);
        finishSM(pB0, pB1, alB, l_reg, pa0, pa1, pa2, pa3); SBAR();
        pv_tile<1>(o, vb0, pa0, pa1, pa2, pa3);
#undef HALF_STEP
#undef RESC
#undef QKT
#undef MLOAD
#undef SWRITE_K
#undef SWRITE_V
#undef SLOAD
#undef VMW
        if (hi == 0) li_l[r32] = l_reg; asm volatile("s_waitcnt lgkmcnt(0)" ::: "memory");
        float rli[16];
#pragma unroll
        for (int r = 0; r < 16; ++r) rli[r] = __builtin_amdgcn_rcpf(li_l[crow(r, hi)]);
        bf16_t* Ow = A.Op + (size_t)(qlo) * 2048; asm volatile("" : "+v"(Ow));
        if (MODE != 1) {
#pragma unroll
            for (int r = 0; r < 16; ++r) { const int orow = crow(r, hi);
#pragma unroll
                for (int d0 = 0; d0 < 4; ++d0) { const float v = o[d0][r] * rli[r]; const float vn = __shfl_xor(v, 1);
                    if ((r32 & 1) == 0) *(unsigned*)(Ow + (size_t)orow * 2048 + d0 * 32 + r32) = cvtpk(v, vn); } }
        } else if (pass == 0) {
#pragma unroll
            for (int d0 = 0; d0 < 4; ++d0)
#pragma unroll
                for (int r = 0; r < 16; r += 4) *(f32x4*)(A.stash + tid * 64 + d0 * 16 + r) = (f32x4){o[d0][r] * rli[r], o[d0][r + 1] * rli[r + 1], o[d0][r + 2] * rli[r + 2], o[d0][r + 3] * rli[r + 3]};
        } else {
            float ss[16];
#pragma unroll
            for (int d0 = 0; d0 < 4; ++d0)
#pragma unroll
                for (int r = 0; r < 16; r += 4) { const f32x4 sv = *(const f32x4*)(A.stash + tid * 64 + d0 * 16 + r);
#pragma unroll
                    for (int j = 0; j < 4; ++j) o[d0][r + j] = sv[j] - A.lam * (o[d0][r + j] * rli[r + j]); }
#pragma unroll
            for (int r = 0; r < 16; ++r) { float s = 0.f;
#pragma unroll
                for (int d0 = 0; d0 < 4; ++d0) { const float v = o[d0][r]; s += v * v; }
                s += __shfl_xor(s, 1); s += __shfl_xor(s, 2); s += __shfl_xor(s, 4); s += __shfl_xor(s, 8); s += __shfl_xor(s, 16);
                ss[r] = __builtin_amdgcn_rsqf(s * (1.f / 128.f) + RMS_EPS) * A.post;
                if ((r & 3) == 3) asm volatile("" ::: "memory"); }
#pragma unroll
            for (int d0 = 0; d0 < 4; ++d0) { const float gs = A.gsub[d0 * 32 + r32];
#pragma unroll
                for (int r = 0; r < 16; ++r) { const int orow = crow(r, hi); const float v = o[d0][r] * ss[r] * gs; const float vn = __shfl_xor(v, 1);
                    if ((r32 & 1) == 0) *(unsigned*)(Ow + (size_t)orow * 2048 + d0 * 32 + r32) = cvtpk(v, vn); } }
        }
        __syncthreads();
    }
}

template <int MODE>
DI void attn_unit_p(LAS char* lds, const UnitArgs& A) {
    int tid_l = threadIdx.x; asm volatile("" : "+v"(tid_l)); const int tid = tid_l;
    LAS float* tab = (LAS float*)(lds + OFF_TAB); LAS float* fk = (LAS float*)(lds + OFF_FK);
    if (MODE == 0 || MODE == 1) { if (tid < 128) { const int bk = t5_bucket(tid); tab[tid] = (A.relb[bk * 8 + A.relcol] - A.relb[31 * 8 + A.relcol]) * LOG2E; } }
    if (MODE == 2) { for (int i = tid; i < A.q0 + 256; i += 512) fk[i] = A.fcum[i]; }
    attn_pass_p<MODE, 0>(lds, A);
    if (MODE == 1) attn_pass_p<MODE, 1>(lds, A);
}
#undef SBAR
}

#define XB_TMO      128
#define XB_XCNT(j)  (256  + 64 * (j))
#define XB_XSUB(j)  (1280 + 64 * (j))
#define XB_XGEN(j)  (2304 + 64 * (j))
#define XB_TOP      3328
#define XB_TOPGEN   3392
#define XCD_BAR_WORDS 3456
#define XB_SPIN_CAP (1u << 20)

__device__ __forceinline__ unsigned xb_ld(unsigned* p)              { return __hip_atomic_load(p, __ATOMIC_RELAXED, __HIP_MEMORY_SCOPE_AGENT); }
__device__ __forceinline__ unsigned xb_add(unsigned* p, unsigned v) { return __hip_atomic_fetch_add(p, v, __ATOMIC_RELAXED, __HIP_MEMORY_SCOPE_AGENT); }
__device__ __forceinline__ unsigned xb_xcc_id() { return (unsigned)__builtin_amdgcn_s_getreg((3 << 11) | 20) & 0xFu; }
#define XB_SPIN(cond, bar) do { unsigned _sp = 0; while (cond) { __builtin_amdgcn_s_sleep(1); \
    if ((++_sp & 255u) == 0u) { if (xb_ld(&(bar)[XB_TMO])) break; if (_sp > XB_SPIN_CAP) { atomicAdd(&(bar)[XB_TMO], 1u); break; } } } } while (0)

struct XcdBarrier {
    unsigned* bar; unsigned x;
    volatile LAS unsigned* st;
};

__device__ __forceinline__ XcdBarrier xcd_barrier_post(unsigned* bar, volatile LAS unsigned* st) {
    XcdBarrier b; b.bar = bar; b.x = xb_xcc_id(); b.st = st;
    if (threadIdx.x == 0) (void)xb_add(&bar[XB_XCNT(b.x)], 1u);
    return b;
}
__device__ __forceinline__ void xcd_barrier_complete(unsigned* bar, unsigned x, unsigned& nloc, unsigned& nx) {
    const unsigned G = gridDim.x * gridDim.y * gridDim.z;
    unsigned sum, cnt, mine, sp = 0u;
    for (;;) {
        sum = 0u; cnt = 0u; mine = 0u;
#pragma unroll
        for (unsigned j = 0; j < 16; ++j) { const unsigned c = xb_ld(&bar[XB_XCNT(j)]); sum += c; cnt += (c > 0u) ? 1u : 0u; mine = (j == x) ? c : mine; }
        if (sum == G) break;
        __builtin_amdgcn_s_sleep(1);
        if ((++sp & 255u) == 0u) { if (xb_ld(&bar[XB_TMO])) break; if (sp > XB_SPIN_CAP) { atomicAdd(&bar[XB_TMO], 1u); break; } }
    }
    nloc = mine > 0u ? mine : 1u; nx = cnt > 0u ? cnt : 1u;
}

__device__ __forceinline__ void xcd_barrier(const XcdBarrier& b) {
    asm volatile("s_waitcnt vmcnt(0)" ::: "memory");
    __syncthreads();
    if (threadIdx.x == 0) {
        unsigned* bar = b.bar; asm volatile("" : "+s"(bar));
        __builtin_amdgcn_s_waitcnt(0);
        unsigned nloc = b.st[0], nx = b.st[1];
        if (nloc == 0u) { xcd_barrier_complete(bar, b.x, nloc, nx); b.st[0] = nloc; b.st[1] = nx; }
        const unsigned old = xb_add(&bar[XB_XSUB(b.x)], 1u);
        const unsigned gen = old / nloc;
        if (old + 1u == (gen + 1u) * nloc) {
            __builtin_amdgcn_fence(__ATOMIC_RELEASE, "agent");
            asm volatile("s_waitcnt vmcnt(0)" ::: "memory");
            const unsigned og = xb_add(&bar[XB_TOP], 1u);
            const unsigned tg = og / nx;
            if (og + 1u == (tg + 1u) * nx) xb_add(&bar[XB_TOPGEN], 1u);
            else XB_SPIN(xb_ld(&bar[XB_TOPGEN]) == tg, bar);
            __builtin_amdgcn_fence(__ATOMIC_ACQUIRE, "agent");
            xb_add(&bar[XB_XGEN(b.x)], 1u);
            asm volatile("s_waitcnt vmcnt(0)" ::: "memory");
        } else {
            XB_SPIN(xb_ld(&bar[XB_XGEN(b.x)]) == gen, bar);
            __builtin_amdgcn_fence(__ATOMIC_ACQUIRE, "agent");
            asm volatile("s_waitcnt vmcnt(0)" ::: "memory");
        }
    }
    __syncthreads();
}
#define RLX_AGENT __ATOMIC_RELAXED, __HIP_MEMORY_SCOPE_AGENT
#define LDS_WAIT() asm volatile("s_waitcnt lgkmcnt(0)" ::: "memory")
DI unsigned f2bf(float f) { unsigned u = __builtin_bit_cast(unsigned, f); return (u + 0x7fffu + ((u >> 16) & 1u)) >> 16; }
DI unsigned pk2(float lo, float hi) { return f2bf(lo) | (f2bf(hi) << 16); }

struct MapPlain { DI int src(int n) const { return n; } DI float scale(int) const { return 1.f; } };
struct MapWin {
    DI int src(int n) const {
        if (n < 1536) return 1860 + n;
        if (n < 2048) return 5956 + (n - 1536);
        if (n < 3584) return 3396 + (n - 2048);
        if (n < 3840) return 1536 + (n - 3584);
        if (n < 3904) return 1792 + (n - 3840);
        if (n < 3908) return 1856 + (n - 3904);
        if (n < 3912) return 6468 + (n - 3908);
        if (n < 4096) return -1;
        if (n < 5632) return n - 4096;
        if (n < 6144) return 4932 + (n - 5632);
        return 5444 + (n - 6144);
    }
    DI float scale(int n) const { return n < 512 ? 0.125f * LOG2E : 1.f; }
};
constexpr float QSCALE128 = 0.08838834764831845f * LOG2E;
struct MapGate {
    DI int src(int n) const { const int pn = n >> 8, c = n & 255; const int g = 2 * (c >> 7) + ((c >> 4) & 1), dl = 16 * ((c >> 5) & 3) + (c & 15); return g * 2048 + 64 * pn + dl; }
    DI float scale(int) const { return 1.f; }
};
template <class Map>
DI void transpose_item(const float* W, int K, int Nsrc, int nblk  , bf16_t* WT, const Map& map, LAS float* scr, int item, int lane) {
    const int kb = item / nblk, nb = item % nblk, k0 = 64 * kb, n0 = 32 * nb;
    const int nd = n0 + (lane & 31); const int s = map.src(nd); const float scl = map.scale(nd);
#pragma unroll 8
    for (int i = 0; i < 32; ++i) { const int kk = 2 * i + (lane >> 5); scr[kk * 33 + (lane & 31)] = (s >= 0) ? W[(size_t)(k0 + kk) * Nsrc + s] * scl : 0.f; }
    LDS_WAIT(); asm volatile("" ::: "memory");
    const int c = lane & 7;
#pragma unroll
    for (int j = 0; j < 4; ++j) { const int n = (lane >> 3) + 8 * j; const LAS float* sp = scr + (8 * c) * 33 + n;
        u32x4 o; o.x = pk2(sp[0 * 33], sp[1 * 33]); o.y = pk2(sp[2 * 33], sp[3 * 33]); o.z = pk2(sp[4 * 33], sp[5 * 33]); o.w = pk2(sp[6 * 33], sp[7 * 33]);
        *(u32x4*)(WT + (size_t)(n0 + n) * K + k0 + 8 * c) = o; }
    LDS_WAIT(); asm volatile("" ::: "memory");
}
constexpr float WG8_SCALE = 64.f;
template <class Map>
DI void transpose_item8(const float* W, int K, int Nsrc, int nblk, unsigned char* WT, const Map& map, int noff  , LAS float* scr, int item, int lane) {
    const int kb = item / nblk, nb = item % nblk, k0 = 64 * kb, n0 = 32 * nb;
    const int nd = noff + n0 + (lane & 31); const int s = map.src(nd); const float scl = map.scale(nd) * WG8_SCALE;
#pragma unroll 8
    for (int i = 0; i < 32; ++i) { const int kk = 2 * i + (lane >> 5); scr[kk * 33 + (lane & 31)] = (s >= 0) ? W[(size_t)(k0 + kk) * Nsrc + s] * scl : 0.f; }
    LDS_WAIT(); asm volatile("" ::: "memory");
#pragma unroll
    for (int j = 0; j < 2; ++j) { const int q = lane + 64 * j, n = q >> 2, c = q & 3; const LAS float* sp = scr + (16 * c) * 33 + n;
        int o[4];
#pragma unroll
        for (int e = 0; e < 4; ++e) { int w = 0; w = __builtin_amdgcn_cvt_pk_fp8_f32(sp[(4 * e + 0) * 33], sp[(4 * e + 1) * 33], w, false); w = __builtin_amdgcn_cvt_pk_fp8_f32(sp[(4 * e + 2) * 33], sp[(4 * e + 3) * 33], w, true); o[e] = w; }
        *(u32x4*)(WT + (size_t)(n0 + n) * K + k0 + 16 * c) = (u32x4){(unsigned)o[0], (unsigned)o[1], (unsigned)o[2], (unsigned)o[3]}; }
    LDS_WAIT(); asm volatile("" ::: "memory");
}
DI void mod_partial_item(const float* c, const float* wada, float* modp, int item, int lane) {
    const int kc = item & 15, nb = (item >> 4) % 48, l = item / (16 * 48);
    const int k0 = kc * 128, n0 = nb * 256 + 4 * lane;
    const float* Wl = wada + (size_t)l * 2048 * 12288;
    f32x4 acc[8];
#pragma unroll
    for (int b = 0; b < 8; ++b) acc[b] = (f32x4){0.f, 0.f, 0.f, 0.f};
#pragma unroll 1
    for (int sub = 0; sub < 2; ++sub) {
        float cb[8];
#pragma unroll
        for (int b = 0; b < 8; ++b) { const float x = c[b * 2048 + k0 + 64 * sub + lane]; cb[b] = x / (1.f + __expf(-x)); }
#pragma unroll 8
        for (int kk = 0; kk < 64; ++kk) { const f32x4 w = *(const f32x4*)(Wl + (size_t)(k0 + 64 * sub + kk) * 12288 + n0);
#pragma unroll
            for (int b = 0; b < 8; ++b) { const float s = __builtin_bit_cast(float, __builtin_amdgcn_readlane(__builtin_bit_cast(int, cb[b]), kk)); acc[b] += s * w; } }
    }
#pragma unroll
    for (int b = 0; b < 8; ++b) *(f32x4*)(modp + ((size_t)(kc * 2 + l) * 8 + b) * 12288 + n0) = acc[b];
}
template <bool F8, bool XB16>
DI void norm_row(const void* xrow, bf16_t* orow, unsigned char* orow8, const f32x4 (&Av)[8], const f32x4 (&Bv)[8], int lane) {
    f32x4 v[8]; float s = 0.f;
#pragma unroll
    for (int j = 0; j < 8; ++j) {
        if (XB16) { const u32x2 w = ((const u32x2*)xrow)[lane + 64 * j]; v[j] = (f32x4){__uint_as_float(w.x << 16), __uint_as_float(w.x & 0xffff0000u), __uint_as_float(w.y << 16), __uint_as_float(w.y & 0xffff0000u)}; }
        else v[j] = ((const f32x4*)xrow)[lane + 64 * j];
        s += (v[j][0] * v[j][0] + v[j][1] * v[j][1]) + (v[j][2] * v[j][2] + v[j][3] * v[j][3]); }
    const float rstd = 1.f / sqrtf(wave_sum(s) * (1.f / 2048.f) + RMS_EPS);
    u32x2* o8 = (u32x2*)orow + lane;
#pragma unroll
    for (int j = 0; j < 8; ++j) { const f32x4 h = v[j] * rstd * Av[j] + Bv[j]; u32x2 w; w.x = cvtpk(h[0], h[1]); w.y = cvtpk(h[2], h[3]); o8[64 * j] = w;
        if (F8) { int q = 0; q = __builtin_amdgcn_cvt_pk_fp8_f32(h[0], h[1], q, false); q = __builtin_amdgcn_cvt_pk_fp8_f32(h[2], h[3], q, true); ((int*)orow8)[lane + 64 * j] = q; } }
}
DI void final_row(const bf16_t* xrow, float* orow, const f32x4 (&Gv)[8], int lane) {
    f32x4* xr = (f32x4*)orow + lane;
    f32x4 v[8]; float s = 0.f;
#pragma unroll
    for (int j = 0; j < 8; ++j) { const u32x2 w = ((const u32x2*)xrow)[lane + 64 * j]; v[j] = (f32x4){__uint_as_float(w.x << 16), __uint_as_float(w.x & 0xffff0000u), __uint_as_float(w.y << 16), __uint_as_float(w.y & 0xffff0000u)};
        s += (v[j][0] * v[j][0] + v[j][1] * v[j][1]) + (v[j][2] * v[j][2] + v[j][3] * v[j][3]); }
    const float rstd = 1.f / sqrtf(wave_sum(s) * (1.f / 2048.f) + RMS_EPS);
#pragma unroll
    for (int j = 0; j < 8; ++j) xr[64 * j] = v[j] * rstd * Gv[j];
}
DI void conv_task(const bf16_t* qkv, const float* cw, bf16_t* br, int row0, int lane) {
    const int ch = lane * 8;
    float w0[8], w1[8], w2[8];
#pragma unroll
    for (int j = 0; j < 8; ++j) { w0[j] = cw[ch + j]; w1[j] = cw[512 + ch + j]; w2[j] = cw[1024 + ch + j]; }
    float up2[8], up1[8];
    const bf16_t* rp = qkv + (size_t)row0 * LDQ + ch;
    auto load_u = [&](const bf16_t* r, float (&u)[8]) {
        const bf16x8 cg = *(const bf16x8*)(r + C_CG), xi = *(const bf16x8*)(r + C_XIN);
#pragma unroll
        for (int j = 0; j < 8; ++j) u[j] = bf2f((bf16_t)cg[j]) * bf2f((bf16_t)xi[j]);
    };
    if ((row0 & (SEQ - 1)) == 0) {
#pragma unroll
        for (int j = 0; j < 8; ++j) { up2[j] = 0.f; up1[j] = 0.f; }
    } else { load_u(rp - 2 * LDQ, up2); load_u(rp - LDQ, up1); }
    bf16_t* op = br + (size_t)row0 * 2048 + 1024 + ch;
#pragma unroll
    for (int i = 0; i < 8; ++i) { float u[8]; load_u(rp, u);
        const bf16x8 bg = *(const bf16x8*)(rp + C_BG);
        rp += LDQ; asm volatile("" : "+v"(rp));
        float y[8];
#pragma unroll
        for (int j = 0; j < 8; ++j) y[j] = bf2f((bf16_t)bg[j]) * (w0[j] * up2[j] + w1[j] * up1[j] + w2[j] * u[j]);
        u32x4 o; o.x = cvtpk(y[0], y[1]); o.y = cvtpk(y[2], y[3]); o.z = cvtpk(y[4], y[5]); o.w = cvtpk(y[6], y[7]);
        *(u32x4*)op = o; op += 2048; asm volatile("" : "+v"(op));
#pragma unroll
        for (int j = 0; j < 8; ++j) { up2[j] = up1[j]; up1[j] = u[j]; } }
}
DI void fcum_task(const bf16_t* qkvb  , float bf_h, int h, float* out  , int lane) {
    const bf16_t* p = qkvb + (size_t)(32 * lane) * LDQ + C_FD + h;
    float v[32];
#pragma unroll
    for (int i = 0; i < 32; ++i) { v[i] = bf2f(*p); p += LDQ; asm volatile("" : "+v"(p)); }
    float run = 0.f;
#pragma unroll
    for (int i = 0; i < 32; ++i) { const float x = v[i] + bf_h; run -= __logf(1.f + __expf(-x)); v[i] = run; }
    float incl = run;
#pragma unroll
    for (int o = 1; o < 64; o <<= 1) { const float y = __shfl_up(incl, o); if (lane >= o) incl += y; }
    const float excl = incl - run;
    float* op = out + 32 * lane;
#pragma unroll
    for (int i = 0; i < 32; i += 4) *(f32x4*)(op + i) = (f32x4){(v[i] + excl) * LOG2E, (v[i + 1] + excl) * LOG2E, (v[i + 2] + excl) * LOG2E, (v[i + 3] + excl) * LOG2E};
}
DI int rowsum16(int x) { x += __shfl_xor(x, 8); x += __shfl_xor(x, 4); x += __shfl_xor(x, 2); x += __shfl_xor(x, 1); return x; }
DI void select_task(const bf16_t* qkvb  , const bf16_t* ikb  , unsigned long long* mrow  , int t0, LAS unsigned long long* wl, int lane_in) {
    int lane = lane_in; asm volatile("" : "+v"(lane));
    const int fr = lane & 15, fq = lane >> 4, t = t0 + fq;
    const int nch = __builtin_amdgcn_readfirstlane((t0 + 3) / 256 + 1);
    const bf16_t* ap = qkvb + (size_t)(t0 + (fr >> 2)) * LDQ + C_IQ + (fr & 3) * 64 + fq * 8;
    const bf16x8 a0 = *(const bf16x8*)ap, a1 = *(const bf16x8*)(ap + 32);
    float w[4]; { const u32x2 ww = *(const u32x2*)(qkvb + (size_t)t * LDQ + C_IW);
        w[0] = __uint_as_float(ww.x << 16) * IDX_SCALE; w[1] = __uint_as_float(ww.x & 0xffff0000u) * IDX_SCALE; w[2] = __uint_as_float(ww.y << 16) * IDX_SCALE; w[3] = __uint_as_float(ww.y & 0xffff0000u) * IDX_SCALE; }
    unsigned u[128];
    const int tf = t - fr;
    const char* kbase = (const char*)ikb;
    unsigned voff = (unsigned)lane * 16u;
#pragma unroll
    for (int c = 0; c < 8; ++c) {
        if (c < nch) {
#pragma unroll
            for (int ii = 0; ii < 16; ++ii) { const int i = c * 16 + ii;
                const bf16x8 b0 = *(const bf16x8*)(kbase + voff), b1 = *(const bf16x8*)(kbase + voff + 1024);
                voff += 16 * 64 * 2; asm volatile("" : "+v"(voff));
                f32x4 acc = (f32x4){0.f, 0.f, 0.f, 0.f};
                acc = __builtin_amdgcn_mfma_f32_16x16x32_bf16(a0, b0, acc, 0, 0, 0);
                acc = __builtin_amdgcn_mfma_f32_16x16x32_bf16(a1, b1, acc, 0, 0, 0);
                const float sc = ((w[0] * fmaxf(acc[0], 0.f) + w[1] * fmaxf(acc[1], 0.f)) + w[2] * fmaxf(acc[2], 0.f)) + w[3] * fmaxf(acc[3], 0.f);
                unsigned bits = __float_as_uint(sc); if (bits == 0x80000000u) bits = 0u;
                const unsigned key = (bits & 0x80000000u) ? ~bits : (bits | 0x80000000u);
                u[i] = (16 * i <= tf) ? key : 0u; }
        } else {
#pragma unroll
            for (int ii = 0; ii < 16; ++ii) u[c * 16 + ii] = 0u;
        }
    }
#define CNT_GE(cnt, x, c) asm("v_cmp_ge_u32 vcc, %1, %2\n\tv_addc_co_u32 %0, vcc, 0, %0, vcc" : "+v"(cnt) : "v"(x), "v"(c) : "vcc")
#define CNT_GT(cnt, x, c) asm("v_cmp_gt_u32 vcc, %1, %2\n\tv_addc_co_u32 %0, vcc, 0, %0, vcc" : "+v"(cnt) : "v"(x), "v"(c) : "vcc")
#define FOR_CHUNKS(BODY) _Pragma("unroll") for (int c_ = 0; c_ < 8; ++c_) { if (c_ < nch) { _Pragma("unroll") for (int ii_ = 0; ii_ < 16; ++ii_) { const int i = c_ * 16 + ii_; BODY; } } }
    unsigned T = 0u;
    bool done = false;
#pragma unroll 1
    for (int bit = 31; bit >= 0; --bit) { const unsigned c = T | (1u << bit); int cnt = 0;
        FOR_CHUNKS(CNT_GE(cnt, u[i], c));
        cnt = rowsum16(cnt); if (!done && cnt >= 256) T = c; done = done || (cnt == 256);
        if (__all(done)) break; }
    int cgt = 0, cge = 0;
    FOR_CHUNKS(CNT_GT(cgt, u[i], T); CNT_GE(cge, u[i], T));
    cgt = rowsum16(cgt); cge = rowsum16(cge);
    const int need = 256 - cgt; const bool tie = (cge - cgt) > need;
    int X0 = 4095;
    if (__any(tie)) { int x = 0; const unsigned notT = ~T;
#pragma unroll 1
        for (int bit = 10; bit >= 0; --bit) { const int c = x | (1 << bit); int g = 0; const int cf = c - fr;
            FOR_CHUNKS(unsigned tmp;
                asm("v_cmp_lt_i32 vcc, %6, %3\n\tv_cndmask_b32 %1, %4, %2, vcc\n\tv_cmp_eq_u32 vcc, %1, %5\n\tv_addc_co_u32 %0, vcc, 0, %0, vcc"
                    : "+v"(g), "=&v"(tmp) : "v"(u[i]), "v"(cf), "v"(notT), "v"(T), "n"(16 * i) : "vcc"));
            g = rowsum16(g); if (g < need) x = c; }
        if (tie) X0 = x; }
#undef CNT_GE
#undef CNT_GT
    const int xf = X0 - fr;
    FOR_CHUNKS(const bool sel = (u[i] > T) || (u[i] == T && 16 * i <= xf);
        const unsigned long long bal = __ballot(sel); if (lane == 0) wl[i] = bal;
        if ((i & 3) == 3) asm volatile("" ::: "memory"));
#undef FOR_CHUNKS
    LDS_WAIT(); asm volatile("" ::: "memory");
#pragma unroll
    for (int half = 0; half < 2; ++half) { const int j = fr + 16 * half; unsigned long long word = 0ull;
        if (j < nch * 4) {
#pragma unroll
            for (int i4 = 0; i4 < 4; ++i4) word |= ((wl[4 * j + i4] >> (16 * fq)) & 0xFFFFull) << (16 * i4); }
        mrow[(size_t)t * 32 + j] = word; }
    LDS_WAIT(); asm volatile("" ::: "memory");
}
DI void select_causal_task(unsigned long long* mrow, int t0, int lane) {
    const int fr = lane & 15, fq = lane >> 4, t = t0 + fq;
#pragma unroll
    for (int half = 0; half < 2; ++half) { const int j = fr + 16 * half; const int n = t - 64 * j + 1;
        const unsigned long long word = n >= 64 ? ~0ull : (n <= 0 ? 0ull : ((1ull << n) - 1ull));
        mrow[(size_t)t * 32 + j] = word; }
}
DI void select_any(const bf16_t* qkvb, const bf16_t* ikb, unsigned long long* mrow, int t0, LAS unsigned long long* wl, int lane) {
    if (t0 + 3 < 256) select_causal_task(mrow, t0, lane);
    else select_task(qkvb, ikb, mrow, t0, wl, lane);
}

constexpr size_t MiB = 1u << 20;
constexpr size_t WS_CTL = 0, CTL_ZERO_BYTES = 1 * MiB;
constexpr size_t WS_MODF = 1 * MiB;
constexpr size_t WS_IK = 2 * MiB;
constexpr size_t WS_MODP = 2 * MiB;
constexpr size_t WS_FCUM = 14 * MiB;
constexpr size_t WS_MASK = 15 * MiB;
constexpr size_t WS_STASH = 20 * MiB;
constexpr size_t WS_W = 52 * MiB;
constexpr size_t OW_IN = 0, OW_IN8 = 16 * MiB  , OW_G = 26 * MiB, OW_B = 58 * MiB, OW_O = 66 * MiB, OW_1 = 74 * MiB, OW_2 = 106 * MiB, LW_BYTES = 138 * MiB;
constexpr size_t WS_H = WS_W + 2 * LW_BYTES;
constexpr size_t WS_BR = WS_H + 64 * MiB;
constexpr size_t WS_R1 = WS_BR + 64 * MiB;
constexpr size_t WS_H8 = WS_R1 + 256 * MiB;
constexpr size_t WS_XB = WS_H8 + 32 * MiB;
constexpr size_t WS_END = WS_XB + 64 * MiB;
constexpr int CW_BAR = 4096;
constexpr int CW_QUEUE = 16384;

constexpr int RING_OFF = 0, RING_BYTES = 131072;
constexpr int LDSCTL_OFF = RING_BYTES, MISC_OFF = LDSCTL_OFF + 320;
constexpr int LDS_BYTES = 147456;
static_assert(att::LDS_END <= RING_BYTES, "attention scratch inside the ring region");


constexpr int NWAVES = 8;
constexpr int N_PHASES = 23;
struct Args { const float* in[19]; float* out; unsigned char* ws; int ph_lo, ph_hi; };

typedef __attribute__((address_space(4))) const unsigned char* kargp_t;
DI kargp_t karg_base() { kargp_t kp = (kargp_t)__builtin_amdgcn_kernarg_segment_ptr(); asm volatile("" : "+s"(kp)); return kp; }
DI unsigned long long karg_u64(int i) { return *(const __attribute__((address_space(4))) unsigned long long*)(karg_base() + 8 * i); }
DI const float* karg_in(int i) { return (const float*)(GAS const float*)karg_u64(i); }
DI float* karg_out() { return (float*)(GAS float*)karg_u64(19); }
DI unsigned char* karg_ws() { return (unsigned char*)(GAS unsigned char*)karg_u64(20); }
#define ARG_IN(i) karg_in(i)

constexpr int CV_IN = 32 * 208, CV_G = 32 * 256, CV_B = 4 * 8 * 64, CV_O = 32 * 64, CV_1 = 32 * 256, CV_2 = 128 * 64, CV_L = CV_IN + CV_G + CV_B + CV_O + CV_1 + CV_2;
DI void convert_item(int it, unsigned char* ws, LAS float* scr, int lane) {
    const int l = it / CV_L; int r = it % CV_L;
    unsigned char* wl_ = ws + WS_W + (size_t)l * LW_BYTES;
    if (r < 32 * 128) { transpose_item(ARG_IN(5) + (size_t)l * 2048 * 6472, 2048, 6472, 128, (bf16_t*)(wl_ + OW_IN), MapWin(), scr, r, lane); return; } r -= 32 * 128;
    if (r < 32 * 80) { transpose_item8(ARG_IN(5) + (size_t)l * 2048 * 6472, 2048, 6472, 80, (unsigned char*)(wl_ + OW_IN8), MapWin(), N_IN16, scr, r, lane); return; } r -= 32 * 80;
    if (r < CV_G) { transpose_item8(ARG_IN(11) + (size_t)l * 2048 * 8192, 2048, 8192, 256, (unsigned char*)(wl_ + OW_G), MapGate(), 0, scr, r, lane); return; } r -= CV_G;
    const float* W; int K, Ns, nblk; bf16_t* WT;
    if (r < CV_B) { const int g = r / 512; r -= g * 512; W = ARG_IN(13) + (size_t)(l * 4 + g) * 512 * 2048; K = 512; Ns = 2048; nblk = 64; WT = (bf16_t*)(wl_ + OW_B) + (size_t)g * 2048 * 512; }
    else { r -= CV_B;
        if (r < CV_O) { W = ARG_IN(14) + (size_t)l * 2048 * 2048; K = 2048; Ns = 2048; nblk = 64; WT = (bf16_t*)(wl_ + OW_O); }
        else { r -= CV_O;
            if (r < CV_1) { W = ARG_IN(16) + (size_t)l * 2048 * 8192; K = 2048; Ns = 8192; nblk = 256; WT = (bf16_t*)(wl_ + OW_1); }
            else { r -= CV_1; W = ARG_IN(17) + (size_t)l * 8192 * 2048; K = 8192; Ns = 2048; nblk = 64; WT = (bf16_t*)(wl_ + OW_2); } } }
    transpose_item(W, K, Ns, nblk, WT, MapPlain(), scr, r, lane);
}

template <int MODE>
DI void attn_queue(LAS unsigned char* lds, volatile LAS unsigned* MISC, int qidx, int l, int tid, int lane, int variant = 0) {
    unsigned char* ws = karg_ws();
    unsigned* qhead = (unsigned*)(ws + WS_CTL) + CW_QUEUE + 64 * qidx;
    bf16_t* QKV = (bf16_t*)(ws + WS_R1); bf16_t* BR = (bf16_t*)(ws + WS_BR);
    float lamv = 0.f, post = 0.f;
    if (MODE == 1) { const float* lq = ARG_IN(8) + l * 256; const float a = wave_sum(lq[lane] * lq[64 + lane]), b = wave_sum(lq[128 + lane] * lq[192 + lane]);
        const float lam_init = 0.8f - 0.6f * expf(-0.3f * (float)l); lamv = expf(a) - expf(b) + lam_init; post = 1.f - lam_init; }
    for (;;) {
        if (tid == 0) MISC[0] = __hip_atomic_fetch_add(qhead, 1u, RLX_AGENT);
        __syncthreads();
        const unsigned u = MISC[0];
        __syncthreads();
        if (u >= 256u) break;
        const int qb = 7 - (int)(u >> 5), bh = (int)(u & 31u), b = bh >> 2, h = bh & 3;
        att::UnitArgs A;
        const size_t rowb = (size_t)b * SEQ;
        const int cq = MODE == 0 ? C_QA : (MODE == 1 ? C_QB : C_QD), ck = MODE == 0 ? C_KA : (MODE == 1 ? C_KB : C_KD), cv = MODE == 0 ? C_VA : (MODE == 1 ? C_VB : C_VD);
        const int oc = MODE == 0 ? 0 : (MODE == 1 ? 512 : 1536);
        A.Qp = QKV + rowb * LDQ + cq + h * 128; A.Kp = QKV + rowb * LDQ + ck + h * 128; A.Vp = QKV + rowb * LDQ + cv + h * 128;
        A.Op = BR + rowb * 2048 + oc + h * 128; A.q0 = qb * 256;
        A.maskp = (const unsigned long long*)(ws + WS_MASK) + rowb * 32;
        A.fcum = (const float*)(ws + WS_FCUM) + (size_t)(b * 4 + h) * SEQ;
        A.relb = ARG_IN(10); A.relcol = (MODE == 1 ? 4 : 0) + h;
        A.lam = lamv; A.post = post; A.gsub = ARG_IN(9) + l * 128;
        A.stash = (float*)(ws + WS_STASH) + (size_t)blockIdx.x * 64 * 512;
        A.variant = variant; if (variant) A.Op = (bf16_t*)(ws + WS_END) + rowb * 2048 + oc + h * 128;
#ifdef ATT_V1
        att::attn_unit<MODE>((LAS char*)lds, A);
#else
        att::attn_unit_p<MODE>((LAS char*)lds, A);
#endif
    }
}

#define IN(k) (lo <= (k) && (k) < hi)
#ifdef PROBE_TIME
#ifndef PROBE_BLK
#define PROBE_BLK 0
#endif
#ifndef PROBE_SEL
#define PROBE_SEL(k) 1
#endif
#ifndef PROBE_Q
#define PROBE_Q 50.f
#endif
constexpr int CW_TIME = 20000, CW_TPREV = 20064;
#define SEAM(k) do { if (IN((k) + 1)) { unsigned* cw_ = (unsigned*)(karg_ws() + WS_CTL); const bool me_ = (blockIdx.x == PROBE_BLK && threadIdx.x == 0); \
        const unsigned ta_ = (unsigned)__builtin_amdgcn_s_memrealtime(); \
        if (me_ && PROBE_TIME == 2 && PROBE_SEL(k)) atomicAdd(cw_ + CW_TIME, ta_ - cw_[CW_TPREV]); \
        xcd_barrier(bar); \
        const unsigned te_ = (unsigned)__builtin_amdgcn_s_memrealtime(); \
        if (me_) { if (PROBE_TIME == 1) atomicAdd(cw_ + CW_TIME, te_ - ta_); cw_[CW_TPREV] = te_; } } } while (0)
#else
#define SEAM(k) do { if (IN((k) + 1)) xcd_barrier(bar); } while (0)
#endif
#define PH_PTRS int tid_p = threadIdx.x; asm volatile("" : "+v"(tid_p)); const int tid = tid_p, lane = tid & 63; (void)lane; unsigned char* ws = karg_ws(); float* xbuf = karg_out(); float* modf = (float*)(ws + WS_MODF); float* modp = (float*)(ws + WS_MODP); \
    bf16_t* Hb = (bf16_t*)(ws + WS_H); bf16_t* BR = (bf16_t*)(ws + WS_BR); bf16_t* R1 = (bf16_t*)(ws + WS_R1); \
    (void)xbuf; (void)modf; (void)modp; (void)Hb; (void)BR; (void)R1
#define PH_LAYER PH_PTRS; unsigned char* wl_ = ws + WS_W + (size_t)l * LW_BYTES; const float* modl = modf + (size_t)l * 8 * 12288; (void)wl_; (void)modl
template <int l, int LO, int HI>
DI void layer_phases(LAS unsigned char* lds, volatile LAS unsigned* MISC, const XcdBarrier& bar, int wave, int G, int bx, int gw, int NGW) {
    constexpr int lo = LO, hi = HI;
        const int pb = 2 + 10 * l;
        if (IN(pb + 0)) { PH_LAYER;
            const float* g1 = ARG_IN(4) + l * 2048; bf16_t* xb16 = (bf16_t*)(ws + WS_XB); (void)xb16;
#ifndef PROBE_REP_N1
#define PROBE_REP_N1 1
#endif
#pragma unroll 1
          for (int rep = 0; rep < PROBE_REP_N1; ++rep)
            for (int rb = gw; rb < M_TOK / 8; rb += NGW) { const int b = (rb * 8) / SEQ; f32x4 Av[8], Bv[8];
#pragma unroll
                for (int j = 0; j < 8; ++j) { const int c = 4 * lane + 256 * j; const f32x4 g = *(const f32x4*)(g1 + c), sc = *(const f32x4*)(modl + b * 12288 + 2048 + c); Av[j] = g * (sc + 1.f); Bv[j] = *(const f32x4*)(modl + b * 12288 + c); }
#pragma unroll 1
                for (int i = 0; i < 8; ++i) { const size_t ro = (size_t)(rb * 8 + i) * 2048;
                    if (l == 0) norm_row<true, false>(ARG_IN(0) + ro, Hb + ro, ws + WS_H8 + ro, Av, Bv, lane); else norm_row<true, true>(xb16 + ro, Hb + ro, ws + WS_H8 + ro, Av, Bv, lane); } }
            SEAM(pb + 0);
        }
        if (IN(pb + 1)) { PH_LAYER;
            { pg8::Gemm g{(const bf16_t*)(ws + WS_H8), (const bf16_t*)(wl_ + OW_IN8), M_TOK, N_IN8, 1024, 1024, 1024, 1 << 30, 0}; pg8::StaticOrder S; S.init(M_TOK, N_IN8, G, bx);
              pg8::EpiBf16s E{R1 + N_IN16, LDQ, 1.f / WG8_SCALE, QSCALE128 / WG8_SCALE, 0xC3u};
              pg8::gemm_phase<pg8::EpiBf16s, pg8::StaticOrder, true, true, true>(lds + RING_OFF, g, S, E); }
            { pg8::Gemm g{Hb, (const bf16_t*)(wl_ + OW_IN), M_TOK, N_IN16, 2048, 2048, 2048, 1 << 30, 0}; pg8::StaticOrder S; S.init(M_TOK, N_IN16, G, bx);
              pg8::EpiBf16ik E{R1, LDQ, (bf16_t*)(ws + WS_IK)};
              pg8::gemm_phase<pg8::EpiBf16ik, pg8::StaticOrder, true, true>(lds + RING_OFF, g, S, E); }
            SEAM(pb + 1);
        }
        if (IN(pb + 2)) { PH_LAYER;
            LAS unsigned long long* wlq = (LAS unsigned long long*)(lds + RING_OFF + wave * 16384 + 12288);
            LAS float* scr = (LAS float*)(lds + RING_OFF + wave * 16384); (void)scr;
            int cvn = (l == 0) ? gw : CV_L;
            unsigned long long* mask = (unsigned long long*)(ws + WS_MASK);
            unsigned* qh = (unsigned*)(ws + WS_CTL) + CW_QUEUE + 64 * (12 + l);
#pragma unroll 1
            for (;;) {
                unsigned kq = 0u; if (lane == 0) kq = __hip_atomic_fetch_add(qh, 1u, RLX_AGENT);
                const int k = __builtin_amdgcn_readfirstlane((int)kq);
                if (k >= 6176) break;
                int ln = lane; asm volatile("" : "+v"(ln));
                if (k < 2048 || (k >= 2080 && k < 4128)) { const int j = k < 2048 ? k : k - 32; const int b = j & 7, t0 = (511 - (j >> 3)) * 4;
                    select_any(R1 + (size_t)b * SEQ * LDQ, (const bf16_t*)(ws + WS_IK) + (size_t)b * SEQ * 64, mask + (size_t)b * SEQ * 32, t0, wlq, ln); }
                else if (k < 2080) { const int kk = k - 2048, b = kk >> 2, h = kk & 3; fcum_task(R1 + (size_t)b * SEQ * LDQ, ARG_IN(6)[l * 4 + h], h, (float*)(ws + WS_FCUM) + (size_t)kk * SEQ, ln); }
                else conv_task(R1, ARG_IN(7) + l * 1536, BR, (k - 4128) * 8, ln);
                if (l == 0) {
#pragma unroll 1
                    for (; cvn < CV_L; cvn += NGW) { int l2 = lane; asm volatile("" : "+v"(l2)); convert_item(CV_L + cvn, ws, scr, l2); } }
            }
            if (l == 0) {
#pragma unroll 1
                for (; cvn < CV_L; cvn += NGW) { int l2 = lane; asm volatile("" : "+v"(l2)); convert_item(CV_L + cvn, ws, scr, l2); } }
            SEAM(pb + 2);
        }
        if (IN(pb + 3)) { PH_LAYER;
#ifndef PROBE_REP_M2
#define PROBE_REP_M2 1
#endif
#ifndef PROBE_VARIANT
#define PROBE_VARIANT 0
#endif
#pragma unroll 1
          for (int rep = 0; rep < PROBE_REP_M2; ++rep) {
            if (rep) xcd_barrier(bar);
            attn_queue<1>(lds + RING_OFF, MISC, 3 * l + 0 + 6 * rep, l, tid, lane, rep ? PROBE_VARIANT : 0);
            attn_queue<0>(lds + RING_OFF, MISC, 3 * l + 1 + 6 * rep, l, tid, lane, rep ? PROBE_VARIANT : 0);
            attn_queue<2>(lds + RING_OFF, MISC, 3 * l + 2 + 6 * rep, l, tid, lane, rep ? PROBE_VARIANT : 0);
          }
            SEAM(pb + 3);
        }
        if (IN(pb + 4)) { PH_LAYER;
            pg8::Gemm g{BR, (const bf16_t*)(wl_ + OW_B), M_TOK, 8192, 512, 2048, 512, 8, 512}; pg8::StaticOrder S; S.init(M_TOK, 8192, G, bx);
            pg8::EpiPtile E{R1};

#ifndef NO_G2
#ifndef PROBE_REP_G2
#define PROBE_REP_G2 1
#endif
#pragma unroll 1
            for (int rep = 0; rep < PROBE_REP_G2; ++rep)
            pg8::gemm_phase<pg8::EpiPtile, pg8::StaticOrder, true, true>(lds + RING_OFF, g, S, E);
#endif
            SEAM(pb + 4);
        }
        if (IN(pb + 5)) { PH_LAYER;
            pg8::Gemm g{(const bf16_t*)(ws + WS_H8), (const bf16_t*)(wl_ + OW_G), M_TOK, 8192, 1024, 1024, 1024, 1 << 30, 0}; pg8::StaticOrder S; S.init(M_TOK, 8192, G, bx);
            pg8::EpiGate E{R1, ARG_IN(12) + l * 8192, BR, 1.f / WG8_SCALE};

#ifndef NO_G3
#ifndef PROBE_REP_G3
#define PROBE_REP_G3 1
#endif
#pragma unroll 1
            for (int rep = 0; rep < PROBE_REP_G3; ++rep)
            S.rev = true; pg8::gemm_phase<pg8::EpiGate, pg8::StaticOrder, true, true, true>(lds + RING_OFF, g, S, E);
#endif

            SEAM(pb + 5);
        }
        if (IN(pb + 6)) { PH_LAYER;
            pg8::Gemm g{BR, (const bf16_t*)(wl_ + OW_O), M_TOK, 2048, 2048, 2048, 2048, 1 << 30, 0}; pg8::StaticOrder S; S.init(M_TOK, 2048, G, bx);
            bf16_t* xb16 = (bf16_t*)(ws + WS_XB);
            pg8::EpiResidB<l == 0> E{(l == 0) ? (const void*)ARG_IN(0) : (const void*)xb16, xb16, modl + 4096, 12288};

#ifndef NO_G4
#ifdef PROBE_NULL_G4
            { pg8::EpiNull EN{(float*)(ws + WS_FCUM)}; pg8::gemm_phase<pg8::EpiNull, pg8::StaticOrder, true, true>(lds + RING_OFF, g, S, EN); }
#endif
            pg8::gemm_phase<pg8::EpiResidB<l == 0>, pg8::StaticOrder, true, true>(lds + RING_OFF, g, S, E);
#endif
            SEAM(pb + 6);
        }
        if (IN(pb + 7)) { PH_LAYER;
            const float* g2 = ARG_IN(15) + l * 2048;
            for (int rb = gw; rb < M_TOK / 8; rb += NGW) { const int b = (rb * 8) / SEQ; f32x4 Av[8], Bv[8];
#pragma unroll
                for (int j = 0; j < 8; ++j) { const int c = 4 * lane + 256 * j; const f32x4 g = *(const f32x4*)(g2 + c), sc = *(const f32x4*)(modl + b * 12288 + 8192 + c); Av[j] = g * (sc + 1.f); Bv[j] = *(const f32x4*)(modl + b * 12288 + 6144 + c); }
#pragma unroll 1
                for (int i = 0; i < 8; ++i) norm_row<false, true>((const bf16_t*)(ws + WS_XB) + (size_t)(rb * 8 + i) * 2048, Hb + (size_t)(rb * 8 + i) * 2048, nullptr, Av, Bv, lane); }
            SEAM(pb + 7);
        }
        if (IN(pb + 8)) { PH_LAYER;
            pg8::Gemm g{Hb, (const bf16_t*)(wl_ + OW_1), M_TOK, 8192, 2048, 2048, 2048, 1 << 30, 0}; pg8::StaticOrder S; S.init(M_TOK, 8192, G, bx);
            pg8::EpiBf16<2> E{R1, 8192};

#ifndef NO_G5
#ifdef PROBE_NULL_G5
            { pg8::EpiNull EN{(float*)(ws + WS_FCUM)}; pg8::gemm_phase<pg8::EpiNull, pg8::StaticOrder, true, true>(lds + RING_OFF, g, S, EN); }
#endif
#ifdef PROBE_SPLIT_G5
            { pg8::RangeOrder S1; S1.init(M_TOK, 8192, G, bx); S1.i0 = 0; S1.n = 4; pg8::RangeOrder S2; S2.init(M_TOK, 8192, G, bx); S2.i0 = 4; S2.n = 4;
              pg8::gemm_phase<pg8::EpiBf16<2>, pg8::RangeOrder, true, true>(lds + RING_OFF, g, S1, E);
              xcd_barrier(bar);
              pg8::gemm_phase<pg8::EpiBf16<2>, pg8::RangeOrder, true, true>(lds + RING_OFF, g, S2, E); }
#else
            pg8::gemm_phase<pg8::EpiBf16<2>, pg8::StaticOrder, true, true>(lds + RING_OFF, g, S, E);
#endif
#endif

            SEAM(pb + 8);
        }
        if (IN(pb + 9)) { PH_LAYER;
            pg8::Gemm g{R1, (const bf16_t*)(wl_ + OW_2), M_TOK, 2048, 8192, 8192, 8192, 1 << 30, 0}; pg8::StaticOrder S; S.init(M_TOK, 2048, G, bx);
            bf16_t* xb16 = (bf16_t*)(ws + WS_XB);
            pg8::EpiResidB<false> E{xb16, xb16, modl + 10240, 12288};

#ifndef NO_G6
#ifdef PROBE_DUP_G6
            { pg8::EpiResid ED{xbuf, (float*)(ws + WS_H), modl + 10240, 12288}; pg8::gemm_phase<pg8::EpiResid, pg8::StaticOrder, true, true>(lds + RING_OFF, g, S, ED); }
#endif
#ifdef PROBE_NULL_G6
            { pg8::EpiNull EN{(float*)(ws + WS_FCUM)}; pg8::gemm_phase<pg8::EpiNull, pg8::StaticOrder, true, true>(lds + RING_OFF, g, S, EN); }
#endif
            S.rev = true; pg8::gemm_phase<pg8::EpiResidB<false>, pg8::StaticOrder, true, true>(lds + RING_OFF, g, S, E);
#endif
            SEAM(pb + 9);
        }
}

template <int LO, int HI>
__global__ void __launch_bounds__(NWAVES * 64, 2) mk_fwd(Args args) {
    extern __shared__ __attribute__((aligned(16))) unsigned char lds_raw[];
    LAS unsigned char* lds = (LAS unsigned char*)lds_raw;
    volatile LAS unsigned* MISC = (volatile LAS unsigned*)(lds + MISC_OFF);
    const int tid0 = threadIdx.x, wave = __builtin_amdgcn_readfirstlane(tid0 >> 6);
    const int G = gridDim.x; const int bx = blockIdx.x; const int vcu = (G % 8 == 0) ? (bx % 8) * (G / 8) + bx / 8 : bx;
    const int gw = vcu * NWAVES + wave, NGW = G * NWAVES;
    for (int u = tid0; u < (LDS_BYTES - LDSCTL_OFF) / 4; u += NWAVES * 64) ((LAS unsigned*)(lds + LDSCTL_OFF))[u] = 0u;
    __syncthreads();
    constexpr int lo = LO, hi = HI; (void)args;
    XcdBarrier bar; bar.bar = (unsigned*)(karg_ws() + WS_CTL) + CW_BAR; bar.x = 0; bar.st = nullptr;
    if constexpr (hi - lo > 1) bar = xcd_barrier_post((unsigned*)(karg_ws() + WS_CTL) + CW_BAR, MISC + 8);

#ifdef PROBE_TIME
    if (blockIdx.x == PROBE_BLK && threadIdx.x == 0) ((unsigned*)(karg_ws() + WS_CTL))[CW_TPREV] = (unsigned)__builtin_amdgcn_s_memrealtime();
#endif
    if (IN(0)) { PH_PTRS;
        LAS float* scr = (LAS float*)(lds + RING_OFF + wave * 16384);
#ifndef PROBE_REP_P0
#define PROBE_REP_P0 1
#endif
#pragma unroll 1
        for (int rep = 0; rep < PROBE_REP_P0; ++rep) {
        for (int it = gw; it < CV_L; it += NGW) convert_item(it, ws, scr, lane);
        for (int it = gw; it < 2 * 48 * 16; it += NGW) mod_partial_item(ARG_IN(1), ARG_IN(2), modp, it, lane);
        }
        SEAM(0);
    }
    if (IN(1)) { PH_PTRS;
        for (int i = bx * 512 + tid; i < 2 * 8 * 12288; i += G * 512) { const int n = i % 12288, l = i / (8 * 12288);
            float s = ARG_IN(3)[l * 12288 + n];
#pragma unroll
            for (int kc = 0; kc < 16; ++kc) s += modp[(size_t)kc * (2 * 8 * 12288) + i];
            modf[i] = s; }
        SEAM(1);
    }
    constexpr int L_LO = (LO <= 2) ? 0 : (LO - 2) / 10, L_HI = (HI >= 22) ? NLAYER : (HI - 2 + 9) / 10;
    if constexpr (L_LO <= 0 && 0 < L_HI) layer_phases<0, LO, HI>(lds, MISC, bar, wave, G, bx, gw, NGW);
    if constexpr (L_LO <= 1 && 1 < L_HI) layer_phases<1, LO, HI>(lds, MISC, bar, wave, G, bx, gw, NGW);
    if (IN(22)) { PH_PTRS;
        f32x4 Gv[8];
#pragma unroll
        for (int j = 0; j < 8; ++j) Gv[j] = *(const f32x4*)(ARG_IN(18) + 4 * lane + 256 * j);
        for (int rb = gw; rb < M_TOK / 8; rb += NGW) {
#pragma unroll 1
            for (int i = 0; i < 8; ++i) final_row((const bf16_t*)(ws + WS_XB) + (size_t)(rb * 8 + i) * 2048, xbuf + (size_t)(rb * 8 + i) * 2048, Gv, lane); }
#ifdef PROBE_TIME
        if (bx == 0 && tid == 0) { asm volatile("s_waitcnt vmcnt(0)" ::: "memory"); const unsigned* cw_ = (const unsigned*)(ws + WS_CTL); float t_us = (float)cw_[CW_TIME] * 0.01f; t_us = floorf(t_us / PROBE_Q + 0.5f) * PROBE_Q;
            xbuf[0] = sqrtf(t_us * 1e-3f * 33554432.f); }
#endif
    }
}

#if !MK_ONE_LAUNCH
template <int P> static void set_attr_from() { if constexpr (P < N_PHASES) { (void)hipFuncSetAttribute((const void*)mk_fwd<P, P + 1>, hipFuncAttributeMaxDynamicSharedMemorySize, LDS_BYTES); set_attr_from<P + 1>(); } }
template <int P> static void launch_from(int grid, hipStream_t stream, Args a) {
    if constexpr (P < N_PHASES) { a.ph_lo = P; a.ph_hi = P + 1; hipLaunchKernelGGL((mk_fwd<P, P + 1>), dim3(grid), dim3(NWAVES * 64), LDS_BYTES, stream, a); launch_from<P + 1>(grid, stream, a); } }
#endif
extern "C" void kernel_launch(void* const* d_in, const int* in_sizes, int n_in, void* d_out, int out_size, void* d_ws, size_t ws_size, hipStream_t stream) {
    static int grid = 0;
    if (grid == 0) {
        if (n_in != 19 || in_sizes[0] != M_TOK * DM || out_size != M_TOK * DM || ws_size < WS_END) {
            fprintf(stderr, "kernel_launch: shape / workspace mismatch (n_in %d, in0 %d, out %d, ws %zu, need %zu); nothing launched\n", n_in, n_in > 0 ? in_sizes[0] : -1, out_size, ws_size, (size_t)WS_END); grid = -1; return; }
        int dev = 0, cus = 0, per_cu = 0;
        if (hipGetDevice(&dev) != hipSuccess || hipDeviceGetAttribute(&cus, hipDeviceAttributeMultiprocessorCount, dev) != hipSuccess) { fprintf(stderr, "kernel_launch: device query failed\n"); grid = -1; return; }
#if MK_ONE_LAUNCH
        if (hipFuncSetAttribute((const void*)mk_fwd<0, N_PHASES>, hipFuncAttributeMaxDynamicSharedMemorySize, LDS_BYTES) != hipSuccess) { fprintf(stderr, "kernel_launch: hipFuncSetAttribute failed\n"); grid = -1; return; }
        if (hipOccupancyMaxActiveBlocksPerMultiprocessor(&per_cu, (const void*)mk_fwd<0, N_PHASES>, NWAVES * 64, LDS_BYTES) != hipSuccess || per_cu < 1) fprintf(stderr, "kernel_launch: occupancy query reports %d workgroups per CU\n", per_cu);
#else
        set_attr_from<0>();
#endif
        (void)hipGetLastError();
        grid = cus;
    }
    if (grid < 0) return;
    if (hipMemsetAsync((char*)d_ws + WS_CTL, 0, CTL_ZERO_BYTES, stream) != hipSuccess) { fprintf(stderr, "kernel_launch: memset failed\n"); return; }
    Args a{};
    for (int i = 0; i < 19; ++i) a.in[i] = (const float*)d_in[i];
    a.out = (float*)d_out; a.ws = (unsigned char*)d_ws;
#if MK_ONE_LAUNCH
    a.ph_lo = 0; a.ph_hi = N_PHASES;
    hipLaunchKernelGGL((mk_fwd<0, N_PHASES>), dim3(grid), dim3(NWAVES * 64), LDS_BYTES, stream, a);
#else
    launch_from<0>(grid, stream, a);
#endif
    const hipError_t le = hipPeekAtLastError();
    if (le != hipSuccess) fprintf(stderr, "kernel_launch: launch failed: %s\n", hipGetErrorName(le));
}
```

```cpp
#define ATT_V1 1
#include <hip/hip_runtime.h>
#include <cstdio>
#include <cstdint>

#ifndef MK_ONE_LAUNCH
#define MK_ONE_LAUNCH 1
#endif

#define DI __device__ __forceinline__
#define LAS __attribute__((address_space(3)))
#define GAS __attribute__((address_space(1)))

namespace pg8 {
#define PG8_LAS __attribute__((address_space(3)))
typedef unsigned short bf16_t;
typedef short bf16x8 __attribute__((ext_vector_type(8)));
typedef float f32x4 __attribute__((ext_vector_type(4)));
typedef float f32x2 __attribute__((ext_vector_type(2)));
typedef unsigned u32x4 __attribute__((ext_vector_type(4)));
typedef unsigned u32x2 __attribute__((ext_vector_type(2)));
typedef int i32x8a __attribute__((ext_vector_type(8), aligned(16)));
constexpr int BM = 256, BK = 64, HALF = 128, HTB = HALF * BK * 2  , STAGE_BYTES = 8 * HTB, NXCD = 8, WGM = 8;

__host__ __device__ __forceinline__ int lds_byte(int r, int c) { const int st = (r >> 4) * 2 + (c >> 5), rr = r & 15, cc = c & 31, ob = rr * 64 + cc * 2; return st * 1024 + (ob ^ (((ob >> 9) & 1) << 5)); }
__host__ __device__ __forceinline__ void stage_rc(int b, int& R, int& C) { const int st = b / 1024, sb = b % 1024, swz = sb ^ (((sb >> 9) & 1) << 5); R = (st >> 1) * 16 + swz / 64; C = (st & 1) * 32 + (swz % 64) / 2; }
__host__ __device__ __forceinline__ int perm32(int rho) { const int n = rho >> 4, i = rho & 15; return 8 * (i >> 2) + 4 * n + (i & 3); }

struct Unit { int pm, pn; };
struct Gemm { const bf16_t* A; const bf16_t* Bt; int M, N, K, lda, ldb, agdiv, agoff; };

struct StaticOrder {
    int nM, nN, nwg, G, c; bool rev;
    __host__ __device__ void init(int M, int N, int G_, int c_) { nM = M / BM; nN = N / BM; nwg = nM * nN; G = G_; c = c_; rev = false; }
    __host__ __device__ bool next(int i, Unit& u) const {
        const long L = (long)i * G + c; if (L >= nwg) return false;
        int wgid = (int)L; { const int q = nwg / NXCD, r = nwg % NXCD, xcd = wgid % NXCD, off = wgid / NXCD; wgid = (xcd < r ? xcd * (q + 1) : r * (q + 1) + (xcd - r) * q) + off; }
        const int nig = WGM * nN, gid = wgid / nig, fm = gid * WGM, gsz = (nM - fm) < WGM ? (nM - fm) : WGM;
        u.pm = fm + ((wgid % nig) % gsz); u.pn = (wgid % nig) / gsz; if (rev) u.pm = nM - 1 - u.pm; return true;
    }
    __device__ __forceinline__ void a_ready(const Unit&) const {}
    __device__ __forceinline__ void done(const Unit&) const {}
};

struct HalfOrder : StaticOrder {
    int nall, extra; bool hi_half;
    __host__ __device__ bool next(int i, Unit& u) const {
        const int x = c % NXCD, s = c / NXCD, q = nwg / NXCD; const bool mine = ((s >= 16) == hi_half);
        int off;
        if (i < nall) off = i * 32 + s; else { if (!mine || i >= nall + extra) return false; off = nall * 32 + (i - nall) * 16 + (s & 15); }
        if (off >= q) return false;
        const int wgid = x * q + off;
        const int nig = WGM * nN, gid = wgid / nig, fm = gid * WGM, gsz = (nM - fm) < WGM ? (nM - fm) : WGM;
        u.pm = fm + ((wgid % nig) % gsz); u.pn = (wgid % nig) / gsz; return true;
    }
};
struct RangeOrder : StaticOrder {
    int i0, n;
    __host__ __device__ bool next(int i, Unit& u) const { if (i >= n) return false; return StaticOrder::next(i + i0, u); }
};
__device__ __forceinline__ unsigned cvt_pk_bf16(float lo, float hi) { unsigned r; asm volatile("v_cvt_pk_bf16_f32 %0, %1, %2" : "=v"(r) : "v"(lo), "v"(hi)); return r; }

template <int ACT> struct EpiBf16 {
    static constexpr bool PERM = true, AFTER_DRAIN = false;
    bf16_t* O; int ldc;
    __device__ __forceinline__ void operator()(const f32x4 (&acc)[2][2][4][2], const Unit& u, int wr, int wc, int fr, int fq) const {
        const int row0 = u.pm * BM + wr * 64 + fr; const int col0 = u.pn * BM + wc * 32 + 8 * fq;
#pragma unroll
        for (int ai = 0; ai < 2; ++ai)
#pragma unroll
            for (int m = 0; m < 4; ++m) { bf16_t* rowp = O + (size_t)(row0 + ai * HALF + m * 16) * ldc + col0;
#pragma unroll
                for (int bj = 0; bj < 2; ++bj) { f32x4 v0 = acc[ai][bj][m][0], v1 = acc[ai][bj][m][1];
                    if (ACT == 2) {
#pragma unroll
                        for (int j = 0; j < 4; ++j) { const float a = fmaxf(v0[j], 0.f), b = fmaxf(v1[j], 0.f); v0[j] = a * a; v1[j] = b * b; } }
                    u32x4 w; w.x = cvt_pk_bf16(v0[0], v0[1]); w.y = cvt_pk_bf16(v0[2], v0[3]); w.z = cvt_pk_bf16(v1[0], v1[1]); w.w = cvt_pk_bf16(v1[2], v1[3]);
                    *(u32x4*)(rowp + bj * HALF) = w; } }
    }
};
struct EpiNull {
    static constexpr bool PERM = true, AFTER_DRAIN = false;
    float* sink;
    __device__ __forceinline__ void operator()(const f32x4 (&acc)[2][2][4][2], const Unit& u, int wr, int wc, int fr, int fq) const {
        f32x4 s = (f32x4){0.f, 0.f, 0.f, 0.f};
#pragma unroll
        for (int ai = 0; ai < 2; ++ai)
#pragma unroll
            for (int bj = 0; bj < 2; ++bj)
#pragma unroll
                for (int m = 0; m < 4; ++m)
#pragma unroll
                    for (int n = 0; n < 2; ++n) s += acc[ai][bj][m][n];
        if (s[0] + s[1] + s[2] + s[3] == 1.2345678e33f) sink[u.pm] = s[0];
    }
};
struct EpiPtile {
    static constexpr bool PERM = true, AFTER_DRAIN = false; static constexpr int NVM = 16;
    bf16_t* O;
    __device__ __forceinline__ void operator()(const f32x4 (&acc)[2][2][4][2], const Unit& u, int wr, int wc, int fr, int fq) const {
        const int g = u.pn >> 3;
#pragma unroll
        for (int bj = 0; bj < 2; ++bj) { const int d = (u.pn & 7) * BM + bj * HALF + wc * 32 + 8 * fq;
            bf16_t* blk = O + (((size_t)(u.pm * 32 + (d >> 6)) * 4 + g) * 4 + ((d >> 4) & 3)) * (256 * 16) + (d & 15);
#pragma unroll
            for (int ai = 0; ai < 2; ++ai)
#pragma unroll
                for (int m = 0; m < 4; ++m) { const f32x4 v0 = acc[ai][bj][m][0], v1 = acc[ai][bj][m][1];
                    u32x4 w; w.x = cvt_pk_bf16(v0[0], v0[1]); w.y = cvt_pk_bf16(v0[2], v0[3]); w.z = cvt_pk_bf16(v1[0], v1[1]); w.w = cvt_pk_bf16(v1[2], v1[3]);
                    *(u32x4*)(blk + (size_t)(ai * HALF + wr * 64 + m * 16 + fr) * 16) = w; } }
    }
};
struct EpiBf16s {
    static constexpr bool PERM = true, AFTER_DRAIN = false;
    bf16_t* O; int ldc; float sd, sq; unsigned qmask;
    __device__ __forceinline__ void operator()(const f32x4 (&acc)[2][2][4][2], const Unit& u, int wr, int wc, int fr, int fq) const {
        const int row0 = u.pm * BM + wr * 64 + fr; const int col0 = u.pn * BM + wc * 32 + 8 * fq; const float sc = ((qmask >> u.pn) & 1u) ? sq : sd;
#pragma unroll
        for (int ai = 0; ai < 2; ++ai)
#pragma unroll
            for (int m = 0; m < 4; ++m) { bf16_t* rowp = O + (size_t)(row0 + ai * HALF + m * 16) * ldc + col0;
#pragma unroll
                for (int bj = 0; bj < 2; ++bj) { const f32x4 v0 = acc[ai][bj][m][0] * sc, v1 = acc[ai][bj][m][1] * sc;
                    u32x4 w; w.x = cvt_pk_bf16(v0[0], v0[1]); w.y = cvt_pk_bf16(v0[2], v0[3]); w.z = cvt_pk_bf16(v1[0], v1[1]); w.w = cvt_pk_bf16(v1[2], v1[3]);
                    *(u32x4*)(rowp + bj * HALF) = w; } }
    }
};
struct EpiBf16ik {
    static constexpr bool PERM = true, AFTER_DRAIN = false;
    bf16_t* O; int ldc; bf16_t* IK;
    __device__ __forceinline__ void operator()(const f32x4 (&acc)[2][2][4][2], const Unit& u, int wr, int wc, int fr, int fq) const {
        const int row0 = u.pm * BM + wr * 64 + fr; const int col0 = u.pn * BM + wc * 32 + 8 * fq;
        const bool ikt = (u.pn == 15) && (wc < 2);
#pragma unroll
        for (int ai = 0; ai < 2; ++ai)
#pragma unroll
            for (int m = 0; m < 4; ++m) { const int row = row0 + ai * HALF + m * 16; bf16_t* rowp = O + (size_t)row * ldc + col0;
#pragma unroll
                for (int bj = 0; bj < 2; ++bj) { const f32x4 v0 = acc[ai][bj][m][0], v1 = acc[ai][bj][m][1];
                    u32x4 w; w.x = cvt_pk_bf16(v0[0], v0[1]); w.y = cvt_pk_bf16(v0[2], v0[3]); w.z = cvt_pk_bf16(v1[0], v1[1]); w.w = cvt_pk_bf16(v1[2], v1[3]);
                    *(u32x4*)(rowp + bj * HALF) = w;
                    if (bj == 0 && ikt) *(u32x4*)(IK + ((size_t)(row >> 4) * 2 + wc) * 512 + (fq * 16 + fr) * 8) = w; } }
    }
};
struct EpiResid {
    static constexpr bool PERM = false, AFTER_DRAIN = false;
    const float* xin; float* xout; const float* gate; int gstride;
    __device__ __forceinline__ void operator()(const f32x4 (&acc)[2][2][4][2], const Unit& u, int wr, int wc, int fr, int fq) const {
        const int b = u.pm >> 3; const int col0 = u.pn * BM + wc * 32 + 4 * fq;
        f32x4 gv[2][2];
#pragma unroll
        for (int bj = 0; bj < 2; ++bj)
#pragma unroll
            for (int n = 0; n < 2; ++n) gv[bj][n] = *(const f32x4*)(gate + (size_t)b * gstride + col0 + bj * HALF + n * 16);
#pragma unroll
        for (int ai = 0; ai < 2; ++ai)
#pragma unroll
            for (int m = 0; m < 4; ++m) { const size_t off = (size_t)(u.pm * BM + ai * HALF + wr * 64 + m * 16 + fr) * 2048 + col0;
#pragma unroll
                for (int bj = 0; bj < 2; ++bj)
#pragma unroll
                    for (int n = 0; n < 2; ++n) { const f32x4 x = *(const f32x4*)(xin + off + bj * HALF + n * 16);
                        *(f32x4*)(xout + off + bj * HALF + n * 16) = x + gv[bj][n] * acc[ai][bj][m][n]; }
                if (m == 3) asm volatile("" ::: "memory"); }
    }
};
template <bool XF32> struct EpiResidB {
    static constexpr bool PERM = true, AFTER_DRAIN = false;
    const void* xin; bf16_t* xout; const float* gate; int gstride;
    __device__ __forceinline__ void operator()(const f32x4 (&acc)[2][2][4][2], const Unit& u, int wr, int wc, int fr, int fq) const {
        const int b = u.pm >> 3; const int col0 = u.pn * BM + wc * 32 + 8 * fq;
        f32x4 gv[2][2];
#pragma unroll
        for (int bj = 0; bj < 2; ++bj)
#pragma unroll
            for (int n = 0; n < 2; ++n) gv[bj][n] = *(const f32x4*)(gate + (size_t)b * gstride + col0 + bj * HALF + n * 4);
#pragma unroll
        for (int ai = 0; ai < 2; ++ai)
#pragma unroll
            for (int m = 0; m < 4; ++m) { const size_t off = (size_t)(u.pm * BM + ai * HALF + wr * 64 + m * 16 + fr) * 2048 + col0;
#pragma unroll
                for (int bj = 0; bj < 2; ++bj) { f32x4 x0, x1;
                    if (XF32) { x0 = *(const f32x4*)((const float*)xin + off + bj * HALF); x1 = *(const f32x4*)((const float*)xin + off + bj * HALF + 4); }
                    else { const u32x4 xw = *(const u32x4*)((const bf16_t*)xin + off + bj * HALF);
                        x0 = (f32x4){__uint_as_float(xw.x << 16), __uint_as_float(xw.x & 0xffff0000u), __uint_as_float(xw.y << 16), __uint_as_float(xw.y & 0xffff0000u)};
                        x1 = (f32x4){__uint_as_float(xw.z << 16), __uint_as_float(xw.z & 0xffff0000u), __uint_as_float(xw.w << 16), __uint_as_float(xw.w & 0xffff0000u)}; }
                    const f32x4 y0 = x0 + gv[bj][0] * acc[ai][bj][m][0], y1 = x1 + gv[bj][1] * acc[ai][bj][m][1];
                    u32x4 w; w.x = cvt_pk_bf16(y0[0], y0[1]); w.y = cvt_pk_bf16(y0[2], y0[3]); w.z = cvt_pk_bf16(y1[0], y1[1]); w.w = cvt_pk_bf16(y1[2], y1[3]);
                    *(u32x4*)(xout + off + bj * HALF) = w; }
                if (m == 3) asm volatile("" ::: "memory"); }
    }
};
struct EpiGate {
    static constexpr bool PERM = false, AFTER_DRAIN = false;
    const bf16_t* P; const float* bgate; bf16_t* O; float ascale;
    __device__ __forceinline__ void operator()(const f32x4 (&acc)[2][2][4][2], const Unit& u, int wr, int wc, int fr, int fq) const {
        const int d0 = u.pn * 64 + wc * 16 + 4 * fq;
        f32x4 bv[2][2];
#pragma unroll
        for (int bj = 0; bj < 2; ++bj)
#pragma unroll
            for (int n = 0; n < 2; ++n) bv[bj][n] = *(const f32x4*)(bgate + (2 * bj + n) * 2048 + d0);
#pragma unroll
        for (int ai = 0; ai < 2; ++ai)
#pragma unroll
            for (int m = 0; m < 4; ++m) { const size_t row = (size_t)(u.pm * BM + ai * HALF + wr * 64 + m * 16 + fr);
                f32x4 s = (f32x4){0.f, 0.f, 0.f, 0.f};
#pragma unroll
                for (int bj = 0; bj < 2; ++bj)
#pragma unroll
                    for (int n = 0; n < 2; ++n) { const u32x2 pw = *(const u32x2*)(P + ((((size_t)(u.pm * 32 + u.pn) * 4 + (2 * bj + n)) * 4 + wc) * 256 + (ai * HALF + wr * 64 + m * 16 + fr)) * 16 + 4 * fq);
                        const f32x4 pv = (f32x4){__uint_as_float(pw.x << 16), __uint_as_float(pw.x & 0xffff0000u), __uint_as_float(pw.y << 16), __uint_as_float(pw.y & 0xffff0000u)};
                        const f32x4 x = acc[ai][bj][m][n] * ascale + bv[bj][n];
#pragma unroll
                        for (int j = 0; j < 4; ++j) { const float sg = __builtin_amdgcn_rcpf(1.f + __builtin_amdgcn_exp2f(-1.4426950408889634f * x[j])); s[j] += sg * pv[j]; } }
                u32x2 w; w.x = cvt_pk_bf16(s[0], s[1]); w.y = cvt_pk_bf16(s[2], s[3]);
                *(u32x2*)(O + row * 2048 + d0) = w;
                if (m & 1) asm volatile("" ::: "memory"); }
    }
};

template <class Epi, class Sched, bool ALIGN_EPI = false, bool SP2 = false, bool FP8 = false>
__device__ __forceinline__ void gemm_phase(PG8_LAS unsigned char* lds, const Gemm g, const Sched& S, const Epi& E) {
    int tid_l = threadIdx.x; asm volatile("" : "+v"(tid_l));
    const int tid = tid_l, wid = __builtin_amdgcn_readfirstlane(tid >> 6), lane = tid & 63, wr = wid >> 2, wc = wid & 3, fr = lane & 15, fq = lane >> 4;
    const int K = g.K, nt = K / BK;
    unsigned voffA[2], voffB[2];
#pragma unroll
    for (int i = 0; i < 2; ++i) { int R, C; stage_rc(tid * 16 + i * 8192, R, C); const int Rb = Epi::PERM ? ((R & ~31) + perm32(R & 31)) : R;
        voffA[i] = (unsigned)(R * g.lda + C) * 2u; voffB[i] = (unsigned)(Rb * g.ldb + C) * 2u; }
    const size_t kstep = (size_t)(BK * 2);
    const size_t hstepA = (size_t)HALF * g.lda * 2, hstepB = (size_t)HALF * g.ldb * 2;
    const size_t tstepA = 2 * hstepA, tstepB = 2 * hstepB;
    const unsigned ldsw = (unsigned)wid * 1024u;
    const int aoff = FP8 ? lds_byte(wr * 64 + fr, fq * 16) : lds_byte(wr * 64 + fr, fq * 8), boff = FP8 ? lds_byte(wc * 32 + fr, fq * 16) : lds_byte(wc * 32 + fr, fq * 8);
#define PG8_SA(b, h) (((b) * 2 + (h)) * HTB)
#define PG8_SB(b, h) ((4 + (b) * 2 + (h)) * HTB)
#define PG8_STAGE(bufoff, gbase, voff) do { _Pragma("unroll") for (int _i = 0; _i < 2; ++_i) \
        __builtin_amdgcn_global_load_lds((const unsigned*)((const char*)(gbase) + (voff)[_i]), (PG8_LAS unsigned*)(lds + (bufoff) + ldsw + _i * 8192), 16, 0, 0); } while (0)
#define PG8_LDA(dst, b, h) do { if constexpr (FP8) { _Pragma("unroll") for (int m = 0; m < 4; ++m) dst##8[m] = *(const PG8_LAS i32x8a*)(lds + PG8_SA(b, h) + aoff + m * 2048); } \
        else { _Pragma("unroll") for (int m = 0; m < 4; ++m) _Pragma("unroll") for (int k = 0; k < 2; ++k) dst[m][k] = *(const PG8_LAS bf16x8*)(lds + PG8_SA(b, h) + aoff + m * 2048 + k * 1024); } } while (0)
#define PG8_LDB(dst, b, h) do { if constexpr (FP8) { _Pragma("unroll") for (int n = 0; n < 2; ++n) dst##8[n] = *(const PG8_LAS i32x8a*)(lds + PG8_SB(b, h) + boff + n * 2048); } \
        else { _Pragma("unroll") for (int n = 0; n < 2; ++n) _Pragma("unroll") for (int k = 0; k < 2; ++k) dst[n][k] = *(const PG8_LAS bf16x8*)(lds + PG8_SB(b, h) + boff + n * 2048 + k * 1024); } } while (0)
#define PG8_MMA(ai, bj, At, Bt) do { __builtin_amdgcn_s_setprio(1); \
        if constexpr (FP8) { _Pragma("unroll") for (int m = 0; m < 4; ++m) _Pragma("unroll") for (int n = 0; n < 2; ++n) \
            asm volatile("v_mfma_scale_f32_16x16x128_f8f6f4 %0, %1, %2, %0, %3, %3 op_sel_hi:[0,0,0]" : "+v"(acc[ai][bj][m][n]) : "v"(Bt##8[n]), "v"(At##8[m]), "v"(sc1)); } \
        else { _Pragma("unroll") for (int m = 0; m < 4; ++m) _Pragma("unroll") for (int n = 0; n < 2; ++n) _Pragma("unroll") for (int k = 0; k < 2; ++k) \
            acc[ai][bj][m][n] = __builtin_amdgcn_mfma_f32_16x16x32_bf16(Bt[n][k], At[m][k], acc[ai][bj][m][n], 0, 0, 0); } \
        __builtin_amdgcn_s_setprio(0); } while (0)
#define PG8_WAIT_V(n) asm volatile("s_waitcnt vmcnt(" #n ")" ::: "memory")
#define PG8_WAIT_L(n) asm volatile("s_waitcnt lgkmcnt(" #n ")" ::: "memory")
#define PG8_BAR __builtin_amdgcn_s_barrier()
#define PG8_SCHED __builtin_amdgcn_sched_barrier(0)
    Unit cur, nxt; int ui = 0;
    if (!S.next(0, cur)) return;
    f32x4 acc[2][2][4][2];
#pragma unroll
    for (int a = 0; a < 2; ++a)
#pragma unroll
        for (int b = 0; b < 2; ++b)
#pragma unroll
            for (int m = 0; m < 4; ++m)
#pragma unroll
                for (int n = 0; n < 2; ++n) acc[a][b][m][n] = (f32x4){0.f, 0.f, 0.f, 0.f};
    bf16x8 At[4][2], B0[2][2], B1[2][2];
    i32x8a At8[4], B08[2], B18[2];
    int sc1 = 0x7F7F7F7F; asm volatile("" : "+v"(sc1));
    const char* cA = (const char*)g.A + (size_t)cur.pm * tstepA + (size_t)(cur.pn / g.agdiv) * (size_t)g.agoff * 2; const char* cB = (const char*)g.Bt + (size_t)cur.pn * tstepB;
    S.a_ready(cur);
    if constexpr (SP2) {
        PG8_STAGE(PG8_SB(0, 0), cB, voffB); PG8_STAGE(PG8_SB(0, 1), cB + hstepB, voffB); PG8_STAGE(PG8_SA(0, 0), cA, voffA); PG8_STAGE(PG8_SA(0, 1), cA + hstepA, voffA);
        if (wr == 1) PG8_BAR;
        PG8_WAIT_V(2); PG8_BAR;
        PG8_STAGE(PG8_SB(1, 0), cB + kstep, voffB); PG8_STAGE(PG8_SA(1, 0), cA + kstep, voffA); PG8_STAGE(PG8_SB(1, 1), cB + hstepB + kstep, voffB);
        PG8_WAIT_V(6); PG8_BAR;
    } else {
        PG8_STAGE(PG8_SB(0, 0), cB, voffB); PG8_STAGE(PG8_SA(0, 0), cA, voffA); PG8_STAGE(PG8_SB(0, 1), cB + hstepB, voffB); PG8_STAGE(PG8_SA(0, 1), cA + hstepA, voffA);
        if (wr == 1) PG8_BAR;
        PG8_WAIT_V(4); PG8_BAR;
        PG8_STAGE(PG8_SB(1, 0), cB + kstep, voffB); PG8_STAGE(PG8_SA(1, 0), cA + kstep, voffA); PG8_STAGE(PG8_SB(1, 1), cB + hstepB + kstep, voffB);
        PG8_WAIT_V(6); PG8_BAR;
    }
    for (;;) {
        const bool has_next = S.next(ui + 1, nxt);
        const char* nA = has_next ? (const char*)g.A + (size_t)nxt.pm * tstepA + (size_t)(nxt.pn / g.agdiv) * (size_t)g.agoff * 2 : cA; const char* nB = has_next ? (const char*)g.Bt + (size_t)nxt.pn * tstepB : cB;
        for (int t = 0; t < nt; t += 2) {
            const bool last = (t == nt - 2);
            const char* a1 = cA + (size_t)(t + 1) * kstep;
            const char* a2 = last ? nA : cA + (size_t)(t + 2) * kstep; const char* b2 = last ? nB : cB + (size_t)(t + 2) * kstep;
            const char* a3 = a2 + kstep; const char* b3 = b2 + kstep;
            if (last && has_next) S.a_ready(nxt);
            if constexpr (SP2) {
            PG8_LDB(B0, 0, 0); PG8_LDB(B1, 0, 1); PG8_SCHED; PG8_LDA(At, 0, 0); PG8_STAGE(PG8_SA(1, 1), a1 + hstepA, voffA);
            PG8_WAIT_V(8); PG8_WAIT_L(0); PG8_BAR; PG8_MMA(0, 0, At, B0); PG8_MMA(0, 1, At, B1); PG8_BAR; PG8_SCHED;
            PG8_LDA(At, 0, 1); PG8_STAGE(PG8_SB(0, 0), b2, voffB); PG8_STAGE(PG8_SB(0, 1), b2 + hstepB, voffB); PG8_STAGE(PG8_SA(0, 0), a2, voffA);
            PG8_WAIT_V(8); PG8_WAIT_L(0); PG8_BAR; PG8_MMA(1, 0, At, B0); PG8_MMA(1, 1, At, B1); PG8_BAR; PG8_SCHED;
            PG8_LDB(B0, 1, 0); PG8_LDB(B1, 1, 1); PG8_SCHED; PG8_LDA(At, 1, 0); PG8_STAGE(PG8_SA(0, 1), a2 + hstepA, voffA);
            PG8_WAIT_V(8); PG8_WAIT_L(0); PG8_BAR; PG8_MMA(0, 0, At, B0); PG8_MMA(0, 1, At, B1); PG8_BAR; PG8_SCHED;
            PG8_LDA(At, 1, 1); PG8_STAGE(PG8_SB(1, 0), b3, voffB); PG8_STAGE(PG8_SB(1, 1), b3 + hstepB, voffB); PG8_STAGE(PG8_SA(1, 0), a3, voffA);
            PG8_WAIT_V(8); PG8_WAIT_L(0); PG8_BAR; PG8_MMA(1, 0, At, B0); PG8_MMA(1, 1, At, B1); PG8_BAR; PG8_SCHED;
            } else {
            PG8_LDB(B0, 0, 0); PG8_SCHED; PG8_LDA(At, 0, 0); PG8_STAGE(PG8_SA(1, 1), a1 + hstepA, voffA);
            PG8_WAIT_L(8); PG8_BAR; PG8_WAIT_L(0); PG8_MMA(0, 0, At, B0); PG8_BAR; PG8_SCHED;
            PG8_LDB(B1, 0, 1); PG8_STAGE(PG8_SB(0, 0), b2, voffB);
            PG8_BAR; PG8_WAIT_L(0); PG8_MMA(0, 1, At, B1); PG8_BAR;
            PG8_LDA(At, 0, 1); PG8_STAGE(PG8_SA(0, 0), a2, voffA);
            PG8_BAR; PG8_WAIT_L(0); PG8_MMA(1, 0, At, B0); PG8_BAR; PG8_SCHED;
            PG8_STAGE(PG8_SB(0, 1), b2 + hstepB, voffB);
            PG8_WAIT_V(6); PG8_BAR; PG8_MMA(1, 1, At, B1); PG8_BAR;
            PG8_LDB(B0, 1, 0); PG8_SCHED; PG8_LDA(At, 1, 0); PG8_STAGE(PG8_SA(0, 1), a2 + hstepA, voffA);
            PG8_WAIT_L(8); PG8_BAR; PG8_WAIT_L(0); PG8_MMA(0, 0, At, B0); PG8_BAR; PG8_SCHED;
            PG8_LDB(B1, 1, 1); PG8_STAGE(PG8_SB(1, 0), b3, voffB);
            PG8_BAR; PG8_WAIT_L(0); PG8_MMA(0, 1, At, B1); PG8_BAR;
            PG8_LDA(At, 1, 1); PG8_STAGE(PG8_SA(1, 0), a3, voffA);
            PG8_BAR; PG8_WAIT_L(0); PG8_MMA(1, 0, At, B0); PG8_BAR; PG8_SCHED;
            PG8_STAGE(PG8_SB(1, 1), b3 + hstepB, voffB);
            PG8_WAIT_V(6); PG8_BAR; PG8_MMA(1, 1, At, B1); PG8_BAR;
            }
        }
        if constexpr (ALIGN_EPI) { if (wr == 0) PG8_BAR; }
        if constexpr (FP8) asm volatile("s_nop 15\n\ts_nop 7" ::: "memory");
        if constexpr (!Epi::AFTER_DRAIN) { E(acc, cur, wr, wc, fr, fq); S.done(cur); }
        if (!has_next) break;
#pragma unroll
        for (int a = 0; a < 2; ++a)
#pragma unroll
            for (int b = 0; b < 2; ++b)
#pragma unroll
                for (int m = 0; m < 4; ++m)
#pragma unroll
                    for (int n = 0; n < 2; ++n) acc[a][b][m][n] = (f32x4){0.f, 0.f, 0.f, 0.f};
        cur = nxt; cA = nA; cB = nB; ++ui;
        if constexpr (ALIGN_EPI) { if (wr == 1) PG8_BAR; }
    }
    PG8_WAIT_V(0);
    if constexpr (!ALIGN_EPI) { if (wr == 0) PG8_BAR; }
    PG8_BAR;
    if constexpr (Epi::AFTER_DRAIN) { E.fused(acc, cur, wr, wc, fr, fq, lds, wid, lane); S.done(cur); }
#undef PG8_SA
#undef PG8_SB
#undef PG8_STAGE
#undef PG8_LDA
#undef PG8_LDB
#undef PG8_MMA
#undef PG8_WAIT_V
#undef PG8_WAIT_L
#undef PG8_BAR
#undef PG8_SCHED
}
}

constexpr int NB = 8, SEQ = 2048, DM = 2048, M_TOK = NB * SEQ, DFF = 8192, NLAYER = 2;
constexpr int LDQ = 6656;
constexpr int C_QB = 0, C_KB = 512, C_VB = 1024, C_VD = 1536, C_BG = 2048, C_CG = 2560, C_XIN = 3072, C_IQ = 3584, C_IK = 3840, C_IW = 3904, C_FD = 3908,
              C_QA = 4096, C_KA = 4608, C_VA = 5120, C_QD = 5632, C_KD = 6144;
constexpr int N_IN16 = 4096, N_IN8 = LDQ - N_IN16;
constexpr float LOG2E = 1.4426950408889634f;
constexpr float IDX_SCALE = 0.0625f;
constexpr float RMS_EPS = 1e-6f;

typedef unsigned short bf16_t;
typedef short bf16x8 __attribute__((ext_vector_type(8)));
typedef short s16x4 __attribute__((ext_vector_type(4)));
typedef float f32x16 __attribute__((ext_vector_type(16)));
typedef float f32x8 __attribute__((ext_vector_type(8)));
typedef float f32x4 __attribute__((ext_vector_type(4)));
typedef float f32x2 __attribute__((ext_vector_type(2)));
typedef unsigned u32x4 __attribute__((ext_vector_type(4)));
typedef unsigned u32x2 __attribute__((ext_vector_type(2)));

DI float bf2f(bf16_t v) { return __uint_as_float((unsigned)v << 16); }
DI unsigned cvtpk(float lo, float hi) { unsigned r; asm volatile("v_cvt_pk_bf16_f32 %0, %1, %2" : "=v"(r) : "v"(lo), "v"(hi)); return r; }
DI float wave_sum(float v) {
#pragma unroll
    for (int o = 1; o < 64; o <<= 1) v += __shfl_xor(v, o);
    return v;
}

namespace att {
constexpr int SHM_V = 16384, SHM_K = 16384;
constexpr int OFF_V = 0, OFF_K = 2 * SHM_V, OFF_WS = OFF_K + 2 * SHM_K, OFF_TAB = OFF_WS + 8 * 64 * 4, OFF_FK = OFF_TAB + 512, OFF_KN = OFF_FK + 8192, LDS_END = OFF_KN + 128;
#define KSWZ(row, colB) ((row) * 256 + ((colB) ^ (((row) & 7) << 4)))
#define SBAR() __builtin_amdgcn_sched_barrier(0)
DI int v_st(int k, int c) { const int kk = (k & ~0xC) | ((k & 4) << 1) | ((k & 8) >> 1); return ((kk >> 3) * 4 + (c >> 5)) * 512 + ((kk & 7) * 32 + (c & 31)) * 2; }
DI int v_rd_base(int lane) { return ((lane & 3) << 3) | (((lane >> 2) & 3) << 6) | (((lane >> 4) & 1) << 5) | (((lane >> 5) & 1) << 8); }
constexpr int v_rd_off(int d0, int ks, int half) { return d0 * 512 + ks * 4096 + half * 2048; }
DI int crow(int r, int hi) { return (r & 3) + 8 * (r >> 2) + 4 * hi; }

template <int KB, int D0LO, int D0HI>
DI void qkt(f32x16& p0, f32x16& p1, LAS const char* K_lds, int r32, int hi, const bf16x8* qr) {
#pragma unroll
    for (int r = 0; r < 16; ++r) { p0[r] = 0.f; p1[r] = 0.f; }
    LAS const char* kb[4];
#pragma unroll
    for (int dd = 0; dd < 4; ++dd) kb[dd] = K_lds + KB * SHM_K + KSWZ(r32, (dd * 16 + hi * 8) * 2);
#pragma unroll
    for (int d0 = D0LO; d0 < D0HI; ++d0) { LAS const char* a = kb[d0 & 3] + (d0 >> 2) * 128;
        const bf16x8 b0 = *(LAS const bf16x8*)a;
        const bf16x8 b1 = *(LAS const bf16x8*)(a + 32 * 256);
        p0 = __builtin_amdgcn_mfma_f32_32x32x16_bf16(b0, qr[d0 - D0LO], p0, 0, 0, 0);
        p1 = __builtin_amdgcn_mfma_f32_32x32x16_bf16(b1, qr[d0 - D0LO], p1, 0, 0, 0); }
}
template <int VB>
DI void pv_tile(f32x16* o, int vb0, bf16x8 pa0, bf16x8 pa1, bf16x8 pa2, bf16x8 pa3) {
#define TRRD(dst, off) asm volatile("ds_read_b64_tr_b16 %0, %1 offset:%2" : "=&v"(dst) : "v"(vb0), "i"(off) : "memory")
#define PV_D0(d0) do { s16x4 l0, l1, l2, l3, h0, h1, h2, h3; constexpr int b_ = VB * SHM_V + v_rd_off(d0, 0, 0);     \
        TRRD(l0, b_); TRRD(h0, b_ + 2048); TRRD(l1, b_ + 4096); TRRD(h1, b_ + 6144); TRRD(l2, b_ + 8192); TRRD(h2, b_ + 10240); TRRD(l3, b_ + 12288); TRRD(h3, b_ + 14336); \
        asm volatile("s_waitcnt lgkmcnt(0)" ::: "memory"); SBAR();   \
        o[d0] = __builtin_amdgcn_mfma_f32_32x32x16_bf16(pa0, (bf16x8){l0[0], l0[1], l0[2], l0[3], h0[0], h0[1], h0[2], h0[3]}, o[d0], 0, 0, 0);   \
        o[d0] = __builtin_amdgcn_mfma_f32_32x32x16_bf16(pa1, (bf16x8){l1[0], l1[1], l1[2], l1[3], h1[0], h1[1], h1[2], h1[3]}, o[d0], 0, 0, 0);   \
        o[d0] = __builtin_amdgcn_mfma_f32_32x32x16_bf16(pa2, (bf16x8){l2[0], l2[1], l2[2], l2[3], h2[0], h2[1], h2[2], h2[3]}, o[d0], 0, 0, 0);   \
        o[d0] = __builtin_amdgcn_mfma_f32_32x32x16_bf16(pa3, (bf16x8){l3[0], l3[1], l3[2], l3[3], h3[0], h3[1], h3[2], h3[3]}, o[d0], 0, 0, 0); } while (0)
    PV_D0(0); PV_D0(1); PV_D0(2); PV_D0(3);
#undef PV_D0
#undef TRRD
}
DI int t5_bucket(int n) {
    if (n < 16) return n;
    int b = 16;
    b += (n >= 19); b += (n >= 21); b += (n >= 24); b += (n >= 27); b += (n >= 31); b += (n >= 35); b += (n >= 40); b += (n >= 46);
    b += (n >= 52); b += (n >= 59); b += (n >= 67); b += (n >= 77); b += (n >= 87); b += (n >= 99); b += (n >= 113);
    return b;
}

DI float row16_sum(float x) {
    x += __int_as_float(__builtin_amdgcn_update_dpp(0, __float_as_int(x), 0xB1, 0xF, 0xF, true));
    x += __int_as_float(__builtin_amdgcn_update_dpp(0, __float_as_int(x), 0x4E, 0xF, 0xF, true));
    x += __int_as_float(__builtin_amdgcn_update_dpp(0, __float_as_int(x), 0x141, 0xF, 0xF, true));
    x += __int_as_float(__builtin_amdgcn_update_dpp(0, __float_as_int(x), 0x140, 0xF, 0xF, true));
    return x;
}
struct UnitArgs {
    const bf16_t* Qp; const bf16_t* Kp; const bf16_t* Vp; bf16_t* Op; int q0;
    const unsigned long long* maskp;
    const float* fcum;
    const float* relb; int relcol;
    float lam, post;
    const float* gsub;
    float* stash;
    int variant;
};

template <int MODE>
DI void attn_unit(LAS char* lds, const UnitArgs& A) {
    int tid_l = threadIdx.x; asm volatile("" : "+v"(tid_l));
    const int tid = tid_l, wid = __builtin_amdgcn_readfirstlane(tid >> 6), lane = tid & 63, r32 = lane & 31, hi = lane >> 5;
    const int q0 = A.q0, NT = (q0 + 256) / 64;
    LAS char* V_lds = lds + OFF_V; LAS char* K_lds = lds + OFF_K;
    LAS float* wsf = (LAS float*)(lds + OFF_WS) + wid * 64; LAS float* li_l = wsf; LAS float* al_l = wsf + 32;
    LAS float* tab = (LAS float*)(lds + OFF_TAB); LAS float* fk = (LAS float*)(lds + OFF_FK);
    const int qlo = q0 + wid * 32, qpos = qlo + r32;
    const int sr = tid >> 4, sc = (tid & 15) * 8;
    const int vst0 = v_st(sr, sc), vst1 = v_st(32 + sr, sc), kws = KSWZ(sr, sc * 2);
    const int vb0 = (int)(unsigned)(uintptr_t)V_lds + v_rd_base(lane);
    if (MODE == 0 || MODE == 1) { if (tid < 128) { const int bk = t5_bucket(tid); tab[tid] = (A.relb[bk * 8 + A.relcol] - A.relb[31 * 8 + A.relcol]) * LOG2E; } }
    float fqv = 0.f;
    if (MODE == 2) { for (int i = tid; i < q0 + 256; i += 512) fk[i] = A.fcum[i]; fqv = A.fcum[qpos]; }
    LAS unsigned* kn2 = (LAS unsigned*)(lds + OFF_KN);
    float qn = 0.f, sqq = 0.f;
    if (MODE == 2) { if (tid < 32) kn2[tid] = 0u; __syncthreads(); }
    constexpr int NPASS = (MODE == 1) ? 2 : 1, NQ = (MODE == 1) ? 4 : 8;
#pragma unroll 1
    for (int pass = 0; pass < NPASS; ++pass) {
        bf16x8 qr[NQ];
#pragma unroll
        for (int d = 0; d < NQ; ++d) qr[d] = *(const bf16x8*)(A.Qp + (size_t)(qpos) * LDQ + (MODE == 1 ? pass * 64 : 0) + d * 16 + hi * 8);
        if (MODE == 2) { float s2 = 0.f, sd = 0.f;
#pragma unroll
            for (int d = 0; d < NQ; ++d) { const bf16x8 kk = *(const bf16x8*)(A.Kp + (size_t)(qpos) * LDQ + d * 16 + hi * 8);
#pragma unroll
                for (int j = 0; j < 8; ++j) { const float qf = bf2f((bf16_t)qr[d][j]), kf = bf2f((bf16_t)kk[j]); s2 += qf * qf; sd += qf * kf; } }
            s2 += __shfl_xor(s2, 32); sd += __shfl_xor(sd, 32);
            qn = sqrtf(s2) * 1.001f; sqq = sd - 0.05f; }
        bf16x8 st_k0, st_k1, st_v0, st_v1;
#define KNORM(tix) do { if (MODE == 2) { float n0_ = 0.f, n1_ = 0.f; \
            _Pragma("unroll") for (int j = 0; j < 8; ++j) { const float a_ = bf2f((bf16_t)st_k0[j]), b_ = bf2f((bf16_t)st_k1[j]); n0_ += a_ * a_; n1_ += b_ * b_; } \
            n0_ = row16_sum(n0_); n1_ = row16_sum(n1_); \
            if ((tid & 15) == 0) (void)__hip_atomic_fetch_max(kn2 + (tix), __float_as_uint(fmaxf(n0_, n1_)), __ATOMIC_RELAXED, __HIP_MEMORY_SCOPE_WORKGROUP); } } while (0)
#define SLOAD(k0_) do { const int k0 = (A.variant == 1) ? 0 : (k0_); st_v0 = *(const bf16x8*)(A.Vp + (size_t)((k0) + sr) * LDQ + sc); st_v1 = *(const bf16x8*)(A.Vp + (size_t)((k0) + 32 + sr) * LDQ + sc); \
                       st_k0 = *(const bf16x8*)(A.Kp + (size_t)((k0) + sr) * LDQ + sc); st_k1 = *(const bf16x8*)(A.Kp + (size_t)((k0) + 32 + sr) * LDQ + sc); } while (0)
#define SWRITE(bf) do { *(LAS bf16x8*)(V_lds + (bf) * SHM_V + vst0) = st_v0; *(LAS bf16x8*)(V_lds + (bf) * SHM_V + vst1) = st_v1; \
                        *(LAS bf16x8*)(K_lds + (bf) * SHM_K + kws) = st_k0; *(LAS bf16x8*)(K_lds + (bf) * SHM_K + kws + 32 * 256) = st_k1; } while (0)
        SLOAD(0); SWRITE(0); KNORM(0);
        __syncthreads();
        float m_reg = -1e30f, l_reg = 0.f; f32x16 o[4];
#pragma unroll
        for (int d = 0; d < 4; ++d)
#pragma unroll
            for (int r = 0; r < 16; ++r) o[d][r] = 0.f;
        f32x16 p0, p1; bf16x8 pa0, pa1, pa2, pa3;
        unsigned long long mw_next = 0ull; if (MODE == 0) mw_next = A.maskp[(size_t)qpos * 32];
#define STEP(t, KB) do { const int t_ = (t); const bool more_ = (t_ + 1 < NT); const int kbase = t_ * 64; \
        const unsigned long long mw_ = mw_next; if (MODE == 0) { if (more_) mw_next = A.maskp[(size_t)qpos * 32 + t_ + 1]; } \
        if (more_) SLOAD(kbase + 64); \
        bool far_ = false; if (MODE == 2) { const float kn_ = sqrtf(__uint_as_float(kn2[t_])) * 1.001f; far_ = __all(qn * kn_ + (fqv - fk[kbase + 63]) - sqq < -100.f); } \
        if (kbase <= qlo + 31 && !far_) {        \
        if (A.variant == 4) { _Pragma("unroll") for (int r = 0; r < 16; ++r) { p0[r] = 0.f; p1[r] = 0.f; } } else { \
        if (MODE == 1) { if (pass == 0) qkt<KB, 0, 4>(p0, p1, K_lds, r32, hi, qr); else qkt<KB, 4, 8>(p0, p1, K_lds, r32, hi, qr); } \
        else qkt<KB, 0, 8>(p0, p1, K_lds, r32, hi, qr); } \
        if (A.variant != 2) { \
        if (MODE == 0 || MODE == 1) { if (kbase + 63 + 113 > qlo) { const int dq_ = qpos - kbase - 4 * hi; \
            _Pragma("unroll") for (int r = 0; r < 16; ++r) { const int c_ = (r & 3) + 8 * (r >> 2); int i0 = dq_ - c_, i1 = dq_ - c_ - 32; \
                i0 = i0 < 0 ? 0 : (i0 > 127 ? 127 : i0); i1 = i1 < 0 ? 0 : (i1 > 127 ? 127 : i1); p0[r] += tab[i0]; p1[r] += tab[i1]; } } } \
        if (MODE == 2) { _Pragma("unroll") for (int g = 0; g < 4; ++g) { const f32x4 f0 = *(LAS const f32x4*)(fk + kbase + 8 * g + 4 * hi), f1 = *(LAS const f32x4*)(fk + kbase + 32 + 8 * g + 4 * hi); \
                _Pragma("unroll") for (int j = 0; j < 4; ++j) { p0[4 * g + j] += fqv - f0[j]; p1[4 * g + j] += fqv - f1[j]; } } } \
        if (kbase + 63 > qlo) { const int dq_ = qpos - kbase - 4 * hi; const float NEG_ = -__builtin_inff(); \
            _Pragma("unroll") for (int r = 0; r < 16; ++r) { const int c_ = (r & 3) + 8 * (r >> 2); if (dq_ - c_ < 0) p0[r] = NEG_; if (dq_ - c_ - 32 < 0) p1[r] = NEG_; } } \
        if (MODE == 0) { const int wl_ = (int)((unsigned)mw_ >> (4 * hi)), wh_ = (int)((unsigned)(mw_ >> 32) >> (4 * hi)); \
            _Pragma("unroll") for (int r = 0; r < 16; ++r) { const int c_ = (r & 3) + 8 * (r >> 2); \
                const unsigned m0_ = (unsigned)__builtin_amdgcn_sbfe(wl_, c_, 1), m1_ = (unsigned)__builtin_amdgcn_sbfe(wh_, c_, 1);     \
                p0[r] = __uint_as_float((__float_as_uint(p0[r]) & m0_) | (0xff800000u & ~m0_)); p1[r] = __uint_as_float((__float_as_uint(p1[r]) & m1_) | (0xff800000u & ~m1_)); } } \
        } \
        float pmax_ = p0[0]; _Pragma("unroll") for (int r = 1; r < 16; ++r) pmax_ = fmaxf(pmax_, p0[r]); _Pragma("unroll") for (int r = 0; r < 16; ++r) pmax_ = fmaxf(pmax_, p1[r]); \
        { auto rr = __builtin_amdgcn_permlane32_swap(__float_as_uint(pmax_), __float_as_uint(pmax_), false, false); pmax_ = fmaxf(__uint_as_float(rr[0]), __uint_as_float(rr[1])); } \
        float mn_ = m_reg, alpha_ = 1.f; \
        if (!__all(pmax_ - m_reg <= 8.f)) { mn_ = fmaxf(m_reg, pmax_); alpha_ = __builtin_amdgcn_exp2f(m_reg - mn_); m_reg = mn_; } \
        p0 = p0 - mn_; p1 = p1 - mn_;                        \
        _Pragma("unroll") for (int r = 0; r < 16; ++r) p0[r] = __builtin_amdgcn_exp2f(p0[r]); \
        _Pragma("unroll") for (int r = 0; r < 16; ++r) p1[r] = __builtin_amdgcn_exp2f(p1[r]); \
        float ps_; { const f32x16 s16_ = p0 + p1; const f32x8 s8_ = s16_.lo + s16_.hi; const f32x4 s4_ = s8_.lo + s8_.hi; ps_ = (s4_[0] + s4_[1]) + (s4_[2] + s4_[3]); } \
        { auto rr = __builtin_amdgcn_permlane32_swap(__float_as_uint(ps_), __float_as_uint(ps_), false, false); ps_ = __uint_as_float(rr[0]) + __uint_as_float(rr[1]); } \
        l_reg = l_reg * alpha_ + ps_; \
        PK4(p0, 0, pa0); PK4(p0, 8, pa1); PK4(p1, 0, pa2); PK4(p1, 8, pa3); \
        if (__any(alpha_ < 1.f)) { if (hi == 0) al_l[r32] = alpha_; asm volatile("s_waitcnt lgkmcnt(0)" ::: "memory"); \
            _Pragma("unroll") for (int d_ = 0; d_ < 4; ++d_) _Pragma("unroll") for (int r = 0; r < 16; ++r) o[d_][r] *= al_l[crow(r, hi)]; } \
        SBAR(); if (A.variant != 3) pv_tile<KB>(o, vb0, pa0, pa1, pa2, pa3); } \
        if (A.variant != 5) { if (more_) { asm volatile("s_waitcnt vmcnt(0)" ::: "memory"); SWRITE((KB) ^ 1); KNORM(t_ + 1); } \
        __syncthreads(); } } while (0)
#define PK4(P, B_, OUT) do { unsigned a0 = cvtpk(P[B_+0], P[B_+1]), a1 = cvtpk(P[B_+2], P[B_+3]);                          \
        unsigned b0 = cvtpk(P[B_+4], P[B_+5]), b1 = cvtpk(P[B_+6], P[B_+7]);                                             \
        auto r0 = __builtin_amdgcn_permlane32_swap(a0, b0, false, false); auto r1 = __builtin_amdgcn_permlane32_swap(a1, b1, false, false); \
        u32x4 w = {r0[0], r1[0], r0[1], r1[1]}; OUT = __builtin_bit_cast(bf16x8, w); } while (0)
#pragma unroll 1
        for (int t = 0; t < NT; t += 2) { STEP(t, 0); STEP(t + 1, 1); }
#undef STEP
#undef PK4
#undef SLOAD
#undef SWRITE
#undef KNORM
        if (hi == 0) li_l[r32] = l_reg; asm volatile("s_waitcnt lgkmcnt(0)" ::: "memory");
        float rli[16];
#pragma unroll
        for (int r = 0; r < 16; ++r) rli[r] = __builtin_amdgcn_rcpf(li_l[crow(r, hi)]);
        bf16_t* Ow = A.Op + (size_t)(qlo) * 2048; asm volatile("" : "+v"(Ow));
        if (MODE != 1) {
#pragma unroll
            for (int r = 0; r < 16; ++r) { const int orow = crow(r, hi);
#pragma unroll
                for (int d0 = 0; d0 < 4; ++d0) { const float v = o[d0][r] * rli[r]; const float vn = __shfl_xor(v, 1);
                    if ((r32 & 1) == 0) *(unsigned*)(Ow + (size_t)orow * 2048 + d0 * 32 + r32) = cvtpk(v, vn); } }
        } else if (pass == 0) {
#pragma unroll
            for (int d0 = 0; d0 < 4; ++d0)
#pragma unroll
                for (int r = 0; r < 16; r += 4) *(f32x4*)(A.stash + tid * 64 + d0 * 16 + r) = (f32x4){o[d0][r] * rli[r], o[d0][r + 1] * rli[r + 1], o[d0][r + 2] * rli[r + 2], o[d0][r + 3] * rli[r + 3]};
        } else {
            float ss[16];
#pragma unroll
            for (int d0 = 0; d0 < 4; ++d0)
#pragma unroll
                for (int r = 0; r < 16; r += 4) { const f32x4 sv = *(const f32x4*)(A.stash + tid * 64 + d0 * 16 + r);
#pragma unroll
                    for (int j = 0; j < 4; ++j) o[d0][r + j] = sv[j] - A.lam * (o[d0][r + j] * rli[r + j]); }
#pragma unroll
            for (int r = 0; r < 16; ++r) { float s = 0.f;
#pragma unroll
                for (int d0 = 0; d0 < 4; ++d0) { const float v = o[d0][r]; s += v * v; }
                s += __shfl_xor(s, 1); s += __shfl_xor(s, 2); s += __shfl_xor(s, 4); s += __shfl_xor(s, 8); s += __shfl_xor(s, 16);
                ss[r] = __builtin_amdgcn_rsqf(s * (1.f / 128.f) + RMS_EPS) * A.post;
                if ((r & 3) == 3) asm volatile("" ::: "memory"); }
#pragma unroll
            for (int d0 = 0; d0 < 4; ++d0) { const float gs = A.gsub[d0 * 32 + r32];
#pragma unroll
                for (int r = 0; r < 16; ++r) { const int orow = crow(r, hi); const float v = o[d0][r] * ss[r] * gs; const float vn = __shfl_xor(v, 1);
                    if ((r32 & 1) == 0) *(unsigned*)(Ow + (size_t)orow * 2048 + d0 * 32 + r32) = cvtpk(v, vn); } }
        }
        __syncthreads();
    }
}

template <int MODE>
DI void tile_hooks(f32x16& p0, f32x16& p1, int kbase, int qlo, int qpos, int hi, LAS const float* tab, LAS const float* fk, float fqv, unsigned long long mw) {
    if (MODE == 0 || MODE == 1) { if (kbase + 63 + 113 > qlo) { const int dq_ = qpos - kbase - 4 * hi;
#pragma unroll
        for (int r = 0; r < 16; ++r) { const int c_ = (r & 3) + 8 * (r >> 2); int i0 = dq_ - c_, i1 = dq_ - c_ - 32;
            i0 = i0 < 0 ? 0 : (i0 > 127 ? 127 : i0); i1 = i1 < 0 ? 0 : (i1 > 127 ? 127 : i1); p0[r] += tab[i0]; p1[r] += tab[i1]; } } }
    if (MODE == 2) {
#pragma unroll
        for (int g = 0; g < 4; ++g) { const f32x4 f0 = *(LAS const f32x4*)(fk + kbase + 8 * g + 4 * hi), f1 = *(LAS const f32x4*)(fk + kbase + 32 + 8 * g + 4 * hi);
#pragma unroll
            for (int j = 0; j < 4; ++j) { p0[4 * g + j] += fqv - f0[j]; p1[4 * g + j] += fqv - f1[j]; } } }
    if (kbase + 63 > qlo) { const int dq_ = qpos - kbase - 4 * hi; const float NEG_ = -__builtin_inff();
#pragma unroll
        for (int r = 0; r < 16; ++r) { const int c_ = (r & 3) + 8 * (r >> 2); if (dq_ - c_ < 0) p0[r] = NEG_; if (dq_ - c_ - 32 < 0) p1[r] = NEG_; } }
    if (MODE == 0) { const unsigned wl_ = (unsigned)mw >> (4 * hi), wh_ = (unsigned)(mw >> 32) >> (4 * hi); const float NEG_ = -__builtin_inff();
#pragma unroll
        for (int r = 0; r < 16; ++r) { const int c_ = (r & 3) + 8 * (r >> 2); if (!((wl_ >> c_) & 1u)) p0[r] = NEG_; if (!((wh_ >> c_) & 1u)) p1[r] = NEG_; } }
}
DI void partialSM(f32x16& p0, f32x16& p1, float& m_reg, float& mn, float& alpha) {
    float pmax = p0[0];
#pragma unroll
    for (int r = 1; r < 16; ++r) pmax = fmaxf(pmax, p0[r]);
#pragma unroll
    for (int r = 0; r < 16; ++r) pmax = fmaxf(pmax, p1[r]);
    { auto rr = __builtin_amdgcn_permlane32_swap(__float_as_uint(pmax), __float_as_uint(pmax), false, false); pmax = fmaxf(__uint_as_float(rr[0]), __uint_as_float(rr[1])); }
    if (__builtin_expect(__all(pmax - m_reg <= 8.f), 1)) { mn = m_reg; alpha = 1.f; }
    else { mn = fmaxf(m_reg, pmax); alpha = __builtin_amdgcn_exp2f(m_reg - mn); m_reg = mn; }
#pragma unroll
    for (int r = 0; r < 16; ++r) { p0[r] -= mn; p1[r] -= mn; }
#pragma unroll
    for (int r = 0; r < 16; ++r) p0[r] = __builtin_amdgcn_exp2f(p0[r]);
}
DI void finishSM(f32x16& p0, f32x16& p1, float alpha, float& l_reg, bf16x8& pa0, bf16x8& pa1, bf16x8& pa2, bf16x8& pa3) {
#pragma unroll
    for (int r = 0; r < 16; ++r) p1[r] = __builtin_amdgcn_exp2f(p1[r]);
    float ps = 0.f;
#pragma unroll
    for (int r = 0; r < 16; ++r) ps += p0[r];
#pragma unroll
    for (int r = 0; r < 16; ++r) ps += p1[r];
    { auto rr = __builtin_amdgcn_permlane32_swap(__float_as_uint(ps), __float_as_uint(ps), false, false); ps = __uint_as_float(rr[0]) + __uint_as_float(rr[1]); }
    l_reg = l_reg * alpha + ps;
#define PK4(P, B_, OUT) do { unsigned a0 = cvtpk(P[B_+0], P[B_+1]), a1 = cvtpk(P[B_+2], P[B_+3]);                          \
        unsigned b0 = cvtpk(P[B_+4], P[B_+5]), b1 = cvtpk(P[B_+6], P[B_+7]);                                             \
        auto r0 = __builtin_amdgcn_permlane32_swap(a0, b0, false, false); auto r1 = __builtin_amdgcn_permlane32_swap(a1, b1, false, false); \
        u32x4 w = {r0[0], r1[0], r0[1], r1[1]}; OUT = __builtin_bit_cast(bf16x8, w); } while (0)
    PK4(p0, 0, pa0); PK4(p0, 8, pa1); PK4(p1, 0, pa2); PK4(p1, 8, pa3);
#undef PK4
}

template <int MODE, int PASS>
DI void attn_pass_p(LAS char* lds, const UnitArgs& A) {
    int tid_l = threadIdx.x; asm volatile("" : "+v"(tid_l));
    const int tid = tid_l, wid = __builtin_amdgcn_readfirstlane(tid >> 6), lane = tid & 63, r32 = lane & 31, hi = lane >> 5;
    const int q0 = A.q0, NT = (q0 + 256) / 64;
    LAS char* V_lds = lds + OFF_V; LAS char* K_lds = lds + OFF_K;
    LAS float* wsf = (LAS float*)(lds + OFF_WS) + wid * 64; LAS float* li_l = wsf; LAS float* al_l = wsf + 32;
    LAS float* tab = (LAS float*)(lds + OFF_TAB); LAS float* fk = (LAS float*)(lds + OFF_FK);
    const int qlo = q0 + wid * 32, qpos = qlo + r32;
    const int sr = tid >> 4, sc = (tid & 15) * 8;
    const int vst0 = v_st(sr, sc), vst1 = v_st(32 + sr, sc), kws = KSWZ(sr, sc * 2);
    const int vb0 = (int)(unsigned)(uintptr_t)V_lds + v_rd_base(lane);
    const unsigned soff = (unsigned)(sr * LDQ + sc) * 2u;
    float fqv = 0.f;
    if (MODE == 2) fqv = A.fcum[qpos];
    constexpr int NQ = (MODE == 1) ? 4 : 8; constexpr int pass = PASS;
    {
        bf16x8 qr[NQ];
#pragma unroll
        for (int d = 0; d < NQ; ++d) qr[d] = *(const bf16x8*)(A.Qp + (size_t)(qpos) * LDQ + (MODE == 1 ? pass * 64 : 0) + d * 16 + hi * 8);
        bf16x8 st_k0, st_k1, st_v0, st_v1;
        unsigned long long mwC = 0ull;
#define VMW() asm volatile("s_waitcnt vmcnt(0)" ::: "memory")
#define SLOAD(k0) do { const char* vb_ = (const char*)A.Vp + (size_t)(k0) * (LDQ * 2); const char* kb_ = (const char*)A.Kp + (size_t)(k0) * (LDQ * 2);     \
                       st_v0 = *(const bf16x8*)(vb_ + soff); st_v1 = *(const bf16x8*)(vb_ + soff + 32 * LDQ * 2); st_k0 = *(const bf16x8*)(kb_ + soff); st_k1 = *(const bf16x8*)(kb_ + soff + 32 * LDQ * 2); } while (0)
#define SWRITE_K(bf) do { *(LAS bf16x8*)(K_lds + (bf) * SHM_K + kws) = st_k0; *(LAS bf16x8*)(K_lds + (bf) * SHM_K + kws + 32 * 256) = st_k1; } while (0)
#define SWRITE_V(bf) do { *(LAS bf16x8*)(V_lds + (bf) * SHM_V + vst0) = st_v0; *(LAS bf16x8*)(V_lds + (bf) * SHM_V + vst1) = st_v1; } while (0)
#define MLOAD(t) do { if (MODE == 0) mwC = A.maskp[(size_t)qpos * 32 + (t)]; } while (0)
#define QKT(KB, P0, P1) do { if (MODE == 1) { if (pass == 0) qkt<KB, 0, 4>(P0, P1, K_lds, r32, hi, qr); else qkt<KB, 4, 8>(P0, P1, K_lds, r32, hi, qr); } else qkt<KB, 0, 8>(P0, P1, K_lds, r32, hi, qr); } while (0)
#define RESC(a) do { if (__any((a) < 1.f)) { if (hi == 0) al_l[r32] = (a); asm volatile("s_waitcnt lgkmcnt(0)" ::: "memory"); \
            _Pragma("unroll") for (int d_ = 0; d_ < 4; ++d_) _Pragma("unroll") for (int r = 0; r < 16; ++r) o[d_][r] *= al_l[crow(r, hi)]; } } while (0)
        MLOAD(0); SLOAD(0); VMW(); SWRITE_K(0);
        __syncthreads();
        float m_reg = -1e30f, l_reg = 0.f; f32x16 o[4];
#pragma unroll
        for (int d = 0; d < 4; ++d)
#pragma unroll
            for (int r = 0; r < 16; ++r) o[d][r] = 0.f;
        f32x16 pA0, pA1, pB0, pB1; float mnA, mnB, alA, alB; bf16x8 pa0, pa1, pa2, pa3;
        SWRITE_V(0); SBAR();
        SLOAD(64);
        SBAR(); QKT(0, pA0, pA1);
        tile_hooks<MODE>(pA0, pA1, 0, qlo, qpos, hi, tab, fk, fqv, mwC); MLOAD(1); partialSM(pA0, pA1, m_reg, mnA, alA);
        VMW(); SWRITE_V(1); SWRITE_K(1);
        __syncthreads();
#define HALF_STEP(PX0, PX1, mnX, alX, PY0, PY1, alY, t, KB, VB, SB) do { \
        SBAR(); QKT(KB, PX0, PX1); \
        finishSM(PY0, PY1, alY, l_reg, pa0, pa1, pa2, pa3); SBAR(); \
        if ((t) + 1 < NT) { SLOAD(((t) + 1) * 64); SBAR(); } \
        pv_tile<VB>(o, vb0, pa0, pa1, pa2, pa3); \
        tile_hooks<MODE>(PX0, PX1, (t) * 64, qlo, qpos, hi, tab, fk, fqv, mwC); if ((t) + 1 < NT) MLOAD((t) + 1); partialSM(PX0, PX1, m_reg, mnX, alX); \
        __syncthreads(); \
        if ((t) + 1 < NT) { VMW(); SWRITE_V(SB); SWRITE_K(SB); } \
        RESC(alX); __syncthreads(); } while (0)
#pragma unroll 1
        for (int t = 1; t + 1 < NT; t += 2) {
            HALF_STEP(pB0, pB1, mnB, alB, pA0, pA1, alA, t, 1, 0, 0);
            HALF_STEP(pA0, pA1, mnA, alA, pB0, pB1, alB, t + 1, 0, 1, 1);
        }
        SBAR(); QKT(1, pB0, pB1); SBAR();
        finishSM(pA0, pA1, alA, l_reg, pa0, pa1, pa2, pa3); SBAR();
        pv_tile<0>(o, vb0, pa0, pa1, pa2, pa3);
        tile_hooks<MODE>(pB0, pB1, (NT - 1) * 64, qlo, qpos, hi, tab, fk, fqv, mwC); partialSM(pB0, pB1, m_reg, mnB, alB);
        RESC(alB);
        finishSM(pB0, pB1, alB, l_reg, pa0, pa1, pa2, pa3); SBAR();
        pv_tile<1>(o, vb0, pa0, pa1, pa2, pa3);
#undef HALF_STEP
#undef RESC
#undef QKT
#undef MLOAD
#undef SWRITE_K
#undef SWRITE_V
#undef SLOAD
#undef VMW
        if (hi == 0) li_l[r32] = l_reg; asm volatile("s_waitcnt lgkmcnt(0)" ::: "memory");
        float rli[16];
#pragma unroll
        for (int r = 0; r < 16; ++r) rli[r] = __builtin_amdgcn_rcpf(li_l[crow(r, hi)]);
        bf16_t* Ow = A.Op + (size_t)(qlo) * 2048; asm volatile("" : "+v"(Ow));
        if (MODE != 1) {
#pragma unroll
            for (int r = 0; r < 16; ++r) { const int orow = crow(r, hi);
#pragma unroll
                for (int d0 = 0; d0 < 4; ++d0) { const float v = o[d0][r] * rli[r]; const float vn = __shfl_xor(v, 1);
                    if ((r32 & 1) == 0) *(unsigned*)(Ow + (size_t)orow * 2048 + d0 * 32 + r32) = cvtpk(v, vn); } }
        } else if (pass == 0) {
#pragma unroll
            for (int d0 = 0; d0 < 4; ++d0)
#pragma unroll
                for (int r = 0; r < 16; r += 4) *(f32x4*)(A.stash + tid * 64 + d0 * 16 + r) = (f32x4){o[d0][r] * rli[r], o[d0][r + 1] * rli[r + 1], o[d0][r + 2] * rli[r + 2], o[d0][r + 3] * rli[r + 3]};
        } else {
            float ss[16];
#pragma unroll
            for (int d0 = 0; d0 < 4; ++d0)
#pragma unroll
                for (int r = 0; r < 16; r += 4) { const f32x4 sv = *(const f32x4*)(A.stash + tid * 64 + d0 * 16 + r);
#pragma unroll
                    for (int j = 0; j < 4; ++j) o[d0][r + j] = sv[j] - A.lam * (o[d0][r + j] * rli[r + j]); }
#pragma unroll
            for (int r = 0; r < 16; ++r) { float s = 0.f;
#pragma unroll
                for (int d0 = 0; d0 < 4; ++d0) { const float v = o[d0][r]; s += v * v; }
                s += __shfl_xor(s, 1); s += __shfl_xor(s, 2); s += __shfl_xor(s, 4); s += __shfl_xor(s, 8); s += __shfl_xor(s, 16);
                ss[r] = __builtin_amdgcn_rsqf(s * (1.f / 128.f) + RMS_EPS) * A.post;
                if ((r & 3) == 3) asm volatile("" ::: "memory"); }
#pragma unroll
            for (int d0 = 0; d0 < 4; ++d0) { const float gs = A.gsub[d0 * 32 + r32];
#pragma unroll
                for (int r = 0; r < 16; ++r) { const int orow = crow(r, hi); const float v = o[d0][r] * ss[r] * gs; const float vn = __shfl_xor(v, 1);
                    if ((r32 & 1) == 0) *(unsigned*)(Ow + (size_t)orow * 2048 + d0 * 32 + r32) = cvtpk(v, vn); } }
        }
        __syncthreads();
    }
}

template <int MODE>
DI void attn_unit_p(LAS char* lds, const UnitArgs& A) {
    int tid_l = threadIdx.x; asm volatile("" : "+v"(tid_l)); const int tid = tid_l;
    LAS float* tab = (LAS float*)(lds + OFF_TAB); LAS float* fk = (LAS float*)(lds + OFF_FK);
    if (MODE == 0 || MODE == 1) { if (tid < 128) { const int bk = t5_bucket(tid); tab[tid] = (A.relb[bk * 8 + A.relcol] - A.relb[31 * 8 + A.relcol]) * LOG2E; } }
    if (MODE == 2) { for (int i = tid; i < A.q0 + 256; i += 512) fk[i] = A.fcum[i]; }
    attn_pass_p<MODE, 0>(lds, A);
    if (MODE == 1) attn_pass_p<MODE, 1>(lds, A);
}
#undef SBAR
}

#define XB_TMO      128
#define XB_XCNT(j)  (256  + 64 * (j))
#define XB_XSUB(j)  (1280 + 64 * (j))
#define XB_XGEN(j)  (2304 + 64 * (j))
#define XB_TOP      3328
#define XB_TOPGEN   3392
#define XCD_BAR_WORDS 3456
#define XB_SPIN_CAP (1u << 20)

__device__ __forceinline__ unsigned xb_ld(unsigned* p)              { return __hip_atomic_load(p, __ATOMIC_RELAXED, __HIP_MEMORY_SCOPE_AGENT); }
__device__ __forceinline__ unsigned xb_add(unsigned* p, unsigned v) { return __hip_atomic_fetch_add(p, v, __ATOMIC_RELAXED, __HIP_MEMORY_SCOPE_AGENT); }
__device__ __forceinline__ unsigned xb_xcc_id() { return (unsigned)__builtin_amdgcn_s_getreg((3 << 11) | 20) & 0xFu; }
#define XB_SPIN(cond, bar) do { unsigned _sp = 0; while (cond) { __builtin_amdgcn_s_sleep(1); \
    if ((++_sp & 255u) == 0u) { if (xb_ld(&(bar)[XB_TMO])) break; if (_sp > XB_SPIN_CAP) { atomicAdd(&(bar)[XB_TMO], 1u); break; } } } } while (0)

struct XcdBarrier {
    unsigned* bar; unsigned x;
    volatile LAS unsigned* st;
};

__device__ __forceinline__ XcdBarrier xcd_barrier_post(unsigned* bar, volatile LAS unsigned* st) {
    XcdBarrier b; b.bar = bar; b.x = xb_xcc_id(); b.st = st;
    if (threadIdx.x == 0) (void)xb_add(&bar[XB_XCNT(b.x)], 1u);
    return b;
}
__device__ __forceinline__ void xcd_barrier_complete(unsigned* bar, unsigned x, unsigned& nloc, unsigned& nx) {
    const unsigned G = gridDim.x * gridDim.y * gridDim.z;
    unsigned sum, cnt, mine, sp = 0u;
    for (;;) {
        sum = 0u; cnt = 0u; mine = 0u;
#pragma unroll
        for (unsigned j = 0; j < 16; ++j) { const unsigned c = xb_ld(&bar[XB_XCNT(j)]); sum += c; cnt += (c > 0u) ? 1u : 0u; mine = (j == x) ? c : mine; }
        if (sum == G) break;
        __builtin_amdgcn_s_sleep(1);
        if ((++sp & 255u) == 0u) { if (xb_ld(&bar[XB_TMO])) break; if (sp > XB_SPIN_CAP) { atomicAdd(&bar[XB_TMO], 1u); break; } }
    }
    nloc = mine > 0u ? mine : 1u; nx = cnt > 0u ? cnt : 1u;
}

__device__ __forceinline__ void xcd_barrier(const XcdBarrier& b) {
    asm volatile("s_waitcnt vmcnt(0)" ::: "memory");
    __syncthreads();
    if (threadIdx.x == 0) {
        unsigned* bar = b.bar; asm volatile("" : "+s"(bar));
        __builtin_amdgcn_s_waitcnt(0);
        unsigned nloc = b.st[0], nx = b.st[1];
        if (nloc == 0u) { xcd_barrier_complete(bar, b.x, nloc, nx); b.st[0] = nloc; b.st[1] = nx; }
        const unsigned old = xb_add(&bar[XB_XSUB(b.x)], 1u);
        const unsigned gen = old / nloc;
        if (old + 1u == (gen + 1u) * nloc) {
            __builtin_amdgcn_fence(__ATOMIC_RELEASE, "agent");
            asm volatile("s_waitcnt vmcnt(0)" ::: "memory");
            const unsigned og = xb_add(&bar[XB_TOP], 1u);
            const unsigned tg = og / nx;
            if (og + 1u == (tg + 1u) * nx) xb_add(&bar[XB_TOPGEN], 1u);
            else XB_SPIN(xb_ld(&bar[XB_TOPGEN]) == tg, bar);
            __builtin_amdgcn_fence(__ATOMIC_ACQUIRE, "agent");
            xb_add(&bar[XB_XGEN(b.x)], 1u);
            asm volatile("s_waitcnt vmcnt(0)" ::: "memory");
        } else {
            XB_SPIN(xb_ld(&bar[XB_XGEN(b.x)]) == gen, bar);
            __builtin_amdgcn_fence(__ATOMIC_ACQUIRE, "agent");
            asm volatile("s_waitcnt vmcnt(0)" ::: "memory");
        }
    }
    __syncthreads();
}
#define RLX_AGENT __ATOMIC_RELAXED, __HIP_MEMORY_SCOPE_AGENT
#define LDS_WAIT() asm volatile("s_waitcnt lgkmcnt(0)" ::: "memory")
DI unsigned f2bf(float f) { unsigned u = __builtin_bit_cast(unsigned, f); return (u + 0x7fffu + ((u >> 16) & 1u)) >> 16; }
DI unsigned pk2(float lo, float hi) { return f2bf(lo) | (f2bf(hi) << 16); }

struct MapPlain { DI int src(int n) const { return n; } DI float scale(int) const { return 1.f; } };
struct MapWin {
    DI int src(int n) const {
        if (n < 1536) return 1860 + n;
        if (n < 2048) return 5956 + (n - 1536);
        if (n < 3584) return 3396 + (n - 2048);
        if (n < 3840) return 1536 + (n - 3584);
        if (n < 3904) return 1792 + (n - 3840);
        if (n < 3908) return 1856 + (n - 3904);
        if (n < 3912) return 6468 + (n - 3908);
        if (n < 4096) return -1;
        if (n < 5632) return n - 4096;
        if (n < 6144) return 4932 + (n - 5632);
        return 5444 + (n - 6144);
    }
    DI float scale(int n) const { return n < 512 ? 0.125f * LOG2E : 1.f; }
};
constexpr float QSCALE128 = 0.08838834764831845f * LOG2E;
struct MapGate {
    DI int src(int n) const { const int pn = n >> 8, c = n & 255; const int g = 2 * (c >> 7) + ((c >> 4) & 1), dl = 16 * ((c >> 5) & 3) + (c & 15); return g * 2048 + 64 * pn + dl; }
    DI float scale(int) const { return 1.f; }
};
template <class Map>
DI void transpose_item(const float* W, int K, int Nsrc, int nblk  , bf16_t* WT, const Map& map, LAS float* scr, int item, int lane) {
    const int kb = item / nblk, nb = item % nblk, k0 = 64 * kb, n0 = 32 * nb;
    const int nd = n0 + (lane & 31); const int s = map.src(nd); const float scl = map.scale(nd);
#pragma unroll 8
    for (int i = 0; i < 32; ++i) { const int kk = 2 * i + (lane >> 5); scr[kk * 33 + (lane & 31)] = (s >= 0) ? W[(size_t)(k0 + kk) * Nsrc + s] * scl : 0.f; }
    LDS_WAIT(); asm volatile("" ::: "memory");
    const int c = lane & 7;
#pragma unroll
    for (int j = 0; j < 4; ++j) { const int n = (lane >> 3) + 8 * j; const LAS float* sp = scr + (8 * c) * 33 + n;
        u32x4 o; o.x = pk2(sp[0 * 33], sp[1 * 33]); o.y = pk2(sp[2 * 33], sp[3 * 33]); o.z = pk2(sp[4 * 33], sp[5 * 33]); o.w = pk2(sp[6 * 33], sp[7 * 33]);
        *(u32x4*)(WT + (size_t)(n0 + n) * K + k0 + 8 * c) = o; }
    LDS_WAIT(); asm volatile("" ::: "memory");
}
constexpr float WG8_SCALE = 64.f;
template <class Map>
DI void transpose_item8(const float* W, int K, int Nsrc, int nblk, unsigned char* WT, const Map& map, int noff  , LAS float* scr, int item, int lane) {
    const int kb = item / nblk, nb = item % nblk, k0 = 64 * kb, n0 = 32 * nb;
    const int nd = noff + n0 + (lane & 31); const int s = map.src(nd); const float scl = map.scale(nd) * WG8_SCALE;
#pragma unroll 8
    for (int i = 0; i < 32; ++i) { const int kk = 2 * i + (lane >> 5); scr[kk * 33 + (lane & 31)] = (s >= 0) ? W[(size_t)(k0 + kk) * Nsrc + s] * scl : 0.f; }
    LDS_WAIT(); asm volatile("" ::: "memory");
#pragma unroll
    for (int j = 0; j < 2; ++j) { const int q = lane + 64 * j, n = q >> 2, c = q & 3; const LAS float* sp = scr + (16 * c) * 33 + n;
        int o[4];
#pragma unroll
        for (int e = 0; e < 4; ++e) { int w = 0; w = __builtin_amdgcn_cvt_pk_fp8_f32(sp[(4 * e + 0) * 33], sp[(4 * e + 1) * 33], w, false); w = __builtin_amdgcn_cvt_pk_fp8_f32(sp[(4 * e + 2) * 33], sp[(4 * e + 3) * 33], w, true); o[e] = w; }
        *(u32x4*)(WT + (size_t)(n0 + n) * K + k0 + 16 * c) = (u32x4){(unsigned)o[0], (unsigned)o[1], (unsigned)o[2], (unsigned)o[3]}; }
    LDS_WAIT(); asm volatile("" ::: "memory");
}
DI void mod_partial_item(const float* c, const float* wada, float* modp, int item, int lane) {
    const int kc = item & 15, nb = (item >> 4) % 48, l = item / (16 * 48);
    const int k0 = kc * 128, n0 = nb * 256 + 4 * lane;
    const float* Wl = wada + (size_t)l * 2048 * 12288;
    f32x4 acc[8];
#pragma unroll
    for (int b = 0; b < 8; ++b) acc[b] = (f32x4){0.f, 0.f, 0.f, 0.f};
#pragma unroll 1
    for (int sub = 0; sub < 2; ++sub) {
        float cb[8];
#pragma unroll
        for (int b = 0; b < 8; ++b) { const float x = c[b * 2048 + k0 + 64 * sub + lane]; cb[b] = x / (1.f + __expf(-x)); }
#pragma unroll 8
        for (int kk = 0; kk < 64; ++kk) { const f32x4 w = *(const f32x4*)(Wl + (size_t)(k0 + 64 * sub + kk) * 12288 + n0);
#pragma unroll
            for (int b = 0; b < 8; ++b) { const float s = __builtin_bit_cast(float, __builtin_amdgcn_readlane(__builtin_bit_cast(int, cb[b]), kk)); acc[b] += s * w; } }
    }
#pragma unroll
    for (int b = 0; b < 8; ++b) *(f32x4*)(modp + ((size_t)(kc * 2 + l) * 8 + b) * 12288 + n0) = acc[b];
}
template <bool F8, bool XB16>
DI void norm_row(const void* xrow, bf16_t* orow, unsigned char* orow8, const f32x4 (&Av)[8], const f32x4 (&Bv)[8], int lane) {
    f32x4 v[8]; float s = 0.f;
#pragma unroll
    for (int j = 0; j < 8; ++j) {
        if (XB16) { const u32x2 w = ((const u32x2*)xrow)[lane + 64 * j]; v[j] = (f32x4){__uint_as_float(w.x << 16), __uint_as_float(w.x & 0xffff0000u), __uint_as_float(w.y << 16), __uint_as_float(w.y & 0xffff0000u)}; }
        else v[j] = ((const f32x4*)xrow)[lane + 64 * j];
        s += (v[j][0] * v[j][0] + v[j][1] * v[j][1]) + (v[j][2] * v[j][2] + v[j][3] * v[j][3]); }
    const float rstd = 1.f / sqrtf(wave_sum(s) * (1.f / 2048.f) + RMS_EPS);
    u32x2* o8 = (u32x2*)orow + lane;
#pragma unroll
    for (int j = 0; j < 8; ++j) { const f32x4 h = v[j] * rstd * Av[j] + Bv[j]; u32x2 w; w.x = cvtpk(h[0], h[1]); w.y = cvtpk(h[2], h[3]); o8[64 * j] = w;
        if (F8) { int q = 0; q = __builtin_amdgcn_cvt_pk_fp8_f32(h[0], h[1], q, false); q = __builtin_amdgcn_cvt_pk_fp8_f32(h[2], h[3], q, true); ((int*)orow8)[lane + 64 * j] = q; } }
}
DI void final_row(const bf16_t* xrow, float* orow, const f32x4 (&Gv)[8], int lane) {
    f32x4* xr = (f32x4*)orow + lane;
    f32x4 v[8]; float s = 0.f;
#pragma unroll
    for (int j = 0; j < 8; ++j) { const u32x2 w = ((const u32x2*)xrow)[lane + 64 * j]; v[j] = (f32x4){__uint_as_float(w.x << 16), __uint_as_float(w.x & 0xffff0000u), __uint_as_float(w.y << 16), __uint_as_float(w.y & 0xffff0000u)};
        s += (v[j][0] * v[j][0] + v[j][1] * v[j][1]) + (v[j][2] * v[j][2] + v[j][3] * v[j][3]); }
    const float rstd = 1.f / sqrtf(wave_sum(s) * (1.f / 2048.f) + RMS_EPS);
#pragma unroll
    for (int j = 0; j < 8; ++j) xr[64 * j] = v[j] * rstd * Gv[j];
}
DI void conv_task(const bf16_t* qkv, const float* cw, bf16_t* br, int row0, int lane) {
    const int ch = lane * 8;
    float w0[8], w1[8], w2[8];
#pragma unroll
    for (int j = 0; j < 8; ++j) { w0[j] = cw[ch + j]; w1[j] = cw[512 + ch + j]; w2[j] = cw[1024 + ch + j]; }
    float up2[8], up1[8];
    const bf16_t* rp = qkv + (size_t)row0 * LDQ + ch;
    auto load_u = [&](const bf16_t* r, float (&u)[8]) {
        const bf16x8 cg = *(const bf16x8*)(r + C_CG), xi = *(const bf16x8*)(r + C_XIN);
#pragma unroll
        for (int j = 0; j < 8; ++j) u[j] = bf2f((bf16_t)cg[j]) * bf2f((bf16_t)xi[j]);
    };
    if ((row0 & (SEQ - 1)) == 0) {
#pragma unroll
        for (int j = 0; j < 8; ++j) { up2[j] = 0.f; up1[j] = 0.f; }
    } else { load_u(rp - 2 * LDQ, up2); load_u(rp - LDQ, up1); }
    bf16_t* op = br + (size_t)row0 * 2048 + 1024 + ch;
#pragma unroll
    for (int i = 0; i < 8; ++i) { float u[8]; load_u(rp, u);
        const bf16x8 bg = *(const bf16x8*)(rp + C_BG);
        rp += LDQ; asm volatile("" : "+v"(rp));
        float y[8];
#pragma unroll
        for (int j = 0; j < 8; ++j) y[j] = bf2f((bf16_t)bg[j]) * (w0[j] * up2[j] + w1[j] * up1[j] + w2[j] * u[j]);
        u32x4 o; o.x = cvtpk(y[0], y[1]); o.y = cvtpk(y[2], y[3]); o.z = cvtpk(y[4], y[5]); o.w = cvtpk(y[6], y[7]);
        *(u32x4*)op = o; op += 2048; asm volatile("" : "+v"(op));
#pragma unroll
        for (int j = 0; j < 8; ++j) { up2[j] = up1[j]; up1[j] = u[j]; } }
}
DI void fcum_task(const bf16_t* qkvb  , float bf_h, int h, float* out  , int lane) {
    const bf16_t* p = qkvb + (size_t)(32 * lane) * LDQ + C_FD + h;
    float v[32];
#pragma unroll
    for (int i = 0; i < 32; ++i) { v[i] = bf2f(*p); p += LDQ; asm volatile("" : "+v"(p)); }
    float run = 0.f;
#pragma unroll
    for (int i = 0; i < 32; ++i) { const float x = v[i] + bf_h; run -= __logf(1.f + __expf(-x)); v[i] = run; }
    float incl = run;
#pragma unroll
    for (int o = 1; o < 64; o <<= 1) { const float y = __shfl_up(incl, o); if (lane >= o) incl += y; }
    const float excl = incl - run;
    float* op = out + 32 * lane;
#pragma unroll
    for (int i = 0; i < 32; i += 4) *(f32x4*)(op + i) = (f32x4){(v[i] + excl) * LOG2E, (v[i + 1] + excl) * LOG2E, (v[i + 2] + excl) * LOG2E, (v[i + 3] + excl) * LOG2E};
}
DI int rowsum16(int x) { x += __shfl_xor(x, 8); x += __shfl_xor(x, 4); x += __shfl_xor(x, 2); x += __shfl_xor(x, 1); return x; }
DI void select_task(const bf16_t* qkvb  , const bf16_t* ikb  , unsigned long long* mrow  , int t0, LAS unsigned long long* wl, int lane_in) {
    int lane = lane_in; asm volatile("" : "+v"(lane));
    const int fr = lane & 15, fq = lane >> 4, t = t0 + fq;
    const int nch = __builtin_amdgcn_readfirstlane((t0 + 3) / 256 + 1);
    const bf16_t* ap = qkvb + (size_t)(t0 + (fr >> 2)) * LDQ + C_IQ + (fr & 3) * 64 + fq * 8;
    const bf16x8 a0 = *(const bf16x8*)ap, a1 = *(const bf16x8*)(ap + 32);
    float w[4]; { const u32x2 ww = *(const u32x2*)(qkvb + (size_t)t * LDQ + C_IW);
        w[0] = __uint_as_float(ww.x << 16) * IDX_SCALE; w[1] = __uint_as_float(ww.x & 0xffff0000u) * IDX_SCALE; w[2] = __uint_as_float(ww.y << 16) * IDX_SCALE; w[3] = __uint_as_float(ww.y & 0xffff0000u) * IDX_SCALE; }
    unsigned u[128];
    const int tf = t - fr;
    const char* kbase = (const char*)ikb;
    unsigned voff = (unsigned)lane * 16u;
#pragma unroll
    for (int c = 0; c < 8; ++c) {
        if (c < nch) {
#pragma unroll
            for (int ii = 0; ii < 16; ++ii) { const int i = c * 16 + ii;
                const bf16x8 b0 = *(const bf16x8*)(kbase + voff), b1 = *(const bf16x8*)(kbase + voff + 1024);
                voff += 16 * 64 * 2; asm volatile("" : "+v"(voff));
                f32x4 acc = (f32x4){0.f, 0.f, 0.f, 0.f};
                acc = __builtin_amdgcn_mfma_f32_16x16x32_bf16(a0, b0, acc, 0, 0, 0);
                acc = __builtin_amdgcn_mfma_f32_16x16x32_bf16(a1, b1, acc, 0, 0, 0);
                const float sc = ((w[0] * fmaxf(acc[0], 0.f) + w[1] * fmaxf(acc[1], 0.f)) + w[2] * fmaxf(acc[2], 0.f)) + w[3] * fmaxf(acc[3], 0.f);
                unsigned bits = __float_as_uint(sc); if (bits == 0x80000000u) bits = 0u;
                const unsigned key = (bits & 0x80000000u) ? ~bits : (bits | 0x80000000u);
                u[i] = (16 * i <= tf) ? key : 0u; }
        } else {
#pragma unroll
            for (int ii = 0; ii < 16; ++ii) u[c * 16 + ii] = 0u;
        }
    }
#define CNT_GE(cnt, x, c) asm("v_cmp_ge_u32 vcc, %1, %2\n\tv_addc_co_u32 %0, vcc, 0, %0, vcc" : "+v"(cnt) : "v"(x), "v"(c) : "vcc")
#define CNT_GT(cnt, x, c) asm("v_cmp_gt_u32 vcc, %1, %2\n\tv_addc_co_u32 %0, vcc, 0, %0, vcc" : "+v"(cnt) : "v"(x), "v"(c) : "vcc")
#define FOR_CHUNKS(BODY) _Pragma("unroll") for (int c_ = 0; c_ < 8; ++c_) { if (c_ < nch) { _Pragma("unroll") for (int ii_ = 0; ii_ < 16; ++ii_) { const int i = c_ * 16 + ii_; BODY; } } }
    unsigned T = 0u;
    bool done = false;
#pragma unroll 1
    for (int bit = 31; bit >= 0; --bit) { const unsigned c = T | (1u << bit); int cnt = 0;
        FOR_CHUNKS(CNT_GE(cnt, u[i], c));
        cnt = rowsum16(cnt); if (!done && cnt >= 256) T = c; done = done || (cnt == 256);
        if (__all(done)) break; }
    int cgt = 0, cge = 0;
    FOR_CHUNKS(CNT_GT(cgt, u[i], T); CNT_GE(cge, u[i], T));
    cgt = rowsum16(cgt); cge = rowsum16(cge);
    const int need = 256 - cgt; const bool tie = (cge - cgt) > need;
    int X0 = 4095;
    if (__any(tie)) { int x = 0; const unsigned notT = ~T;
#pragma unroll 1
        for (int bit = 10; bit >= 0; --bit) { const int c = x | (1 << bit); int g = 0; const int cf = c - fr;
            FOR_CHUNKS(unsigned tmp;
                asm("v_cmp_lt_i32 vcc, %6, %3\n\tv_cndmask_b32 %1, %4, %2, vcc\n\tv_cmp_eq_u32 vcc, %1, %5\n\tv_addc_co_u32 %0, vcc, 0, %0, vcc"
                    : "+v"(g), "=&v"(tmp) : "v"(u[i]), "v"(cf), "v"(notT), "v"(T), "n"(16 * i) : "vcc"));
            g = rowsum16(g); if (g < need) x = c; }
        if (tie) X0 = x; }
#undef CNT_GE
#undef CNT_GT
    const int xf = X0 - fr;
    FOR_CHUNKS(const bool sel = (u[i] > T) || (u[i] == T && 16 * i <= xf);
        const unsigned long long bal = __ballot(sel); if (lane == 0) wl[i] = bal;
        if ((i & 3) == 3) asm volatile("" ::: "memory"));
#undef FOR_CHUNKS
    LDS_WAIT(); asm volatile("" ::: "memory");
#pragma unroll
    for (int half = 0; half < 2; ++half) { const int j = fr + 16 * half; unsigned long long word = 0ull;
        if (j < nch * 4) {
#pragma unroll
            for (int i4 = 0; i4 < 4; ++i4) word |= ((wl[4 * j + i4] >> (16 * fq)) & 0xFFFFull) << (16 * i4); }
        mrow[(size_t)t * 32 + j] = word; }
    LDS_WAIT(); asm volatile("" ::: "memory");
}
DI void select_causal_task(unsigned long long* mrow, int t0, int lane) {
    const int fr = lane & 15, fq = lane >> 4, t = t0 + fq;
#pragma unroll
    for (int half = 0; half < 2; ++half) { const int j = fr + 16 * half; const int n = t - 64 * j + 1;
        const unsigned long long word = n >= 64 ? ~0ull : (n <= 0 ? 0ull : ((1ull << n) - 1ull));
        mrow[(size_t)t * 32 + j] = word; }
}
DI void select_any(const bf16_t* qkvb, const bf16_t* ikb, unsigned long long* mrow, int t0, LAS unsigned long long* wl, int lane) {
    if (t0 + 3 < 256) select_causal_task(mrow, t0, lane);
    else select_task(qkvb, ikb, mrow, t0, wl, lane);
}

constexpr size_t MiB = 1u << 20;
constexpr size_t WS_CTL = 0, CTL_ZERO_BYTES = 1 * MiB;
constexpr size_t WS_MODF = 1 * MiB;
constexpr size_t WS_IK = 2 * MiB;
constexpr size_t WS_MODP = 2 * MiB;
constexpr size_t WS_FCUM = 14 * MiB;
constexpr size_t WS_MASK = 15 * MiB;
constexpr size_t WS_STASH = 20 * MiB;
constexpr size_t WS_W = 52 * MiB;
constexpr size_t OW_IN = 0, OW_IN8 = 16 * MiB  , OW_G = 26 * MiB, OW_B = 58 * MiB, OW_O = 66 * MiB, OW_1 = 74 * MiB, OW_2 = 106 * MiB, LW_BYTES = 138 * MiB;
constexpr size_t WS_H = WS_W + 2 * LW_BYTES;
constexpr size_t WS_BR = WS_H + 64 * MiB;
constexpr size_t WS_R1 = WS_BR + 64 * MiB;
constexpr size_t WS_H8 = WS_R1 + 256 * MiB;
constexpr size_t WS_XB = WS_H8 + 32 * MiB;
constexpr size_t WS_END = WS_XB + 64 * MiB;
constexpr int CW_BAR = 4096;
constexpr int CW_QUEUE = 16384;

constexpr int RING_OFF = 0, RING_BYTES = 131072;
constexpr int LDSCTL_OFF = RING_BYTES, MISC_OFF = LDSCTL_OFF + 320;
constexpr int LDS_BYTES = 147456;
static_assert(att::LDS_END <= RING_BYTES, "attention scratch inside the ring region");


constexpr int NWAVES = 8;
constexpr int N_PHASES = 23;
struct Args { const float* in[19]; float* out; unsigned char* ws; int ph_lo, ph_hi; };

typedef __attribute__((address_space(4))) const unsigned char* kargp_t;
DI kargp_t karg_base() { kargp_t kp = (kargp_t)__builtin_amdgcn_kernarg_segment_ptr(); asm volatile("" : "+s"(kp)); return kp; }
DI unsigned long long karg_u64(int i) { return *(const __attribute__((address_space(4))) unsigned long long*)(karg_base() + 8 * i); }
DI const float* karg_in(int i) { return (const float*)(GAS const float*)karg_u64(i); }
DI float* karg_out() { return (float*)(GAS float*)karg_u64(19); }
DI unsigned char* karg_ws() { return (unsigned char*)(GAS unsigned char*)karg_u64(20); }
#define ARG_IN(i) karg_in(i)

template <int MODE>
DI void attn_queue(LAS unsigned char* lds, volatile LAS unsigned* MISC, int qidx, int l, int tid, int lane, int variant = 0) {
    unsigned char* ws = karg_ws();
    unsigned* qhead = (unsigned*)(ws + WS_CTL) + CW_QUEUE + 64 * qidx;
    bf16_t* QKV = (bf16_t*)(ws + WS_R1); bf16_t* BR = (bf16_t*)(ws + WS_BR);
    float lamv = 0.f, post = 0.f;
    if (MODE == 1) { const float* lq = ARG_IN(8) + l * 256; const float a = wave_sum(lq[lane] * lq[64 + lane]), b = wave_sum(lq[128 + lane] * lq[192 + lane]);
        const float lam_init = 0.8f - 0.6f * expf(-0.3f * (float)l); lamv = expf(a) - expf(b) + lam_init; post = 1.f - lam_init; }
    for (;;) {
        if (tid == 0) MISC[0] = __hip_atomic_fetch_add(qhead, 1u, RLX_AGENT);
        __syncthreads();
        const unsigned u = MISC[0];
        __syncthreads();
        if (u >= 256u) break;
        const int qb = 7 - (int)(u >> 5), bh = (int)(u & 31u), b = bh >> 2, h = bh & 3;
        att::UnitArgs A;
        const size_t rowb = (size_t)b * SEQ;
        const int cq = MODE == 0 ? C_QA : (MODE == 1 ? C_QB : C_QD), ck = MODE == 0 ? C_KA : (MODE == 1 ? C_KB : C_KD), cv = MODE == 0 ? C_VA : (MODE == 1 ? C_VB : C_VD);
        const int oc = MODE == 0 ? 0 : (MODE == 1 ? 512 : 1536);
        A.Qp = QKV + rowb * LDQ + cq + h * 128; A.Kp = QKV + rowb * LDQ + ck + h * 128; A.Vp = QKV + rowb * LDQ + cv + h * 128;
        A.Op = BR + rowb * 2048 + oc + h * 128; A.q0 = qb * 256;
        A.maskp = (const unsigned long long*)(ws + WS_MASK) + rowb * 32;
        A.fcum = (const float*)(ws + WS_FCUM) + (size_t)(b * 4 + h) * SEQ;
        A.relb = ARG_IN(10); A.relcol = (MODE == 1 ? 4 : 0) + h;
        A.lam = lamv; A.post = post; A.gsub = ARG_IN(9) + l * 128;
        A.stash = (float*)(ws + WS_STASH) + (size_t)blockIdx.x * 64 * 512;
        A.variant = variant; if (variant) A.Op = (bf16_t*)(ws + WS_END) + rowb * 2048 + oc + h * 128;
#ifdef ATT_V1
        att::attn_unit<MODE>((LAS char*)lds, A);
#else
        att::attn_unit_p<MODE>((LAS char*)lds, A);
#endif
    }
}

#define IN(k) (lo <= (k) && (k) < hi)
#ifdef PROBE_TIME
#ifndef PROBE_BLK
#define PROBE_BLK 0
#endif
#ifndef PROBE_SEL
#define PROBE_SEL(k) 1
#endif
#ifndef PROBE_Q
#define PROBE_Q 50.f
#endif
constexpr int CW_TIME = 20000, CW_TPREV = 20064;
#define SEAM(k) do { if (IN((k) + 1)) { unsigned* cw_ = (unsigned*)(karg_ws() + WS_CTL); const bool me_ = (blockIdx.x == PROBE_BLK && threadIdx.x == 0); \
        const unsigned ta_ = (unsigned)__builtin_amdgcn_s_memrealtime(); \
        if (me_ && PROBE_TIME == 2 && PROBE_SEL(k)) atomicAdd(cw_ + CW_TIME, ta_ - cw_[CW_TPREV]); \
        xcd_barrier(bar); \
        const unsigned te_ = (unsigned)__builtin_amdgcn_s_memrealtime(); \
        if (me_) { if (PROBE_TIME == 1) atomicAdd(cw_ + CW_TIME, te_ - ta_); cw_[CW_TPREV] = te_; } } } while (0)
#else
#define SEAM(k) do { if (IN((k) + 1)) xcd_barrier(bar); } while (0)
#endif
#define PH_PTRS int tid_p = threadIdx.x; asm volatile("" : "+v"(tid_p)); const int tid = tid_p, lane = tid & 63; (void)lane; unsigned char* ws = karg_ws(); float* xbuf = karg_out(); float* modf = (float*)(ws + WS_MODF); float* modp = (float*)(ws + WS_MODP); \
    bf16_t* Hb = (bf16_t*)(ws + WS_H); bf16_t* BR = (bf16_t*)(ws + WS_BR); bf16_t* R1 = (bf16_t*)(ws + WS_R1); \
    (void)xbuf; (void)modf; (void)modp; (void)Hb; (void)BR; (void)R1
#define PH_LAYER PH_PTRS; unsigned char* wl_ = ws + WS_W + (size_t)l * LW_BYTES; const float* modl = modf + (size_t)l * 8 * 12288; (void)wl_; (void)modl
template <int l, int LO, int HI>
DI void layer_phases(LAS unsigned char* lds, volatile LAS unsigned* MISC, const XcdBarrier& bar, int wave, int G, int bx, int gw, int NGW) {
    constexpr int lo = LO, hi = HI;
        const int pb = 2 + 10 * l;
        if (IN(pb + 0)) { PH_LAYER;
            const float* g1 = ARG_IN(4) + l * 2048; bf16_t* xb16 = (bf16_t*)(ws + WS_XB); (void)xb16;
#ifndef PROBE_REP_N1
#define PROBE_REP_N1 1
#endif
#pragma unroll 1
          for (int rep = 0; rep < PROBE_REP_N1; ++rep)
            for (int rb = gw; rb < M_TOK / 8; rb += NGW) { const int b = (rb * 8) / SEQ; f32x4 Av[8], Bv[8];
#pragma unroll
                for (int j = 0; j < 8; ++j) { const int c = 4 * lane + 256 * j; const f32x4 g = *(const f32x4*)(g1 + c), sc = *(const f32x4*)(modl + b * 12288 + 2048 + c); Av[j] = g * (sc + 1.f); Bv[j] = *(const f32x4*)(modl + b * 12288 + c); }
#pragma unroll 1
                for (int i = 0; i < 8; ++i) { const size_t ro = (size_t)(rb * 8 + i) * 2048;
                    if (l == 0) norm_row<true, false>(ARG_IN(0) + ro, Hb + ro, ws + WS_H8 + ro, Av, Bv, lane); else norm_row<true, true>(xb16 + ro, Hb + ro, ws + WS_H8 + ro, Av, Bv, lane); } }
            SEAM(pb + 0);
        }
        if (IN(pb + 1)) { PH_LAYER;
            { pg8::Gemm g{(const bf16_t*)(ws + WS_H8), (const bf16_t*)(wl_ + OW_IN8), M_TOK, N_IN8, 1024, 1024, 1024, 1 << 30, 0}; pg8::HalfOrder S; S.init(M_TOK, N_IN8, G, bx); S.nall = 1; S.extra = 3; S.hi_half = true;
              pg8::EpiBf16s E{R1 + N_IN16, LDQ, 1.f / WG8_SCALE, QSCALE128 / WG8_SCALE, 0xC3u};
              pg8::gemm_phase<pg8::EpiBf16s, pg8::HalfOrder, true, true, true>(lds + RING_OFF, g, S, E); }
            { pg8::Gemm g{Hb, (const bf16_t*)(wl_ + OW_IN), M_TOK, N_IN16, 2048, 2048, 2048, 1 << 30, 0}; pg8::HalfOrder S; S.init(M_TOK, N_IN16, G, bx); S.nall = 3; S.extra = 2; S.hi_half = false;
              pg8::EpiBf16ik E{R1, LDQ, (bf16_t*)(ws + WS_IK)};
              pg8::gemm_phase<pg8::EpiBf16ik, pg8::HalfOrder, true, true>(lds + RING_OFF, g, S, E); }
            SEAM(pb + 1);
        }
        if (IN(pb + 2)) { PH_LAYER;
            LAS unsigned long long* wlq = (LAS unsigned long long*)(lds + RING_OFF) + wave * 128;
            unsigned long long* mask = (unsigned long long*)(ws + WS_MASK);
            unsigned* qh = (unsigned*)(ws + WS_CTL) + CW_QUEUE + 64 * (12 + l);
#pragma unroll 1
            for (;;) {
                unsigned kq = 0u; if (lane == 0) kq = __hip_atomic_fetch_add(qh, 1u, RLX_AGENT);
                const int k = __builtin_amdgcn_readfirstlane((int)kq);
                if (k >= 6176) break;
                int ln = lane; asm volatile("" : "+v"(ln));
                if (k < 2048 || (k >= 2080 && k < 4128)) { const int j = k < 2048 ? k : k - 32; const int b = j & 7, t0 = (511 - (j >> 3)) * 4;
                    select_any(R1 + (size_t)b * SEQ * LDQ, (const bf16_t*)(ws + WS_IK) + (size_t)b * SEQ * 64, mask + (size_t)b * SEQ * 32, t0, wlq, ln); }
                else if (k < 2080) { const int kk = k - 2048, b = kk >> 2, h = kk & 3; fcum_task(R1 + (size_t)b * SEQ * LDQ, ARG_IN(6)[l * 4 + h], h, (float*)(ws + WS_FCUM) + (size_t)kk * SEQ, ln); }
                else conv_task(R1, ARG_IN(7) + l * 1536, BR, (k - 4128) * 8, ln);
            }
            SEAM(pb + 2);
        }
        if (IN(pb + 3)) { PH_LAYER;
#ifndef PROBE_REP_M2
#define PROBE_REP_M2 1
#endif
#ifndef PROBE_VARIANT
#define PROBE_VARIANT 0
#endif
#pragma unroll 1
          for (int rep = 0; rep < PROBE_REP_M2; ++rep) {
            if (rep) xcd_barrier(bar);
            attn_queue<1>(lds + RING_OFF, MISC, 3 * l + 0 + 6 * rep, l, tid, lane, rep ? PROBE_VARIANT : 0);
            attn_queue<0>(lds + RING_OFF, MISC, 3 * l + 1 + 6 * rep, l, tid, lane, rep ? PROBE_VARIANT : 0);
            attn_queue<2>(lds + RING_OFF, MISC, 3 * l + 2 + 6 * rep, l, tid, lane, rep ? PROBE_VARIANT : 0);
          }
            SEAM(pb + 3);
        }
        if (IN(pb + 4)) { PH_LAYER;
            pg8::Gemm g{BR, (const bf16_t*)(wl_ + OW_B), M_TOK, 8192, 512, 2048, 512, 8, 512}; pg8::StaticOrder S; S.init(M_TOK, 8192, G, bx);
            pg8::EpiPtile E{R1};

#ifndef NO_G2
#ifndef PROBE_REP_G2
#define PROBE_REP_G2 1
#endif
#pragma unroll 1
            for (int rep = 0; rep < PROBE_REP_G2; ++rep)
            pg8::gemm_phase<pg8::EpiPtile, pg8::StaticOrder, true, true>(lds + RING_OFF, g, S, E);
#endif
            SEAM(pb + 4);
        }
        if (IN(pb + 5)) { PH_LAYER;
            pg8::Gemm g{(const bf16_t*)(ws + WS_H8), (const bf16_t*)(wl_ + OW_G), M_TOK, 8192, 1024, 1024, 1024, 1 << 30, 0}; pg8::StaticOrder S; S.init(M_TOK, 8192, G, bx);
            pg8::EpiGate E{R1, ARG_IN(12) + l * 8192, BR, 1.f / WG8_SCALE};

#ifndef NO_G3
#ifndef PROBE_REP_G3
#define PROBE_REP_G3 1
#endif
#pragma unroll 1
            for (int rep = 0; rep < PROBE_REP_G3; ++rep)
            S.rev = true; pg8::gemm_phase<pg8::EpiGate, pg8::StaticOrder, true, true, true>(lds + RING_OFF, g, S, E);
#endif

            SEAM(pb + 5);
        }
        if (IN(pb + 6)) { PH_LAYER;
            pg8::Gemm g{BR, (const bf16_t*)(wl_ + OW_O), M_TOK, 2048, 2048, 2048, 2048, 1 << 30, 0}; pg8::StaticOrder S; S.init(M_TOK, 2048, G, bx);
            bf16_t* xb16 = (bf16_t*)(ws + WS_XB);
            pg8::EpiResidB<l == 0> E{(l == 0) ? (const void*)ARG_IN(0) : (const void*)xb16, xb16, modl + 4096, 12288};

#ifndef NO_G4
#ifdef PROBE_NULL_G4
            { pg8::EpiNull EN{(float*)(ws + WS_FCUM)}; pg8::gemm_phase<pg8::EpiNull, pg8::StaticOrder, true, true>(lds + RING_OFF, g, S, EN); }
#endif
            pg8::gemm_phase<pg8::EpiResidB<l == 0>, pg8::StaticOrder, true, true>(lds + RING_OFF, g, S, E);
#endif
            SEAM(pb + 6);
        }
        if (IN(pb + 7)) { PH_LAYER;
            const float* g2 = ARG_IN(15) + l * 2048;
            for (int rb = gw; rb < M_TOK / 8; rb += NGW) { const int b = (rb * 8) / SEQ; f32x4 Av[8], Bv[8];
#pragma unroll
                for (int j = 0; j < 8; ++j) { const int c = 4 * lane + 256 * j; const f32x4 g = *(const f32x4*)(g2 + c), sc = *(const f32x4*)(modl + b * 12288 + 8192 + c); Av[j] = g * (sc + 1.f); Bv[j] = *(const f32x4*)(modl + b * 12288 + 6144 + c); }
#pragma unroll 1
                for (int i = 0; i < 8; ++i) norm_row<false, true>((const bf16_t*)(ws + WS_XB) + (size_t)(rb * 8 + i) * 2048, Hb + (size_t)(rb * 8 + i) * 2048, nullptr, Av, Bv, lane); }
            SEAM(pb + 7);
        }
        if (IN(pb + 8)) { PH_LAYER;
            pg8::Gemm g{Hb, (const bf16_t*)(wl_ + OW_1), M_TOK, 8192, 2048, 2048, 2048, 1 << 30, 0}; pg8::StaticOrder S; S.init(M_TOK, 8192, G, bx);
            pg8::EpiBf16<2> E{R1, 8192};

#ifndef NO_G5
#ifdef PROBE_NULL_G5
            { pg8::EpiNull EN{(float*)(ws + WS_FCUM)}; pg8::gemm_phase<pg8::EpiNull, pg8::StaticOrder, true, true>(lds + RING_OFF, g, S, EN); }
#endif
#ifdef PROBE_SPLIT_G5
            { pg8::RangeOrder S1; S1.init(M_TOK, 8192, G, bx); S1.i0 = 0; S1.n = 4; pg8::RangeOrder S2; S2.init(M_TOK, 8192, G, bx); S2.i0 = 4; S2.n = 4;
              pg8::gemm_phase<pg8::EpiBf16<2>, pg8::RangeOrder, true, true>(lds + RING_OFF, g, S1, E);
              xcd_barrier(bar);
              pg8::gemm_phase<pg8::EpiBf16<2>, pg8::RangeOrder, true, true>(lds + RING_OFF, g, S2, E); }
#else
            pg8::gemm_phase<pg8::EpiBf16<2>, pg8::StaticOrder, true, true>(lds + RING_OFF, g, S, E);
#endif
#endif

            SEAM(pb + 8);
        }
        if (IN(pb + 9)) { PH_LAYER;
            pg8::Gemm g{R1, (const bf16_t*)(wl_ + OW_2), M_TOK, 2048, 8192, 8192, 8192, 1 << 30, 0}; pg8::StaticOrder S; S.init(M_TOK, 2048, G, bx);
            bf16_t* xb16 = (bf16_t*)(ws + WS_XB);
            pg8::EpiResidB<false> E{xb16, xb16, modl + 10240, 12288};

#ifndef NO_G6
#ifdef PROBE_DUP_G6
            { pg8::EpiResid ED{xbuf, (float*)(ws + WS_H), modl + 10240, 12288}; pg8::gemm_phase<pg8::EpiResid, pg8::StaticOrder, true, true>(lds + RING_OFF, g, S, ED); }
#endif
#ifdef PROBE_NULL_G6
            { pg8::EpiNull EN{(float*)(ws + WS_FCUM)}; pg8::gemm_phase<pg8::EpiNull, pg8::StaticOrder, true, true>(lds + RING_OFF, g, S, EN); }
#endif
            S.rev = true; pg8::gemm_phase<pg8::EpiResidB<false>, pg8::StaticOrder, true, true>(lds + RING_OFF, g, S, E);
#endif
            SEAM(pb + 9);
        }
}

template <int LO, int HI>
__global__ void __launch_bounds__(NWAVES * 64, 2) mk_fwd(Args args) {
    extern __shared__ __attribute__((aligned(16))) unsigned char lds_raw[];
    LAS unsigned char* lds = (LAS unsigned char*)lds_raw;
    volatile LAS unsigned* MISC = (volatile LAS unsigned*)(lds + MISC_OFF);
    const int tid0 = threadIdx.x, wave = __builtin_amdgcn_readfirstlane(tid0 >> 6);
    const int G = gridDim.x; const int bx = blockIdx.x; const int vcu = (G % 8 == 0) ? (bx % 8) * (G / 8) + bx / 8 : bx;
    const int gw = vcu * NWAVES + wave, NGW = G * NWAVES;
    for (int u = tid0; u < (LDS_BYTES - LDSCTL_OFF) / 4; u += NWAVES * 64) ((LAS unsigned*)(lds + LDSCTL_OFF))[u] = 0u;
    __syncthreads();
    constexpr int lo = LO, hi = HI; (void)args;
    XcdBarrier bar; bar.bar = (unsigned*)(karg_ws() + WS_CTL) + CW_BAR; bar.x = 0; bar.st = nullptr;
    if constexpr (hi - lo > 1) bar = xcd_barrier_post((unsigned*)(karg_ws() + WS_CTL) + CW_BAR, MISC + 8);

#ifdef PROBE_TIME
    if (blockIdx.x == PROBE_BLK && threadIdx.x == 0) ((unsigned*)(karg_ws() + WS_CTL))[CW_TPREV] = (unsigned)__builtin_amdgcn_s_memrealtime();
#endif
    if (IN(0)) { PH_PTRS;
        LAS float* scr = (LAS float*)(lds + RING_OFF + wave * 16384);
#ifndef PROBE_REP_P0
#define PROBE_REP_P0 1
#endif
#pragma unroll 1
        for (int rep = 0; rep < PROBE_REP_P0; ++rep) {
        constexpr int I_IN = 32 * 208, I_G = 32 * 256, I_B = 4 * 8 * 64, I_O = 32 * 64, I_1 = 32 * 256, I_2 = 128 * 64, I_L = I_IN + I_G + I_B + I_O + I_1 + I_2;
        for (int it = gw; it < 2 * I_L; it += NGW) {
            const int l = it / I_L; int r = it % I_L;
            unsigned char* wl_ = ws + WS_W + (size_t)l * LW_BYTES;
            if (r < 32 * 128) { transpose_item(ARG_IN(5) + (size_t)l * 2048 * 6472, 2048, 6472, 128, (bf16_t*)(wl_ + OW_IN), MapWin(), scr, r, lane); continue; } r -= 32 * 128;
            if (r < 32 * 80) { transpose_item8(ARG_IN(5) + (size_t)l * 2048 * 6472, 2048, 6472, 80, (unsigned char*)(wl_ + OW_IN8), MapWin(), N_IN16, scr, r, lane); continue; } r -= 32 * 80;
            if (r < I_G) { transpose_item8(ARG_IN(11) + (size_t)l * 2048 * 8192, 2048, 8192, 256, (unsigned char*)(wl_ + OW_G), MapGate(), 0, scr, r, lane); continue; } r -= I_G;
            const float* W; int K, Ns, nblk; bf16_t* WT;
            if (r < I_B) { const int g = r / 512; r -= g * 512; W = ARG_IN(13) + (size_t)(l * 4 + g) * 512 * 2048; K = 512; Ns = 2048; nblk = 64; WT = (bf16_t*)(wl_ + OW_B) + (size_t)g * 2048 * 512; }
            else { r -= I_B;
                if (r < I_O) { W = ARG_IN(14) + (size_t)l * 2048 * 2048; K = 2048; Ns = 2048; nblk = 64; WT = (bf16_t*)(wl_ + OW_O); }
                else { r -= I_O;
                    if (r < I_1) { W = ARG_IN(16) + (size_t)l * 2048 * 8192; K = 2048; Ns = 8192; nblk = 256; WT = (bf16_t*)(wl_ + OW_1); }
                    else { r -= I_1; W = ARG_IN(17) + (size_t)l * 8192 * 2048; K = 8192; Ns = 2048; nblk = 64; WT = (bf16_t*)(wl_ + OW_2); } } }
            transpose_item(W, K, Ns, nblk, WT, MapPlain(), scr, r, lane);
        }
        for (int it = gw; it < 2 * 48 * 16; it += NGW) mod_partial_item(ARG_IN(1), ARG_IN(2), modp, it, lane);
        }
        SEAM(0);
    }
    if (IN(1)) { PH_PTRS;
        for (int i = bx * 512 + tid; i < 2 * 8 * 12288; i += G * 512) { const int n = i % 12288, l = i / (8 * 12288);
            float s = ARG_IN(3)[l * 12288 + n];
#pragma unroll
            for (int kc = 0; kc < 16; ++kc) s += modp[(size_t)kc * (2 * 8 * 12288) + i];
            modf[i] = s; }
        SEAM(1);
    }
    constexpr int L_LO = (LO <= 2) ? 0 : (LO - 2) / 10, L_HI = (HI >= 22) ? NLAYER : (HI - 2 + 9) / 10;
    if constexpr (L_LO <= 0 && 0 < L_HI) layer_phases<0, LO, HI>(lds, MISC, bar, wave, G, bx, gw, NGW);
    if constexpr (L_LO <= 1 && 1 < L_HI) layer_phases<1, LO, HI>(lds, MISC, bar, wave, G, bx, gw, NGW);
    if (IN(22)) { PH_PTRS;
        f32x4 Gv[8];
#pragma unroll
        for (int j = 0; j < 8; ++j) Gv[j] = *(const f32x4*)(ARG_IN(18) + 4 * lane + 256 * j);
        for (int rb = gw; rb < M_TOK / 8; rb += NGW) {
#pragma unroll 1
            for (int i = 0; i < 8; ++i) final_row((const bf16_t*)(ws + WS_XB) + (size_t)(rb * 8 + i) * 2048, xbuf + (size_t)(rb * 8 + i) * 2048, Gv, lane); }
#ifdef PROBE_TIME
        if (bx == 0 && tid == 0) { asm volatile("s_waitcnt vmcnt(0)" ::: "memory"); const unsigned* cw_ = (const unsigned*)(ws + WS_CTL); float t_us = (float)cw_[CW_TIME] * 0.01f; t_us = floorf(t_us / PROBE_Q + 0.5f) * PROBE_Q;
            xbuf[0] = sqrtf(t_us * 1e-3f * 33554432.f); }
#endif
    }
}

#if !MK_ONE_LAUNCH
template <int P> static void set_attr_from() { if constexpr (P < N_PHASES) { (void)hipFuncSetAttribute((const void*)mk_fwd<P, P + 1>, hipFuncAttributeMaxDynamicSharedMemorySize, LDS_BYTES); set_attr_from<P + 1>(); } }
template <int P> static void launch_from(int grid, hipStream_t stream, Args a) {
    if constexpr (P < N_PHASES) { a.ph_lo = P; a.ph_hi = P + 1; hipLaunchKernelGGL((mk_fwd<P, P + 1>), dim3(grid), dim3(NWAVES * 64), LDS_BYTES, stream, a); launch_from<P + 1>(grid, stream, a); } }
#endif
extern "C" void kernel_launch(void* const* d_in, const int* in_sizes, int n_in, void* d_out, int out_size, void* d_ws, size_t ws_size, hipStream_t stream) {
    static int grid = 0;
    if (grid == 0) {
        if (n_in != 19 || in_sizes[0] != M_TOK * DM || out_size != M_TOK * DM || ws_size < WS_END) {
            fprintf(stderr, "kernel_launch: shape / workspace mismatch (n_in %d, in0 %d, out %d, ws %zu, need %zu); nothing launched\n", n_in, n_in > 0 ? in_sizes[0] : -1, out_size, ws_size, (size_t)WS_END); grid = -1; return; }
        int dev = 0, cus = 0, per_cu = 0;
        if (hipGetDevice(&dev) != hipSuccess || hipDeviceGetAttribute(&cus, hipDeviceAttributeMultiprocessorCount, dev) != hipSuccess) { fprintf(stderr, "kernel_launch: device query failed\n"); grid = -1; return; }
#if MK_ONE_LAUNCH
        if (hipFuncSetAttribute((const void*)mk_fwd<0, N_PHASES>, hipFuncAttributeMaxDynamicSharedMemorySize, LDS_BYTES) != hipSuccess) { fprintf(stderr, "kernel_launch: hipFuncSetAttribute failed\n"); grid = -1; return; }
        if (hipOccupancyMaxActiveBlocksPerMultiprocessor(&per_cu, (const void*)mk_fwd<0, N_PHASES>, NWAVES * 64, LDS_BYTES) != hipSuccess || per_cu < 1) fprintf(stderr, "kernel_launch: occupancy query reports %d workgroups per CU\n", per_cu);
#else
        set_attr_from<0>();
#endif
        (void)hipGetLastError();
        grid = cus;
    }
    if (grid < 0) return;
    if (hipMemsetAsync((char*)d_ws + WS_CTL, 0, CTL_ZERO_BYTES, stream) != hipSuccess) { fprintf(stderr, "kernel_launch: memset failed\n"); return; }
    Args a{};
    for (int i = 0; i < 19; ++i) a.in[i] = (const float*)d_in[i];
    a.out = (float*)d_out; a.ws = (unsigned char*)d_ws;
#if MK_ONE_LAUNCH
    a.ph_lo = 0; a.ph_hi = N_PHASES;
    hipLaunchKernelGGL((mk_fwd<0, N_PHASES>), dim3(grid), dim3(NWAVES * 64), LDS_BYTES, stream, a);
#else
    launch_from<0>(grid, stream, a);
#endif
    const hipError_t le = hipPeekAtLastError();
    if (le != hipSuccess) fprintf(stderr, "kernel_launch: launch failed: %s\n", hipGetErrorName(le));
}
```

```cpp
#define ATT_V1 1
#include <hip/hip_runtime.h>
#include <cstdio>
#include <cstdint>

#ifndef MK_ONE_LAUNCH
#define MK_ONE_LAUNCH 1
#endif

#define DI __device__ __forceinline__
#define LAS __attribute__((address_space(3)))
#define GAS __attribute__((address_space(1)))

namespace pg8 {
#define PG8_LAS __attribute__((address_space(3)))
typedef unsigned short bf16_t;
typedef short bf16x8 __attribute__((ext_vector_type(8)));
typedef float f32x4 __attribute__((ext_vector_type(4)));
typedef float f32x2 __attribute__((ext_vector_type(2)));
typedef unsigned u32x4 __attribute__((ext_vector_type(4)));
typedef unsigned u32x2 __attribute__((ext_vector_type(2)));
typedef int i32x8a __attribute__((ext_vector_type(8), aligned(16)));
constexpr int BM = 256, BK = 64, HALF = 128, HTB = HALF * BK * 2  , STAGE_BYTES = 8 * HTB, NXCD = 8, WGM = 8;

__host__ __device__ __forceinline__ int lds_byte(int r, int c) { const int st = (r >> 4) * 2 + (c >> 5), rr = r & 15, cc = c & 31, ob = rr * 64 + cc * 2; return st * 1024 + (ob ^ (((ob >> 9) & 1) << 5)); }
__host__ __device__ __forceinline__ void stage_rc(int b, int& R, int& C) { const int st = b / 1024, sb = b % 1024, swz = sb ^ (((sb >> 9) & 1) << 5); R = (st >> 1) * 16 + swz / 64; C = (st & 1) * 32 + (swz % 64) / 2; }
__host__ __device__ __forceinline__ int perm32(int rho) { const int n = rho >> 4, i = rho & 15; return 8 * (i >> 2) + 4 * n + (i & 3); }

struct Unit { int pm, pn; };
struct Gemm { const bf16_t* A; const bf16_t* Bt; int M, N, K, lda, ldb, agdiv, agoff; };

struct StaticOrder {
    int nM, nN, nwg, G, c; bool rev;
    __host__ __device__ void init(int M, int N, int G_, int c_) { nM = M / BM; nN = N / BM; nwg = nM * nN; G = G_; c = c_; rev = false; }
    __host__ __device__ bool next(int i, Unit& u) const {
        const long L = (long)i * G + c; if (L >= nwg) return false;
        int wgid = (int)L; { const int q = nwg / NXCD, r = nwg % NXCD, xcd = wgid % NXCD, off = wgid / NXCD; wgid = (xcd < r ? xcd * (q + 1) : r * (q + 1) + (xcd - r) * q) + off; }
        const int nig = WGM * nN, gid = wgid / nig, fm = gid * WGM, gsz = (nM - fm) < WGM ? (nM - fm) : WGM;
        u.pm = fm + ((wgid % nig) % gsz); u.pn = (wgid % nig) / gsz; if (rev) u.pm = nM - 1 - u.pm; return true;
    }
    __device__ __forceinline__ void a_ready(const Unit&) const {}
    __device__ __forceinline__ void done(const Unit&) const {}
};

struct HalfOrder : StaticOrder {
    int nall, extra; bool hi_half;
    __host__ __device__ bool next(int i, Unit& u) const {
        const int x = c % NXCD, s = c / NXCD, q = nwg / NXCD; const bool mine = ((s >= 16) == hi_half);
        int off;
        if (i < nall) off = i * 32 + s; else { if (!mine || i >= nall + extra) return false; off = nall * 32 + (i - nall) * 16 + (s & 15); }
        if (off >= q) return false;
        const int wgid = x * q + off;
        const int nig = WGM * nN, gid = wgid / nig, fm = gid * WGM, gsz = (nM - fm) < WGM ? (nM - fm) : WGM;
        u.pm = fm + ((wgid % nig) % gsz); u.pn = (wgid % nig) / gsz; return true;
    }
};
struct RangeOrder : StaticOrder {
    int i0, n;
    __host__ __device__ bool next(int i, Unit& u) const { if (i >= n) return false; return StaticOrder::next(i + i0, u); }
};
__device__ __forceinline__ unsigned cvt_pk_bf16(float lo, float hi) { unsigned r; asm volatile("v_cvt_pk_bf16_f32 %0, %1, %2" : "=v"(r) : "v"(lo), "v"(hi)); return r; }

template <int ACT> struct EpiBf16 {
    static constexpr bool PERM = true, AFTER_DRAIN = false;
    bf16_t* O; int ldc;
    __device__ __forceinline__ void operator()(const f32x4 (&acc)[2][2][4][2], const Unit& u, int wr, int wc, int fr, int fq) const {
        const int row0 = u.pm * BM + wr * 64 + fr; const int col0 = u.pn * BM + wc * 32 + 8 * fq;
#pragma unroll
        for (int ai = 0; ai < 2; ++ai)
#pragma unroll
            for (int m = 0; m < 4; ++m) { bf16_t* rowp = O + (size_t)(row0 + ai * HALF + m * 16) * ldc + col0;
#pragma unroll
                for (int bj = 0; bj < 2; ++bj) { f32x4 v0 = acc[ai][bj][m][0], v1 = acc[ai][bj][m][1];
                    if (ACT == 2) {
#pragma unroll
                        for (int j = 0; j < 4; ++j) { const float a = fmaxf(v0[j], 0.f), b = fmaxf(v1[j], 0.f); v0[j] = a * a; v1[j] = b * b; } }
                    u32x4 w; w.x = cvt_pk_bf16(v0[0], v0[1]); w.y = cvt_pk_bf16(v0[2], v0[3]); w.z = cvt_pk_bf16(v1[0], v1[1]); w.w = cvt_pk_bf16(v1[2], v1[3]);
                    *(u32x4*)(rowp + bj * HALF) = w; } }
    }
};
struct EpiNull {
    static constexpr bool PERM = true, AFTER_DRAIN = false;
    float* sink;
    __device__ __forceinline__ void operator()(const f32x4 (&acc)[2][2][4][2], const Unit& u, int wr, int wc, int fr, int fq) const {
        f32x4 s = (f32x4){0.f, 0.f, 0.f, 0.f};
#pragma unroll
        for (int ai = 0; ai < 2; ++ai)
#pragma unroll
            for (int bj = 0; bj < 2; ++bj)
#pragma unroll
                for (int m = 0; m < 4; ++m)
#pragma unroll
                    for (int n = 0; n < 2; ++n) s += acc[ai][bj][m][n];
        if (s[0] + s[1] + s[2] + s[3] == 1.2345678e33f) sink[u.pm] = s[0];
    }
};
struct EpiPtile {
    static constexpr bool PERM = true, AFTER_DRAIN = false; static constexpr int NVM = 16;
    bf16_t* O;
    __device__ __forceinline__ void operator()(const f32x4 (&acc)[2][2][4][2], const Unit& u, int wr, int wc, int fr, int fq) const {
        const int g = u.pn >> 3;
#pragma unroll
        for (int bj = 0; bj < 2; ++bj) { const int d = (u.pn & 7) * BM + bj * HALF + wc * 32 + 8 * fq;
            bf16_t* blk = O + (((size_t)(u.pm * 32 + (d >> 6)) * 4 + g) * 4 + ((d >> 4) & 3)) * (256 * 16) + (d & 15);
#pragma unroll
            for (int ai = 0; ai < 2; ++ai)
#pragma unroll
                for (int m = 0; m < 4; ++m) { const f32x4 v0 = acc[ai][bj][m][0], v1 = acc[ai][bj][m][1];
                    u32x4 w; w.x = cvt_pk_bf16(v0[0], v0[1]); w.y = cvt_pk_bf16(v0[2], v0[3]); w.z = cvt_pk_bf16(v1[0], v1[1]); w.w = cvt_pk_bf16(v1[2], v1[3]);
                    *(u32x4*)(blk + (size_t)(ai * HALF + wr * 64 + m * 16 + fr) * 16) = w; } }
    }
};
struct EpiBf16s {
    static constexpr bool PERM = true, AFTER_DRAIN = false;
    bf16_t* O; int ldc; float sd, sq; unsigned qmask;
    __device__ __forceinline__ void operator()(const f32x4 (&acc)[2][2][4][2], const Unit& u, int wr, int wc, int fr, int fq) const {
        const int row0 = u.pm * BM + wr * 64 + fr; const int col0 = u.pn * BM + wc * 32 + 8 * fq; const float sc = ((qmask >> u.pn) & 1u) ? sq : sd;
#pragma unroll
        for (int ai = 0; ai < 2; ++ai)
#pragma unroll
            for (int m = 0; m < 4; ++m) { bf16_t* rowp = O + (size_t)(row0 + ai * HALF + m * 16) * ldc + col0;
#pragma unroll
                for (int bj = 0; bj < 2; ++bj) { const f32x4 v0 = acc[ai][bj][m][0] * sc, v1 = acc[ai][bj][m][1] * sc;
                    u32x4 w; w.x = cvt_pk_bf16(v0[0], v0[1]); w.y = cvt_pk_bf16(v0[2], v0[3]); w.z = cvt_pk_bf16(v1[0], v1[1]); w.w = cvt_pk_bf16(v1[2], v1[3]);
                    *(u32x4*)(rowp + bj * HALF) = w; } }
    }
};
struct EpiBf16ik {
    static constexpr bool PERM = true, AFTER_DRAIN = false;
    bf16_t* O; int ldc; bf16_t* IK;
    __device__ __forceinline__ void operator()(const f32x4 (&acc)[2][2][4][2], const Unit& u, int wr, int wc, int fr, int fq) const {
        const int row0 = u.pm * BM + wr * 64 + fr; const int col0 = u.pn * BM + wc * 32 + 8 * fq;
        const bool ikt = (u.pn == 15) && (wc < 2);
#pragma unroll
        for (int ai = 0; ai < 2; ++ai)
#pragma unroll
            for (int m = 0; m < 4; ++m) { const int row = row0 + ai * HALF + m * 16; bf16_t* rowp = O + (size_t)row * ldc + col0;
#pragma unroll
                for (int bj = 0; bj < 2; ++bj) { const f32x4 v0 = acc[ai][bj][m][0], v1 = acc[ai][bj][m][1];
                    u32x4 w; w.x = cvt_pk_bf16(v0[0], v0[1]); w.y = cvt_pk_bf16(v0[2], v0[3]); w.z = cvt_pk_bf16(v1[0], v1[1]); w.w = cvt_pk_bf16(v1[2], v1[3]);
                    *(u32x4*)(rowp + bj * HALF) = w;
                    if (bj == 0 && ikt) *(u32x4*)(IK + ((size_t)(row >> 4) * 2 + wc) * 512 + (fq * 16 + fr) * 8) = w; } }
    }
};
struct EpiResid {
    static constexpr bool PERM = false, AFTER_DRAIN = false;
    const float* xin; float* xout; const float* gate; int gstride;
    __device__ __forceinline__ void operator()(const f32x4 (&acc)[2][2][4][2], const Unit& u, int wr, int wc, int fr, int fq) const {
        const int b = u.pm >> 3; const int col0 = u.pn * BM + wc * 32 + 4 * fq;
        f32x4 gv[2][2];
#pragma unroll
        for (int bj = 0; bj < 2; ++bj)
#pragma unroll
            for (int n = 0; n < 2; ++n) gv[bj][n] = *(const f32x4*)(gate + (size_t)b * gstride + col0 + bj * HALF + n * 16);
#pragma unroll
        for (int ai = 0; ai < 2; ++ai)
#pragma unroll
            for (int m = 0; m < 4; ++m) { const size_t off = (size_t)(u.pm * BM + ai * HALF + wr * 64 + m * 16 + fr) * 2048 + col0;
#pragma unroll
                for (int bj = 0; bj < 2; ++bj)
#pragma unroll
                    for (int n = 0; n < 2; ++n) { const f32x4 x = *(const f32x4*)(xin + off + bj * HALF + n * 16);
                        *(f32x4*)(xout + off + bj * HALF + n * 16) = x + gv[bj][n] * acc[ai][bj][m][n]; }
                if (m == 3) asm volatile("" ::: "memory"); }
    }
};
template <bool XF32> struct EpiResidB {
    static constexpr bool PERM = true, AFTER_DRAIN = false;
    const void* xin; bf16_t* xout; const float* gate; int gstride;
    __device__ __forceinline__ void operator()(const f32x4 (&acc)[2][2][4][2], const Unit& u, int wr, int wc, int fr, int fq) const {
        const int b = u.pm >> 3; const int col0 = u.pn * BM + wc * 32 + 8 * fq;
        f32x4 gv[2][2];
#pragma unroll
        for (int bj = 0; bj < 2; ++bj)
#pragma unroll
            for (int n = 0; n < 2; ++n) gv[bj][n] = *(const f32x4*)(gate + (size_t)b * gstride + col0 + bj * HALF + n * 4);
#pragma unroll
        for (int ai = 0; ai < 2; ++ai)
#pragma unroll
            for (int m = 0; m < 4; ++m) { const size_t off = (size_t)(u.pm * BM + ai * HALF + wr * 64 + m * 16 + fr) * 2048 + col0;
#pragma unroll
                for (int bj = 0; bj < 2; ++bj) { f32x4 x0, x1;
                    if (XF32) { x0 = *(const f32x4*)((const float*)xin + off + bj * HALF); x1 = *(const f32x4*)((const float*)xin + off + bj * HALF + 4); }
                    else { const u32x4 xw = *(const u32x4*)((const bf16_t*)xin + off + bj * HALF);
                        x0 = (f32x4){__uint_as_float(xw.x << 16), __uint_as_float(xw.x & 0xffff0000u), __uint_as_float(xw.y << 16), __uint_as_float(xw.y & 0xffff0000u)};
                        x1 = (f32x4){__uint_as_float(xw.z << 16), __uint_as_float(xw.z & 0xffff0000u), __uint_as_float(xw.w << 16), __uint_as_float(xw.w & 0xffff0000u)}; }
                    const f32x4 y0 = x0 + gv[bj][0] * acc[ai][bj][m][0], y1 = x1 + gv[bj][1] * acc[ai][bj][m][1];
                    u32x4 w; w.x = cvt_pk_bf16(y0[0], y0[1]); w.y = cvt_pk_bf16(y0[2], y0[3]); w.z = cvt_pk_bf16(y1[0], y1[1]); w.w = cvt_pk_bf16(y1[2], y1[3]);
                    *(u32x4*)(xout + off + bj * HALF) = w; }
                if (m == 3) asm volatile("" ::: "memory"); }
    }
};
struct EpiGate {
    static constexpr bool PERM = false, AFTER_DRAIN = false;
    const bf16_t* P; const float* bgate; bf16_t* O; float ascale;
    __device__ __forceinline__ void operator()(const f32x4 (&acc)[2][2][4][2], const Unit& u, int wr, int wc, int fr, int fq) const {
        const int d0 = u.pn * 64 + wc * 16 + 4 * fq;
        f32x4 bv[2][2];
#pragma unroll
        for (int bj = 0; bj < 2; ++bj)
#pragma unroll
            for (int n = 0; n < 2; ++n) bv[bj][n] = *(const f32x4*)(bgate + (2 * bj + n) * 2048 + d0);
#pragma unroll
        for (int ai = 0; ai < 2; ++ai)
#pragma unroll
            for (int m = 0; m < 4; ++m) { const size_t row = (size_t)(u.pm * BM + ai * HALF + wr * 64 + m * 16 + fr);
                f32x4 s = (f32x4){0.f, 0.f, 0.f, 0.f};
#pragma unroll
                for (int bj = 0; bj < 2; ++bj)
#pragma unroll
                    for (int n = 0; n < 2; ++n) { const u32x2 pw = *(const u32x2*)(P + ((((size_t)(u.pm * 32 + u.pn) * 4 + (2 * bj + n)) * 4 + wc) * 256 + (ai * HALF + wr * 64 + m * 16 + fr)) * 16 + 4 * fq);
                        const f32x4 pv = (f32x4){__uint_as_float(pw.x << 16), __uint_as_float(pw.x & 0xffff0000u), __uint_as_float(pw.y << 16), __uint_as_float(pw.y & 0xffff0000u)};
                        const f32x4 x = acc[ai][bj][m][n] * ascale + bv[bj][n];
#pragma unroll
                        for (int j = 0; j < 4; ++j) { const float sg = __builtin_amdgcn_rcpf(1.f + __builtin_amdgcn_exp2f(-1.4426950408889634f * x[j])); s[j] += sg * pv[j]; } }
                u32x2 w; w.x = cvt_pk_bf16(s[0], s[1]); w.y = cvt_pk_bf16(s[2], s[3]);
                *(u32x2*)(O + row * 2048 + d0) = w;
                if (m & 1) asm volatile("" ::: "memory"); }
    }
};

template <class Epi, class Sched, bool ALIGN_EPI = false, bool SP2 = false, bool FP8 = false>
__device__ __forceinline__ void gemm_phase(PG8_LAS unsigned char* lds, const Gemm g, const Sched& S, const Epi& E) {
    int tid_l = threadIdx.x; asm volatile("" : "+v"(tid_l));
    const int tid = tid_l, wid = __builtin_amdgcn_readfirstlane(tid >> 6), lane = tid & 63, wr = wid >> 2, wc = wid & 3, fr = lane & 15, fq = lane >> 4;
    const int K = g.K, nt = K / BK;
    unsigned voffA[2], voffB[2];
#pragma unroll
    for (int i = 0; i < 2; ++i) { int R, C; stage_rc(tid * 16 + i * 8192, R, C); const int Rb = Epi::PERM ? ((R & ~31) + perm32(R & 31)) : R;
        voffA[i] = (unsigned)(R * g.lda + C) * 2u; voffB[i] = (unsigned)(Rb * g.ldb + C) * 2u; }
    const size_t kstep = (size_t)(BK * 2);
    const size_t hstepA = (size_t)HALF * g.lda * 2, hstepB = (size_t)HALF * g.ldb * 2;
    const size_t tstepA = 2 * hstepA, tstepB = 2 * hstepB;
    const unsigned ldsw = (unsigned)wid * 1024u;
    const int aoff = FP8 ? lds_byte(wr * 64 + fr, fq * 16) : lds_byte(wr * 64 + fr, fq * 8), boff = FP8 ? lds_byte(wc * 32 + fr, fq * 16) : lds_byte(wc * 32 + fr, fq * 8);
#define PG8_SA(b, h) (((b) * 2 + (h)) * HTB)
#define PG8_SB(b, h) ((4 + (b) * 2 + (h)) * HTB)
#define PG8_STAGE(bufoff, gbase, voff) do { _Pragma("unroll") for (int _i = 0; _i < 2; ++_i) \
        __builtin_amdgcn_global_load_lds((const unsigned*)((const char*)(gbase) + (voff)[_i]), (PG8_LAS unsigned*)(lds + (bufoff) + ldsw + _i * 8192), 16, 0, 0); } while (0)
#define PG8_LDA(dst, b, h) do { if constexpr (FP8) { _Pragma("unroll") for (int m = 0; m < 4; ++m) dst##8[m] = *(const PG8_LAS i32x8a*)(lds + PG8_SA(b, h) + aoff + m * 2048); } \
        else { _Pragma("unroll") for (int m = 0; m < 4; ++m) _Pragma("unroll") for (int k = 0; k < 2; ++k) dst[m][k] = *(const PG8_LAS bf16x8*)(lds + PG8_SA(b, h) + aoff + m * 2048 + k * 1024); } } while (0)
#define PG8_LDB(dst, b, h) do { if constexpr (FP8) { _Pragma("unroll") for (int n = 0; n < 2; ++n) dst##8[n] = *(const PG8_LAS i32x8a*)(lds + PG8_SB(b, h) + boff + n * 2048); } \
        else { _Pragma("unroll") for (int n = 0; n < 2; ++n) _Pragma("unroll") for (int k = 0; k < 2; ++k) dst[n][k] = *(const PG8_LAS bf16x8*)(lds + PG8_SB(b, h) + boff + n * 2048 + k * 1024); } } while (0)
#define PG8_MMA(ai, bj, At, Bt) do { __builtin_amdgcn_s_setprio(1); \
        if constexpr (FP8) { _Pragma("unroll") for (int m = 0; m < 4; ++m) _Pragma("unroll") for (int n = 0; n < 2; ++n) \
            asm volatile("v_mfma_scale_f32_16x16x128_f8f6f4 %0, %1, %2, %0, %3, %3 op_sel_hi:[0,0,0]" : "+v"(acc[ai][bj][m][n]) : "v"(Bt##8[n]), "v"(At##8[m]), "v"(sc1)); } \
        else { _Pragma("unroll") for (int m = 0; m < 4; ++m) _Pragma("unroll") for (int n = 0; n < 2; ++n) _Pragma("unroll") for (int k = 0; k < 2; ++k) \
            acc[ai][bj][m][n] = __builtin_amdgcn_mfma_f32_16x16x32_bf16(Bt[n][k], At[m][k], acc[ai][bj][m][n], 0, 0, 0); } \
        __builtin_amdgcn_s_setprio(0); } while (0)
#define PG8_WAIT_V(n) asm volatile("s_waitcnt vmcnt(" #n ")" ::: "memory")
#define PG8_WAIT_L(n) asm volatile("s_waitcnt lgkmcnt(" #n ")" ::: "memory")
#define PG8_BAR __builtin_amdgcn_s_barrier()
#define PG8_SCHED __builtin_amdgcn_sched_barrier(0)
    Unit cur, nxt; int ui = 0;
    if (!S.next(0, cur)) return;
    f32x4 acc[2][2][4][2];
#pragma unroll
    for (int a = 0; a < 2; ++a)
#pragma unroll
        for (int b = 0; b < 2; ++b)
#pragma unroll
            for (int m = 0; m < 4; ++m)
#pragma unroll
                for (int n = 0; n < 2; ++n) acc[a][b][m][n] = (f32x4){0.f, 0.f, 0.f, 0.f};
    bf16x8 At[4][2], B0[2][2], B1[2][2];
    i32x8a At8[4], B08[2], B18[2];
    int sc1 = 0x7F7F7F7F; asm volatile("" : "+v"(sc1));
    const char* cA = (const char*)g.A + (size_t)cur.pm * tstepA + (size_t)(cur.pn / g.agdiv) * (size_t)g.agoff * 2; const char* cB = (const char*)g.Bt + (size_t)cur.pn * tstepB;
    S.a_ready(cur);
    if constexpr (SP2) {
        PG8_STAGE(PG8_SB(0, 0), cB, voffB); PG8_STAGE(PG8_SB(0, 1), cB + hstepB, voffB); PG8_STAGE(PG8_SA(0, 0), cA, voffA); PG8_STAGE(PG8_SA(0, 1), cA + hstepA, voffA);
        if (wr == 1) PG8_BAR;
        PG8_WAIT_V(2); PG8_BAR;
        PG8_STAGE(PG8_SB(1, 0), cB + kstep, voffB); PG8_STAGE(PG8_SA(1, 0), cA + kstep, voffA); PG8_STAGE(PG8_SB(1, 1), cB + hstepB + kstep, voffB);
        PG8_WAIT_V(6); PG8_BAR;
    } else {
        PG8_STAGE(PG8_SB(0, 0), cB, voffB); PG8_STAGE(PG8_SA(0, 0), cA, voffA); PG8_STAGE(PG8_SB(0, 1), cB + hstepB, voffB); PG8_STAGE(PG8_SA(0, 1), cA + hstepA, voffA);
        if (wr == 1) PG8_BAR;
        PG8_WAIT_V(4); PG8_BAR;
        PG8_STAGE(PG8_SB(1, 0), cB + kstep, voffB); PG8_STAGE(PG8_SA(1, 0), cA + kstep, voffA); PG8_STAGE(PG8_SB(1, 1), cB + hstepB + kstep, voffB);
        PG8_WAIT_V(6); PG8_BAR;
    }
    for (;;) {
        const bool has_next = S.next(ui + 1, nxt);
        const char* nA = has_next ? (const char*)g.A + (size_t)nxt.pm * tstepA + (size_t)(nxt.pn / g.agdiv) * (size_t)g.agoff * 2 : cA; const char* nB = has_next ? (const char*)g.Bt + (size_t)nxt.pn * tstepB : cB;
        for (int t = 0; t < nt; t += 2) {
            const bool last = (t == nt - 2);
            const char* a1 = cA + (size_t)(t + 1) * kstep;
            const char* a2 = last ? nA : cA + (size_t)(t + 2) * kstep; const char* b2 = last ? nB : cB + (size_t)(t + 2) * kstep;
            const char* a3 = a2 + kstep; const char* b3 = b2 + kstep;
            if (last && has_next) S.a_ready(nxt);
            if constexpr (SP2) {
            PG8_LDB(B0, 0, 0); PG8_LDB(B1, 0, 1); PG8_SCHED; PG8_LDA(At, 0, 0); PG8_STAGE(PG8_SA(1, 1), a1 + hstepA, voffA);
            PG8_WAIT_V(8); PG8_WAIT_L(0); PG8_BAR; PG8_MMA(0, 0, At, B0); PG8_MMA(0, 1, At, B1); PG8_BAR; PG8_SCHED;
            PG8_LDA(At, 0, 1); PG8_STAGE(PG8_SB(0, 0), b2, voffB); PG8_STAGE(PG8_SB(0, 1), b2 + hstepB, voffB); PG8_STAGE(PG8_SA(0, 0), a2, voffA);
            PG8_WAIT_V(8); PG8_WAIT_L(0); PG8_BAR; PG8_MMA(1, 0, At, B0); PG8_MMA(1, 1, At, B1); PG8_BAR; PG8_SCHED;
            PG8_LDB(B0, 1, 0); PG8_LDB(B1, 1, 1); PG8_SCHED; PG8_LDA(At, 1, 0); PG8_STAGE(PG8_SA(0, 1), a2 + hstepA, voffA);
            PG8_WAIT_V(8); PG8_WAIT_L(0); PG8_BAR; PG8_MMA(0, 0, At, B0); PG8_MMA(0, 1, At, B1); PG8_BAR; PG8_SCHED;
            PG8_LDA(At, 1, 1); PG8_STAGE(PG8_SB(1, 0), b3, voffB); PG8_STAGE(PG8_SB(1, 1), b3 + hstepB, voffB); PG8_STAGE(PG8_SA(1, 0), a3, voffA);
            PG8_WAIT_V(8); PG8_WAIT_L(0); PG8_BAR; PG8_MMA(1, 0, At, B0); PG8_MMA(1, 1, At, B1); PG8_BAR; PG8_SCHED;
            } else {
            PG8_LDB(B0, 0, 0); PG8_SCHED; PG8_LDA(At, 0, 0); PG8_STAGE(PG8_SA(1, 1), a1 + hstepA, voffA);
            PG8_WAIT_L(8); PG8_BAR; PG8_WAIT_L(0); PG8_MMA(0, 0, At, B0); PG8_BAR; PG8_SCHED;
            PG8_LDB(B1, 0, 1); PG8_STAGE(PG8_SB(0, 0), b2, voffB);
            PG8_BAR; PG8_WAIT_L(0); PG8_MMA(0, 1, At, B1); PG8_BAR;
            PG8_LDA(At, 0, 1); PG8_STAGE(PG8_SA(0, 0), a2, voffA);
            PG8_BAR; PG8_WAIT_L(0); PG8_MMA(1, 0, At, B0); PG8_BAR; PG8_SCHED;
            PG8_STAGE(PG8_SB(0, 1), b2 + hstepB, voffB);
            PG8_WAIT_V(6); PG8_BAR; PG8_MMA(1, 1, At, B1); PG8_BAR;
            PG8_LDB(B0, 1, 0); PG8_SCHED; PG8_LDA(At, 1, 0); PG8_STAGE(PG8_SA(0, 1), a2 + hstepA, voffA);
            PG8_WAIT_L(8); PG8_BAR; PG8_WAIT_L(0); PG8_MMA(0, 0, At, B0); PG8_BAR; PG8_SCHED;
            PG8_LDB(B1, 1, 1); PG8_STAGE(PG8_SB(1, 0), b3, voffB);
            PG8_BAR; PG8_WAIT_L(0); PG8_MMA(0, 1, At, B1); PG8_BAR;
            PG8_LDA(At, 1, 1); PG8_STAGE(PG8_SA(1, 0), a3, voffA);
            PG8_BAR; PG8_WAIT_L(0); PG8_MMA(1, 0, At, B0); PG8_BAR; PG8_SCHED;
            PG8_STAGE(PG8_SB(1, 1), b3 + hstepB, voffB);
            PG8_WAIT_V(6); PG8_BAR; PG8_MMA(1, 1, At, B1); PG8_BAR;
            }
        }
        if constexpr (ALIGN_EPI) { if (wr == 0) PG8_BAR; }
        if constexpr (FP8) asm volatile("s_nop 15\n\ts_nop 7" ::: "memory");
        if constexpr (!Epi::AFTER_DRAIN) { E(acc, cur, wr, wc, fr, fq); S.done(cur); }
        if (!has_next) break;
#pragma unroll
        for (int a = 0; a < 2; ++a)
#pragma unroll
            for (int b = 0; b < 2; ++b)
#pragma unroll
                for (int m = 0; m < 4; ++m)
#pragma unroll
                    for (int n = 0; n < 2; ++n) acc[a][b][m][n] = (f32x4){0.f, 0.f, 0.f, 0.f};
        cur = nxt; cA = nA; cB = nB; ++ui;
        if constexpr (ALIGN_EPI) { if (wr == 1) PG8_BAR; }
    }
    PG8_WAIT_V(0);
    if constexpr (!ALIGN_EPI) { if (wr == 0) PG8_BAR; }
    PG8_BAR;
    if constexpr (Epi::AFTER_DRAIN) { E.fused(acc, cur, wr, wc, fr, fq, lds, wid, lane); S.done(cur); }
#undef PG8_SA
#undef PG8_SB
#undef PG8_STAGE
#undef PG8_LDA
#undef PG8_LDB
#undef PG8_MMA
#undef PG8_WAIT_V
#undef PG8_WAIT_L
#undef PG8_BAR
#undef PG8_SCHED
}
}

constexpr int NB = 8, SEQ = 2048, DM = 2048, M_TOK = NB * SEQ, DFF = 8192, NLAYER = 2;
constexpr int LDQ = 6656;
constexpr int C_QB = 0, C_KB = 512, C_VB = 1024, C_VD = 1536, C_BG = 2048, C_CG = 2560, C_XIN = 3072, C_IQ = 3584, C_IK = 3840, C_IW = 3904, C_FD = 3908,
              C_QA = 4096, C_KA = 4608, C_VA = 5120, C_QD = 5632, C_KD = 6144;
constexpr int N_IN16 = 4096, N_IN8 = LDQ - N_IN16;
constexpr float LOG2E = 1.4426950408889634f;
constexpr float IDX_SCALE = 0.0625f;
constexpr float RMS_EPS = 1e-6f;

typedef unsigned short bf16_t;
typedef short bf16x8 __attribute__((ext_vector_type(8)));
typedef short s16x4 __attribute__((ext_vector_type(4)));
typedef float f32x16 __attribute__((ext_vector_type(16)));
typedef float f32x8 __attribute__((ext_vector_type(8)));
typedef float f32x4 __attribute__((ext_vector_type(4)));
typedef float f32x2 __attribute__((ext_vector_type(2)));
typedef unsigned u32x4 __attribute__((ext_vector_type(4)));
typedef unsigned u32x2 __attribute__((ext_vector_type(2)));

DI float bf2f(bf16_t v) { return __uint_as_float((unsigned)v << 16); }
DI unsigned cvtpk(float lo, float hi) { unsigned r; asm volatile("v_cvt_pk_bf16_f32 %0, %1, %2" : "=v"(r) : "v"(lo), "v"(hi)); return r; }
DI float wave_sum(float v) {
#pragma unroll
    for (int o = 1; o < 64; o <<= 1) v += __shfl_xor(v, o);
    return v;
}

namespace att {
constexpr int SHM_V = 16384, SHM_K = 16384;
constexpr int OFF_V = 0, OFF_K = 2 * SHM_V, OFF_WS = OFF_K + 2 * SHM_K, OFF_TAB = OFF_WS + 8 * 64 * 4, OFF_FK = OFF_TAB + 512, OFF_KN = OFF_FK + 8192, LDS_END = OFF_KN + 128;
#define KSWZ(row, colB) ((row) * 256 + ((colB) ^ (((row) & 7) << 4)))
#define SBAR() __builtin_amdgcn_sched_barrier(0)
DI int v_st(int k, int c) { const int kk = (k & ~0xC) | ((k & 4) << 1) | ((k & 8) >> 1); return ((kk >> 3) * 4 + (c >> 5)) * 512 + ((kk & 7) * 32 + (c & 31)) * 2; }
DI int v_rd_base(int lane) { return ((lane & 3) << 3) | (((lane >> 2) & 3) << 6) | (((lane >> 4) & 1) << 5) | (((lane >> 5) & 1) << 8); }
constexpr int v_rd_off(int d0, int ks, int half) { return d0 * 512 + ks * 4096 + half * 2048; }
DI int crow(int r, int hi) { return (r & 3) + 8 * (r >> 2) + 4 * hi; }

template <int KB, int D0LO, int D0HI>
DI void qkt(f32x16& p0, f32x16& p1, LAS const char* K_lds, int r32, int hi, const bf16x8* qr) {
#pragma unroll
    for (int r = 0; r < 16; ++r) { p0[r] = 0.f; p1[r] = 0.f; }
    LAS const char* kb[4];
#pragma unroll
    for (int dd = 0; dd < 4; ++dd) kb[dd] = K_lds + KB * SHM_K + KSWZ(r32, (dd * 16 + hi * 8) * 2);
#pragma unroll
    for (int d0 = D0LO; d0 < D0HI; ++d0) { LAS const char* a = kb[d0 & 3] + (d0 >> 2) * 128;
        const bf16x8 b0 = *(LAS const bf16x8*)a;
        const bf16x8 b1 = *(LAS const bf16x8*)(a + 32 * 256);
        p0 = __builtin_amdgcn_mfma_f32_32x32x16_bf16(b0, qr[d0 - D0LO], p0, 0, 0, 0);
        p1 = __builtin_amdgcn_mfma_f32_32x32x16_bf16(b1, qr[d0 - D0LO], p1, 0, 0, 0); }
}
template <int VB>
DI void pv_tile(f32x16* o, int vb0, bf16x8 pa0, bf16x8 pa1, bf16x8 pa2, bf16x8 pa3) {
#define TRRD(dst, off) asm volatile("ds_read_b64_tr_b16 %0, %1 offset:%2" : "=&v"(dst) : "v"(vb0), "i"(off) : "memory")
#define PV_D0(d0) do { s16x4 l0, l1, l2, l3, h0, h1, h2, h3; constexpr int b_ = VB * SHM_V + v_rd_off(d0, 0, 0);     \
        TRRD(l0, b_); TRRD(h0, b_ + 2048); TRRD(l1, b_ + 4096); TRRD(h1, b_ + 6144); TRRD(l2, b_ + 8192); TRRD(h2, b_ + 10240); TRRD(l3, b_ + 12288); TRRD(h3, b_ + 14336); \
        asm volatile("s_waitcnt lgkmcnt(0)" ::: "memory"); SBAR();   \
        o[d0] = __builtin_amdgcn_mfma_f32_32x32x16_bf16(pa0, (bf16x8){l0[0], l0[1], l0[2], l0[3], h0[0], h0[1], h0[2], h0[3]}, o[d0], 0, 0, 0);   \
        o[d0] = __builtin_amdgcn_mfma_f32_32x32x16_bf16(pa1, (bf16x8){l1[0], l1[1], l1[2], l1[3], h1[0], h1[1], h1[2], h1[3]}, o[d0], 0, 0, 0);   \
        o[d0] = __builtin_amdgcn_mfma_f32_32x32x16_bf16(pa2, (bf16x8){l2[0], l2[1], l2[2], l2[3], h2[0], h2[1], h2[2], h2[3]}, o[d0], 0, 0, 0);   \
        o[d0] = __builtin_amdgcn_mfma_f32_32x32x16_bf16(pa3, (bf16x8){l3[0], l3[1], l3[2], l3[3], h3[0], h3[1], h3[2], h3[3]}, o[d0], 0, 0, 0); } while (0)
    PV_D0(0); PV_D0(1); PV_D0(2); PV_D0(3);
#undef PV_D0
#undef TRRD
}
DI int t5_bucket(int n) {
    if (n < 16) return n;
    int b = 16;
    b += (n >= 19); b += (n >= 21); b += (n >= 24); b += (n >= 27); b += (n >= 31); b += (n >= 35); b += (n >= 40); b += (n >= 46);
    b += (n >= 52); b += (n >= 59); b += (n >= 67); b += (n >= 77); b += (n >= 87); b += (n >= 99); b += (n >= 113);
    return b;
}

DI float row16_sum(float x) {
    x += __int_as_float(__builtin_amdgcn_update_dpp(0, __float_as_int(x), 0xB1, 0xF, 0xF, true));
    x += __int_as_float(__builtin_amdgcn_update_dpp(0, __float_as_int(x), 0x4E, 0xF, 0xF, true));
    x += __int_as_float(__builtin_amdgcn_update_dpp(0, __float_as_int(x), 0x141, 0xF, 0xF, true));
    x += __int_as_float(__builtin_amdgcn_update_dpp(0, __float_as_int(x), 0x140, 0xF, 0xF, true));
    return x;
}
struct UnitArgs {
    const bf16_t* Qp; const bf16_t* Kp; const bf16_t* Vp; bf16_t* Op; int q0;
    const unsigned long long* maskp;
    const float* fcum;
    const float* relb; int relcol;
    float lam, post;
    const float* gsub;
    float* stash;
    int variant;
};

template <int MODE>
DI void attn_unit(LAS char* lds, const UnitArgs& A) {
    int tid_l = threadIdx.x; asm volatile("" : "+v"(tid_l));
    const int tid = tid_l, wid = __builtin_amdgcn_readfirstlane(tid >> 6), lane = tid & 63, r32 = lane & 31, hi = lane >> 5;
    const int q0 = A.q0, NT = (q0 + 256) / 64;
    LAS char* V_lds = lds + OFF_V; LAS char* K_lds = lds + OFF_K;
    LAS float* wsf = (LAS float*)(lds + OFF_WS) + wid * 64; LAS float* li_l = wsf; LAS float* al_l = wsf + 32;
    LAS float* tab = (LAS float*)(lds + OFF_TAB); LAS float* fk = (LAS float*)(lds + OFF_FK);
    const int qlo = q0 + wid * 32, qpos = qlo + r32;
    const int sr = tid >> 4, sc = (tid & 15) * 8;
    const int vst0 = v_st(sr, sc), vst1 = v_st(32 + sr, sc), kws = KSWZ(sr, sc * 2);
    const int vb0 = (int)(unsigned)(uintptr_t)V_lds + v_rd_base(lane);
    if (MODE == 0 || MODE == 1) { if (tid < 128) { const int bk = t5_bucket(tid); tab[tid] = (A.relb[bk * 8 + A.relcol] - A.relb[31 * 8 + A.relcol]) * LOG2E; } }
    float fqv = 0.f;
    if (MODE == 2) { for (int i = tid; i < q0 + 256; i += 512) fk[i] = A.fcum[i]; fqv = A.fcum[qpos]; }
    LAS unsigned* kn2 = (LAS unsigned*)(lds + OFF_KN);
    float qn = 0.f, sqq = 0.f;
    if (MODE == 2) { if (tid < 32) kn2[tid] = 0u; __syncthreads(); }
    constexpr int NPASS = (MODE == 1) ? 2 : 1, NQ = (MODE == 1) ? 4 : 8;
#pragma unroll 1
    for (int pass = 0; pass < NPASS; ++pass) {
        bf16x8 qr[NQ];
#pragma unroll
        for (int d = 0; d < NQ; ++d) qr[d] = *(const bf16x8*)(A.Qp + (size_t)(qpos) * LDQ + (MODE == 1 ? pass * 64 : 0) + d * 16 + hi * 8);
        if (MODE == 2) { float s2 = 0.f, sd = 0.f;
#pragma unroll
            for (int d = 0; d < NQ; ++d) { const bf16x8 kk = *(const bf16x8*)(A.Kp + (size_t)(qpos) * LDQ + d * 16 + hi * 8);
#pragma unroll
                for (int j = 0; j < 8; ++j) { const float qf = bf2f((bf16_t)qr[d][j]), kf = bf2f((bf16_t)kk[j]); s2 += qf * qf; sd += qf * kf; } }
            s2 += __shfl_xor(s2, 32); sd += __shfl_xor(sd, 32);
            qn = sqrtf(s2) * 1.001f; sqq = sd - 0.05f; }
        bf16x8 st_k0, st_k1, st_v0, st_v1;
#define KNORM(tix) do { if (MODE == 2) { float n0_ = 0.f, n1_ = 0.f; \
            _Pragma("unroll") for (int j = 0; j < 8; ++j) { const float a_ = bf2f((bf16_t)st_k0[j]), b_ = bf2f((bf16_t)st_k1[j]); n0_ += a_ * a_; n1_ += b_ * b_; } \
            n0_ = row16_sum(n0_); n1_ = row16_sum(n1_); \
            if ((tid & 15) == 0) (void)__hip_atomic_fetch_max(kn2 + (tix), __float_as_uint(fmaxf(n0_, n1_)), __ATOMIC_RELAXED, __HIP_MEMORY_SCOPE_WORKGROUP); } } while (0)
#define SLOAD(k0_) do { const int k0 = (A.variant == 1) ? 0 : (k0_); st_v0 = *(const bf16x8*)(A.Vp + (size_t)((k0) + sr) * LDQ + sc); st_v1 = *(const bf16x8*)(A.Vp + (size_t)((k0) + 32 + sr) * LDQ + sc); \
                       st_k0 = *(const bf16x8*)(A.Kp + (size_t)((k0) + sr) * LDQ + sc); st_k1 = *(const bf16x8*)(A.Kp + (size_t)((k0) + 32 + sr) * LDQ + sc); } while (0)
#define SWRITE(bf) do { *(LAS bf16x8*)(V_lds + (bf) * SHM_V + vst0) = st_v0; *(LAS bf16x8*)(V_lds + (bf) * SHM_V + vst1) = st_v1; \
                        *(LAS bf16x8*)(K_lds + (bf) * SHM_K + kws) = st_k0; *(LAS bf16x8*)(K_lds + (bf) * SHM_K + kws + 32 * 256) = st_k1; } while (0)
        SLOAD(0); SWRITE(0); KNORM(0);
        __syncthreads();
        float m_reg = -1e30f, l_reg = 0.f; f32x16 o[4];
#pragma unroll
        for (int d = 0; d < 4; ++d)
#pragma unroll
            for (int r = 0; r < 16; ++r) o[d][r] = 0.f;
        f32x16 p0, p1; bf16x8 pa0, pa1, pa2, pa3;
        unsigned long long mw_next = 0ull; if (MODE == 0) mw_next = A.maskp[(size_t)qpos * 32];
#define STEP(t, KB) do { const int t_ = (t); const bool more_ = (t_ + 1 < NT); const int kbase = t_ * 64; \
        const unsigned long long mw_ = mw_next; if (MODE == 0) { if (more_) mw_next = A.maskp[(size_t)qpos * 32 + t_ + 1]; } \
        if (more_) SLOAD(kbase + 64); \
        bool far_ = false; if (MODE == 2) { const float kn_ = sqrtf(__uint_as_float(kn2[t_])) * 1.001f; far_ = __all(qn * kn_ + (fqv - fk[kbase + 63]) - sqq < -100.f); } \
        if (kbase <= qlo + 31 && !far_) {        \
        if (A.variant == 4) { _Pragma("unroll") for (int r = 0; r < 16; ++r) { p0[r] = 0.f; p1[r] = 0.f; } } else { \
        if (MODE == 1) { if (pass == 0) qkt<KB, 0, 4>(p0, p1, K_lds, r32, hi, qr); else qkt<KB, 4, 8>(p0, p1, K_lds, r32, hi, qr); } \
        else qkt<KB, 0, 8>(p0, p1, K_lds, r32, hi, qr); } \
        if (A.variant != 2) { \
        if (MODE == 0 || MODE == 1) { if (kbase + 63 + 113 > qlo) { const int dq_ = qpos - kbase - 4 * hi; \
            _Pragma("unroll") for (int r = 0; r < 16; ++r) { const int c_ = (r & 3) + 8 * (r >> 2); int i0 = dq_ - c_, i1 = dq_ - c_ - 32; \
                i0 = i0 < 0 ? 0 : (i0 > 127 ? 127 : i0); i1 = i1 < 0 ? 0 : (i1 > 127 ? 127 : i1); p0[r] += tab[i0]; p1[r] += tab[i1]; } } } \
        if (MODE == 2) { _Pragma("unroll") for (int g = 0; g < 4; ++g) { const f32x4 f0 = *(LAS const f32x4*)(fk + kbase + 8 * g + 4 * hi), f1 = *(LAS const f32x4*)(fk + kbase + 32 + 8 * g + 4 * hi); \
                _Pragma("unroll") for (int j = 0; j < 4; ++j) { p0[4 * g + j] += fqv - f0[j]; p1[4 * g + j] += fqv - f1[j]; } } } \
        if (kbase + 63 > qlo) { const int dq_ = qpos - kbase - 4 * hi; const float NEG_ = -__builtin_inff(); \
            _Pragma("unroll") for (int r = 0; r < 16; ++r) { const int c_ = (r & 3) + 8 * (r >> 2); if (dq_ - c_ < 0) p0[r] = NEG_; if (dq_ - c_ - 32 < 0) p1[r] = NEG_; } } \
        if (MODE == 0) { const int wl_ = (int)((unsigned)mw_ >> (4 * hi)), wh_ = (int)((unsigned)(mw_ >> 32) >> (4 * hi)); \
            _Pragma("unroll") for (int r = 0; r < 16; ++r) { const int c_ = (r & 3) + 8 * (r >> 2); \
                const unsigned m0_ = (unsigned)__builtin_amdgcn_sbfe(wl_, c_, 1), m1_ = (unsigned)__builtin_amdgcn_sbfe(wh_, c_, 1);     \
                p0[r] = __uint_as_float((__float_as_uint(p0[r]) & m0_) | (0xff800000u & ~m0_)); p1[r] = __uint_as_float((__float_as_uint(p1[r]) & m1_) | (0xff800000u & ~m1_)); } } \
        } \
        float pmax_ = p0[0]; _Pragma("unroll") for (int r = 1; r < 16; ++r) pmax_ = fmaxf(pmax_, p0[r]); _Pragma("unroll") for (int r = 0; r < 16; ++r) pmax_ = fmaxf(pmax_, p1[r]); \
        { auto rr = __builtin_amdgcn_permlane32_swap(__float_as_uint(pmax_), __float_as_uint(pmax_), false, false); pmax_ = fmaxf(__uint_as_float(rr[0]), __uint_as_float(rr[1])); } \
        float mn_ = m_reg, alpha_ = 1.f; \
        if (!__all(pmax_ - m_reg <= 8.f)) { mn_ = fmaxf(m_reg, pmax_); alpha_ = __builtin_amdgcn_exp2f(m_reg - mn_); m_reg = mn_; } \
        p0 = p0 - mn_; p1 = p1 - mn_;                        \
        _Pragma("unroll") for (int r = 0; r < 16; ++r) p0[r] = __builtin_amdgcn_exp2f(p0[r]); \
        _Pragma("unroll") for (int r = 0; r < 16; ++r) p1[r] = __builtin_amdgcn_exp2f(p1[r]); \
        float ps_; { const f32x16 s16_ = p0 + p1; const f32x8 s8_ = s16_.lo + s16_.hi; const f32x4 s4_ = s8_.lo + s8_.hi; ps_ = (s4_[0] + s4_[1]) + (s4_[2] + s4_[3]); } \
        { auto rr = __builtin_amdgcn_permlane32_swap(__float_as_uint(ps_), __float_as_uint(ps_), false, false); ps_ = __uint_as_float(rr[0]) + __uint_as_float(rr[1]); } \
        l_reg = l_reg * alpha_ + ps_; \
        PK4(p0, 0, pa0); PK4(p0, 8, pa1); PK4(p1, 0, pa2); PK4(p1, 8, pa3); \
        if (__any(alpha_ < 1.f)) { if (hi == 0) al_l[r32] = alpha_; asm volatile("s_waitcnt lgkmcnt(0)" ::: "memory"); \
            _Pragma("unroll") for (int d_ = 0; d_ < 4; ++d_) _Pragma("unroll") for (int r = 0; r < 16; ++r) o[d_][r] *= al_l[crow(r, hi)]; } \
        SBAR(); if (A.variant != 3) pv_tile<KB>(o, vb0, pa0, pa1, pa2, pa3); } \
        if (A.variant != 5) { if (more_) { asm volatile("s_waitcnt vmcnt(0)" ::: "memory"); SWRITE((KB) ^ 1); KNORM(t_ + 1); } \
        __syncthreads(); } } while (0)
#define PK4(P, B_, OUT) do { unsigned a0 = cvtpk(P[B_+0], P[B_+1]), a1 = cvtpk(P[B_+2], P[B_+3]);                          \
        unsigned b0 = cvtpk(P[B_+4], P[B_+5]), b1 = cvtpk(P[B_+6], P[B_+7]);                                             \
        auto r0 = __builtin_amdgcn_permlane32_swap(a0, b0, false, false); auto r1 = __builtin_amdgcn_permlane32_swap(a1, b1, false, false); \
        u32x4 w = {r0[0], r1[0], r0[1], r1[1]}; OUT = __builtin_bit_cast(bf16x8, w); } while (0)
#pragma unroll 1
        for (int t = 0; t < NT; t += 2) { STEP(t, 0); STEP(t + 1, 1); }
#undef STEP
#undef PK4
#undef SLOAD
#undef SWRITE
#undef KNORM
        if (hi == 0) li_l[r32] = l_reg; asm volatile("s_waitcnt lgkmcnt(0)" ::: "memory");
        float rli[16];
#pragma unroll
        for (int r = 0; r < 16; ++r) rli[r] = __builtin_amdgcn_rcpf(li_l[crow(r, hi)]);
        bf16_t* Ow = A.Op + (size_t)(qlo) * 2048; asm volatile("" : "+v"(Ow));
        if (MODE != 1) {
#pragma unroll
            for (int r = 0; r < 16; ++r) { const int orow = crow(r, hi);
#pragma unroll
                for (int d0 = 0; d0 < 4; ++d0) { const float v = o[d0][r] * rli[r]; const float vn = __shfl_xor(v, 1);
                    if ((r32 & 1) == 0) *(unsigned*)(Ow + (size_t)orow * 2048 + d0 * 32 + r32) = cvtpk(v, vn); } }
        } else if (pass == 0) {
#pragma unroll
            for (int d0 = 0; d0 < 4; ++d0)
#pragma unroll
                for (int r = 0; r < 16; r += 4) *(f32x4*)(A.stash + tid * 64 + d0 * 16 + r) = (f32x4){o[d0][r] * rli[r], o[d0][r + 1] * rli[r + 1], o[d0][r + 2] * rli[r + 2], o[d0][r + 3] * rli[r + 3]};
        } else {
            float ss[16];
#pragma unroll
            for (int d0 = 0; d0 < 4; ++d0)
#pragma unroll
                for (int r = 0; r < 16; r += 4) { const f32x4 sv = *(const f32x4*)(A.stash + tid * 64 + d0 * 16 + r);
#pragma unroll
                    for (int j = 0; j < 4; ++j) o[d0][r + j] = sv[j] - A.lam * (o[d0][r + j] * rli[r + j]); }
#pragma unroll
            for (int r = 0; r < 16; ++r) { float s = 0.f;
#pragma unroll
                for (int d0 = 0; d0 < 4; ++d0) { const float v = o[d0][r]; s += v * v; }
                s += __shfl_xor(s, 1); s += __shfl_xor(s, 2); s += __shfl_xor(s, 4); s += __shfl_xor(s, 8); s += __shfl_xor(s, 16);
                ss[r] = __builtin_amdgcn_rsqf(s * (1.f / 128.f) + RMS_EPS) * A.post;
                if ((r & 3) == 3) asm volatile("" ::: "memory"); }
#pragma unroll
            for (int d0 = 0; d0 < 4; ++d0) { const float gs = A.gsub[d0 * 32 + r32];
#pragma unroll
                for (int r = 0; r < 16; ++r) { const int orow = crow(r, hi); const float v = o[d0][r] * ss[r] * gs; const float vn = __shfl_xor(v, 1);
                    if ((r32 & 1) == 0) *(unsigned*)(Ow + (size_t)orow * 2048 + d0 * 32 + r32) = cvtpk(v, vn); } }
        }
        __syncthreads();
    }
}

template <int MODE>
DI void tile_hooks(f32x16& p0, f32x16& p1, int kbase, int qlo, int qpos, int hi, LAS const float* tab, LAS const float* fk, float fqv, unsigned long long mw) {
    if (MODE == 0 || MODE == 1) { if (kbase + 63 + 113 > qlo) { const int dq_ = qpos - kbase - 4 * hi;
#pragma unroll
        for (int r = 0; r < 16; ++r) { const int c_ = (r & 3) + 8 * (r >> 2); int i0 = dq_ - c_, i1 = dq_ - c_ - 32;
            i0 = i0 < 0 ? 0 : (i0 > 127 ? 127 : i0); i1 = i1 < 0 ? 0 : (i1 > 127 ? 127 : i1); p0[r] += tab[i0]; p1[r] += tab[i1]; } } }
    if (MODE == 2) {
#pragma unroll
        for (int g = 0; g < 4; ++g) { const f32x4 f0 = *(LAS const f32x4*)(fk + kbase + 8 * g + 4 * hi), f1 = *(LAS const f32x4*)(fk + kbase + 32 + 8 * g + 4 * hi);
#pragma unroll
            for (int j = 0; j < 4; ++j) { p0[4 * g + j] += fqv - f0[j]; p1[4 * g + j] += fqv - f1[j]; } } }
    if (kbase + 63 > qlo) { const int dq_ = qpos - kbase - 4 * hi; const float NEG_ = -__builtin_inff();
#pragma unroll
        for (int r = 0; r < 16; ++r) { const int c_ = (r & 3) + 8 * (r >> 2); if (dq_ - c_ < 0) p0[r] = NEG_; if (dq_ - c_ - 32 < 0) p1[r] = NEG_; } }
    if (MODE == 0) { const unsigned wl_ = (unsigned)mw >> (4 * hi), wh_ = (unsigned)(mw >> 32) >> (4 * hi); const float NEG_ = -__builtin_inff();
#pragma unroll
        for (int r = 0; r < 16; ++r) { const int c_ = (r & 3) + 8 * (r >> 2); if (!((wl_ >> c_) & 1u)) p0[r] = NEG_; if (!((wh_ >> c_) & 1u)) p1[r] = NEG_; } }
}
DI void partialSM(f32x16& p0, f32x16& p1, float& m_reg, float& mn, float& alpha) {
    float pmax = p0[0];
#pragma unroll
    for (int r = 1; r < 16; ++r) pmax = fmaxf(pmax, p0[r]);
#pragma unroll
    for (int r = 0; r < 16; ++r) pmax = fmaxf(pmax, p1[r]);
    { auto rr = __builtin_amdgcn_permlane32_swap(__float_as_uint(pmax), __float_as_uint(pmax), false, false); pmax = fmaxf(__uint_as_float(rr[0]), __uint_as_float(rr[1])); }
    if (__builtin_expect(__all(pmax - m_reg <= 8.f), 1)) { mn = m_reg; alpha = 1.f; }
    else { mn = fmaxf(m_reg, pmax); alpha = __builtin_amdgcn_exp2f(m_reg - mn); m_reg = mn; }
#pragma unroll
    for (int r = 0; r < 16; ++r) { p0[r] -= mn; p1[r] -= mn; }
#pragma unroll
    for (int r = 0; r < 16; ++r) p0[r] = __builtin_amdgcn_exp2f(p0[r]);
}
DI void finishSM(f32x16& p0, f32x16& p1, float alpha, float& l_reg, bf16x8& pa0, bf16x8& pa1, bf16x8& pa2, bf16x8& pa3) {
#pragma unroll
    for (int r = 0; r < 16; ++r) p1[r] = __builtin_amdgcn_exp2f(p1[r]);
    float ps = 0.f;
#pragma unroll
    for (int r = 0; r < 16; ++r) ps += p0[r];
#pragma unroll
    for (int r = 0; r < 16; ++r) ps += p1[r];
    { auto rr = __builtin_amdgcn_permlane32_swap(__float_as_uint(ps), __float_as_uint(ps), false, false); ps = __uint_as_float(rr[0]) + __uint_as_float(rr[1]); }
    l_reg = l_reg * alpha + ps;
#define PK4(P, B_, OUT) do { unsigned a0 = cvtpk(P[B_+0], P[B_+1]), a1 = cvtpk(P[B_+2], P[B_+3]);                          \
        unsigned b0 = cvtpk(P[B_+4], P[B_+5]), b1 = cvtpk(P[B_+6], P[B_+7]);                                             \
        auto r0 = __builtin_amdgcn_permlane32_swap(a0, b0, false, false); auto r1 = __builtin_amdgcn_permlane32_swap(a1, b1, false, false); \
        u32x4 w = {r0[0], r1[0], r0[1], r1[1]}; OUT = __builtin_bit_cast(bf16x8, w); } while (0)
    PK4(p0, 0, pa0); PK4(p0, 8, pa1); PK4(p1, 0, pa2); PK4(p1, 8, pa3);
#undef PK4
}

template <int MODE, int PASS>
DI void attn_pass_p(LAS char* lds, const UnitArgs& A) {
    int tid_l = threadIdx.x; asm volatile("" : "+v"(tid_l));
    const int tid = tid_l, wid = __builtin_amdgcn_readfirstlane(tid >> 6), lane = tid & 63, r32 = lane & 31, hi = lane >> 5;
    const int q0 = A.q0, NT = (q0 + 256) / 64;
    LAS char* V_lds = lds + OFF_V; LAS char* K_lds = lds + OFF_K;
    LAS float* wsf = (LAS float*)(lds + OFF_WS) + wid * 64; LAS float* li_l = wsf; LAS float* al_l = wsf + 32;
    LAS float* tab = (LAS float*)(lds + OFF_TAB); LAS float* fk = (LAS float*)(lds + OFF_FK);
    const int qlo = q0 + wid * 32, qpos = qlo + r32;
    const int sr = tid >> 4, sc = (tid & 15) * 8;
    const int vst0 = v_st(sr, sc), vst1 = v_st(32 + sr, sc), kws = KSWZ(sr, sc * 2);
    const int vb0 = (int)(unsigned)(uintptr_t)V_lds + v_rd_base(lane);
    const unsigned soff = (unsigned)(sr * LDQ + sc) * 2u;
    float fqv = 0.f;
    if (MODE == 2) fqv = A.fcum[qpos];
    constexpr int NQ = (MODE == 1) ? 4 : 8; constexpr int pass = PASS;
    {
        bf16x8 qr[NQ];
#pragma unroll
        for (int d = 0; d < NQ; ++d) qr[d] = *(const bf16x8*)(A.Qp + (size_t)(qpos) * LDQ + (MODE == 1 ? pass * 64 : 0) + d * 16 + hi * 8);
        bf16x8 st_k0, st_k1, st_v0, st_v1;
        unsigned long long mwC = 0ull;
#define VMW() asm volatile("s_waitcnt vmcnt(0)" ::: "memory")
#define SLOAD(k0) do { const char* vb_ = (const char*)A.Vp + (size_t)(k0) * (LDQ * 2); const char* kb_ = (const char*)A.Kp + (size_t)(k0) * (LDQ * 2);     \
                       st_v0 = *(const bf16x8*)(vb_ + soff); st_v1 = *(const bf16x8*)(vb_ + soff + 32 * LDQ * 2); st_k0 = *(const bf16x8*)(kb_ + soff); st_k1 = *(const bf16x8*)(kb_ + soff + 32 * LDQ * 2); } while (0)
#define SWRITE_K(bf) do { *(LAS bf16x8*)(K_lds + (bf) * SHM_K + kws) = st_k0; *(LAS bf16x8*)(K_lds + (bf) * SHM_K + kws + 32 * 256) = st_k1; } while (0)
#define SWRITE_V(bf) do { *(LAS bf16x8*)(V_lds + (bf) * SHM_V + vst0) = st_v0; *(LAS bf16x8*)(V_lds + (bf) * SHM_V + vst1) = st_v1; } while (0)
#define MLOAD(t) do { if (MODE == 0) mwC = A.maskp[(size_t)qpos * 32 + (t)]; } while (0)
#define QKT(KB, P0, P1) do { if (MODE == 1) { if (pass == 0) qkt<KB, 0, 4>(P0, P1, K_lds, r32, hi, qr); else qkt<KB, 4, 8>(P0, P1, K_lds, r32, hi, qr); } else qkt<KB, 0, 8>(P0, P1, K_lds, r32, hi, qr); } while (0)
#define RESC(a) do { if (__any((a) < 1.f)) { if (hi == 0) al_l[r32] = (a); asm volatile("s_waitcnt lgkmcnt(0)" ::: "memory"); \
            _Pragma("unroll") for (int d_ = 0; d_ < 4; ++d_) _Pragma("unroll") for (int r = 0; r < 16; ++r) o[d_][r] *= al_l[crow(r, hi)]; } } while (0)
        MLOAD(0); SLOAD(0); VMW(); SWRITE_K(0);
        __syncthreads();
        float m_reg = -1e30f, l_reg = 0.f; f32x16 o[4];
#pragma unroll
        for (int d = 0; d < 4; ++d)
#pragma unroll
            for (int r = 0; r < 16; ++r) o[d][r] = 0.f;
        f32x16 pA0, pA1, pB0, pB1; float mnA, mnB, alA, alB; bf16x8 pa0, pa1, pa2, pa3;
        SWRITE_V(0); SBAR();
        SLOAD(64);
        SBAR(); QKT(0, pA0, pA1);
        tile_hooks<MODE>(pA0, pA1, 0, qlo, qpos, hi, tab, fk, fqv, mwC); MLOAD(1); partialSM(pA0, pA1, m_reg, mnA, alA);
        VMW(); SWRITE_V(1); SWRITE_K(1);
        __syncthreads();
#define HALF_STEP(PX0, PX1, mnX, alX, PY0, PY1, alY, t, KB, VB, SB) do { \
        SBAR(); QKT(KB, PX0, PX1); \
        finishSM(PY0, PY1, alY, l_reg, pa0, pa1, pa2, pa3); SBAR(); \
        if ((t) + 1 < NT) { SLOAD(((t) + 1) * 64); SBAR(); } \
        pv_tile<VB>(o, vb0, pa0, pa1, pa2, pa3); \
        tile_hooks<MODE>(PX0, PX1, (t) * 64, qlo, qpos, hi, tab, fk, fqv, mwC); if ((t) + 1 < NT) MLOAD((t) + 1); partialSM(PX0, PX1, m_reg, mnX, alX); \
        __syncthreads(); \
        if ((t) + 1 < NT) { VMW(); SWRITE_V(SB); SWRITE_K(SB); } \
        RESC(alX); __syncthreads(); } while (0)
#pragma unroll 1
        for (int t = 1; t + 1 < NT; t += 2) {
            HALF_STEP(pB0, pB1, mnB, alB, pA0, pA1, alA, t, 1, 0, 0);
            HALF_STEP(pA0, pA1, mnA, alA, pB0, pB1, alB, t + 1, 0, 1, 1);
        }
        SBAR(); QKT(1, pB0, pB1); SBAR();
        finishSM(pA0, pA1, alA, l_reg, pa0, pa1, pa2, pa3); SBAR();
        pv_tile<0>(o, vb0, pa0, pa1, pa2, pa3);
        tile_hooks<MODE>(pB0, pB1, (NT - 1) * 64, qlo, qpos, hi, tab, fk, fqv, mwC); partialSM(pB0, pB1, m_reg, mnB, alB);
        RESC(alB);
        finishSM(pB0, pB1, alB, l_reg, pa0, pa1, pa2, pa3); SBAR();
        pv_tile<1>(o, vb0, pa0, pa1, pa2, pa3);
#undef HALF_STEP
#undef RESC
#undef QKT
#undef MLOAD
#undef SWRITE_K
#undef SWRITE_V
#undef SLOAD
#undef VMW
        if (hi == 0) li_l[r32] = l_reg; asm volatile("s_waitcnt lgkmcnt(0)" ::: "memory");
        float rli[16];
#pragma unroll
        for (int r = 0; r < 16; ++r) rli[r] = __builtin_amdgcn_rcpf(li_l[crow(r, hi)]);
        bf16_t* Ow = A.Op + (size_t)(qlo) * 2048; asm volatile("" : "+v"(Ow));
        if (MODE != 1) {
#pragma unroll
            for (int r = 0; r < 16; ++r) { const int orow = crow(r, hi);
#pragma unroll
                for (int d0 = 0; d0 < 4; ++d0) { const float v = o[d0][r] * rli[r]; const float vn = __shfl_xor(v, 1);
                    if ((r32 & 1) == 0) *(unsigned*)(Ow + (size_t)orow * 2048 + d0 * 32 + r32) = cvtpk(v, vn); } }
        } else if (pass == 0) {
#pragma unroll
            for (int d0 = 0; d0 < 4; ++d0)
#pragma unroll
                for (int r = 0; r < 16; r += 4) *(f32x4*)(A.stash + tid * 64 + d0 * 16 + r) = (f32x4){o[d0][r] * rli[r], o[d0][r + 1] * rli[r + 1], o[d0][r + 2] * rli[r + 2], o[d0][r + 3] * rli[r + 3]};
        } else {
            float ss[16];
#pragma unroll
            for (int d0 = 0; d0 < 4; ++d0)
#pragma unroll
                for (int r = 0; r < 16; r += 4) { const f32x4 sv = *(const f32x4*)(A.stash + tid * 64 + d0 * 16 + r);
#pragma unroll
                    for (int j = 0; j < 4; ++j) o[d0][r + j] = sv[j] - A.lam * (o[d0][r + j] * rli[r + j]); }
#pragma unroll
            for (int r = 0; r < 16; ++r) { float s = 0.f;
#pragma unroll
                for (int d0 = 0; d0 < 4; ++d0) { const float v = o[d0][r]; s += v * v; }
                s += __shfl_xor(s, 1); s += __shfl_xor(s, 2); s += __shfl_xor(s, 4); s += __shfl_xor(s, 8); s += __shfl_xor(s, 16);
                ss[r] = __builtin_amdgcn_rsqf(s * (1.f / 128.f) + RMS_EPS) * A.post;
                if ((r & 3) == 3) asm volatile("" ::: "memory"); }
#pragma unroll
            for (int d0 = 0; d0 < 4; ++d0) { const float gs = A.gsub[d0 * 32 + r32];
#pragma unroll
                for (int r = 0; r < 16; ++r) { const int orow = crow(r, hi); const float v = o[d0][r] * ss[r] * gs; const float vn = __shfl_xor(v, 1);
                    if ((r32 & 1) == 0) *(unsigned*)(Ow + (size_t)orow * 2048 + d0 * 32 + r32) = cvtpk(v, vn); } }
        }
        __syncthreads();
    }
}

template <int MODE>
DI void attn_unit_p(LAS char* lds, const UnitArgs& A) {
    int tid_l = threadIdx.x; asm volatile("" : "+v"(tid_l)); const int tid = tid_l;
    LAS float* tab = (LAS float*)(lds + OFF_TAB); LAS float* fk = (LAS float*)(lds + OFF_FK);
    if (MODE == 0 || MODE == 1) { if (tid < 128) { const int bk = t5_bucket(tid); tab[tid] = (A.relb[bk * 8 + A.relcol] - A.relb[31 * 8 + A.relcol]) * LOG2E; } }
    if (MODE == 2) { for (int i = tid; i < A.q0 + 256; i += 512) fk[i] = A.fcum[i]; }
    attn_pass_p<MODE, 0>(lds, A);
    if (MODE == 1) attn_pass_p<MODE, 1>(lds, A);
}
#undef SBAR
}

#define XB_TMO      128
#define XB_XCNT(j)  (256  + 64 * (j))
#define XB_XSUB(j)  (1280 + 64 * (j))
#define XB_XGEN(j)  (2304 + 64 * (j))
#define XB_TOP      3328
#define XB_TOPGEN   3392
#define XCD_BAR_WORDS 3456
#define XB_SPIN_CAP (1u << 20)

__device__ __forceinline__ unsigned xb_ld(unsigned* p)              { return __hip_atomic_load(p, __ATOMIC_RELAXED, __HIP_MEMORY_SCOPE_AGENT); }
__device__ __forceinline__ unsigned xb_add(unsigned* p, unsigned v) { return __hip_atomic_fetch_add(p, v, __ATOMIC_RELAXED, __HIP_MEMORY_SCOPE_AGENT); }
__device__ __forceinline__ unsigned xb_xcc_id() { return (unsigned)__builtin_amdgcn_s_getreg((3 << 11) | 20) & 0xFu; }
#define XB_SPIN(cond, bar) do { unsigned _sp = 0; while (cond) { __builtin_amdgcn_s_sleep(1); \
    if ((++_sp & 255u) == 0u) { if (xb_ld(&(bar)[XB_TMO])) break; if (_sp > XB_SPIN_CAP) { atomicAdd(&(bar)[XB_TMO], 1u); break; } } } } while (0)

struct XcdBarrier {
    unsigned* bar; unsigned x;
    volatile LAS unsigned* st;
};

__device__ __forceinline__ XcdBarrier xcd_barrier_post(unsigned* bar, volatile LAS unsigned* st) {
    XcdBarrier b; b.bar = bar; b.x = xb_xcc_id(); b.st = st;
    if (threadIdx.x == 0) (void)xb_add(&bar[XB_XCNT(b.x)], 1u);
    return b;
}
__device__ __forceinline__ void xcd_barrier_complete(unsigned* bar, unsigned x, unsigned& nloc, unsigned& nx) {
    const unsigned G = gridDim.x * gridDim.y * gridDim.z;
    unsigned sum, cnt, mine, sp = 0u;
    for (;;) {
        sum = 0u; cnt = 0u; mine = 0u;
#pragma unroll
        for (unsigned j = 0; j < 16; ++j) { const unsigned c = xb_ld(&bar[XB_XCNT(j)]); sum += c; cnt += (c > 0u) ? 1u : 0u; mine = (j == x) ? c : mine; }
        if (sum == G) break;
        __builtin_amdgcn_s_sleep(1);
        if ((++sp & 255u) == 0u) { if (xb_ld(&bar[XB_TMO])) break; if (sp > XB_SPIN_CAP) { atomicAdd(&bar[XB_TMO], 1u); break; } }
    }
    nloc = mine > 0u ? mine : 1u; nx = cnt > 0u ? cnt : 1u;
}

__device__ __forceinline__ void xcd_barrier(const XcdBarrier& b) {
    asm volatile("s_waitcnt vmcnt(0)" ::: "memory");
    __syncthreads();
    if (threadIdx.x == 0) {
        unsigned* bar = b.bar; asm volatile("" : "+s"(bar));
        __builtin_amdgcn_s_waitcnt(0);
        unsigned nloc = b.st[0], nx = b.st[1];
        if (nloc == 0u) { xcd_barrier_complete(bar, b.x, nloc, nx); b.st[0] = nloc; b.st[1] = nx; }
        const unsigned old = xb_add(&bar[XB_XSUB(b.x)], 1u);
        const unsigned gen = old / nloc;
        if (old + 1u == (gen + 1u) * nloc) {
            __builtin_amdgcn_fence(__ATOMIC_RELEASE, "agent");
            asm volatile("s_waitcnt vmcnt(0)" ::: "memory");
            const unsigned og = xb_add(&bar[XB_TOP], 1u);
            const unsigned tg = og / nx;
            if (og + 1u == (tg + 1u) * nx) xb_add(&bar[XB_TOPGEN], 1u);
            else XB_SPIN(xb_ld(&bar[XB_TOPGEN]) == tg, bar);
            __builtin_amdgcn_fence(__ATOMIC_ACQUIRE, "agent");
            xb_add(&bar[XB_XGEN(b.x)], 1u);
            asm volatile("s_waitcnt vmcnt(0)" ::: "memory");
        } else {
            XB_SPIN(xb_ld(&bar[XB_XGEN(b.x)]) == gen, bar);
            __builtin_amdgcn_fence(__ATOMIC_ACQUIRE, "agent");
            asm volatile("s_waitcnt vmcnt(0)" ::: "memory");
        }
    }
    __syncthreads();
}
#define RLX_AGENT __ATOMIC_RELAXED, __HIP_MEMORY_SCOPE_AGENT
#define LDS_WAIT() asm volatile("s_waitcnt lgkmcnt(0)" ::: "memory")
DI unsigned f2bf(float f) { unsigned u = __builtin_bit_cast(unsigned, f); return (u + 0x7fffu + ((u >> 16) & 1u)) >> 16; }
DI unsigned pk2(float lo, float hi) { return f2bf(lo) | (f2bf(hi) << 16); }

struct MapPlain { DI int src(int n) const { return n; } DI float scale(int) const { return 1.f; } };
struct MapWin {
    DI int src(int n) const {
        if (n < 1536) return 1860 + n;
        if (n < 2048) return 5956 + (n - 1536);
        if (n < 3584) return 3396 + (n - 2048);
        if (n < 3840) return 1536 + (n - 3584);
        if (n < 3904) return 1792 + (n - 3840);
        if (n < 3908) return 1856 + (n - 3904);
        if (n < 3912) return 6468 + (n - 3908);
        if (n < 4096) return -1;
        if (n < 5632) return n - 4096;
        if (n < 6144) return 4932 + (n - 5632);
        return 5444 + (n - 6144);
    }
    DI float scale(int n) const { return n < 512 ? 0.125f * LOG2E : 1.f; }
};
constexpr float QSCALE128 = 0.08838834764831845f * LOG2E;
struct MapGate {
    DI int src(int n) const { const int pn = n >> 8, c = n & 255; const int g = 2 * (c >> 7) + ((c >> 4) & 1), dl = 16 * ((c >> 5) & 3) + (c & 15); return g * 2048 + 64 * pn + dl; }
    DI float scale(int) const { return 1.f; }
};
template <class Map>
DI void transpose_item(const float* W, int K, int Nsrc, int nblk  , bf16_t* WT, const Map& map, LAS float* scr, int item, int lane) {
    const int kb = item / nblk, nb = item % nblk, k0 = 64 * kb, n0 = 32 * nb;
    const int nd = n0 + (lane & 31); const int s = map.src(nd); const float scl = map.scale(nd);
#pragma unroll 8
    for (int i = 0; i < 32; ++i) { const int kk = 2 * i + (lane >> 5); scr[kk * 33 + (lane & 31)] = (s >= 0) ? W[(size_t)(k0 + kk) * Nsrc + s] * scl : 0.f; }
    LDS_WAIT(); asm volatile("" ::: "memory");
    const int c = lane & 7;
#pragma unroll
    for (int j = 0; j < 4; ++j) { const int n = (lane >> 3) + 8 * j; const LAS float* sp = scr + (8 * c) * 33 + n;
        u32x4 o; o.x = pk2(sp[0 * 33], sp[1 * 33]); o.y = pk2(sp[2 * 33], sp[3 * 33]); o.z = pk2(sp[4 * 33], sp[5 * 33]); o.w = pk2(sp[6 * 33], sp[7 * 33]);
        *(u32x4*)(WT + (size_t)(n0 + n) * K + k0 + 8 * c) = o; }
    LDS_WAIT(); asm volatile("" ::: "memory");
}
constexpr float WG8_SCALE = 64.f;
template <class Map>
DI void transpose_item8(const float* W, int K, int Nsrc, int nblk, unsigned char* WT, const Map& map, int noff  , LAS float* scr, int item, int lane) {
    const int kb = item / nblk, nb = item % nblk, k0 = 64 * kb, n0 = 32 * nb;
    const int nd = noff + n0 + (lane & 31); const int s = map.src(nd); const float scl = map.scale(nd) * WG8_SCALE;
#pragma unroll 8
    for (int i = 0; i < 32; ++i) { const int kk = 2 * i + (lane >> 5); scr[kk * 33 + (lane & 31)] = (s >= 0) ? W[(size_t)(k0 + kk) * Nsrc + s] * scl : 0.f; }
    LDS_WAIT(); asm volatile("" ::: "memory");
#pragma unroll
    for (int j = 0; j < 2; ++j) { const int q = lane + 64 * j, n = q >> 2, c = q & 3; const LAS float* sp = scr + (16 * c) * 33 + n;
        int o[4];
#pragma unroll
        for (int e = 0; e < 4; ++e) { int w = 0; w = __builtin_amdgcn_cvt_pk_fp8_f32(sp[(4 * e + 0) * 33], sp[(4 * e + 1) * 33], w, false); w = __builtin_amdgcn_cvt_pk_fp8_f32(sp[(4 * e + 2) * 33], sp[(4 * e + 3) * 33], w, true); o[e] = w; }
        *(u32x4*)(WT + (size_t)(n0 + n) * K + k0 + 16 * c) = (u32x4){(unsigned)o[0], (unsigned)o[1], (unsigned)o[2], (unsigned)o[3]}; }
    LDS_WAIT(); asm volatile("" ::: "memory");
}
DI void mod_partial_item(const float* c, const float* wada, float* modp, int item, int lane) {
    const int kc = item & 15, nb = (item >> 4) % 48, l = item / (16 * 48);
    const int k0 = kc * 128, n0 = nb * 256 + 4 * lane;
    const float* Wl = wada + (size_t)l * 2048 * 12288;
    f32x4 acc[8];
#pragma unroll
    for (int b = 0; b < 8; ++b) acc[b] = (f32x4){0.f, 0.f, 0.f, 0.f};
#pragma unroll 1
    for (int sub = 0; sub < 2; ++sub) {
        float cb[8];
#pragma unroll
        for (int b = 0; b < 8; ++b) { const float x = c[b * 2048 + k0 + 64 * sub + lane]; cb[b] = x / (1.f + __expf(-x)); }
#pragma unroll 8
        for (int kk = 0; kk < 64; ++kk) { const f32x4 w = *(const f32x4*)(Wl + (size_t)(k0 + 64 * sub + kk) * 12288 + n0);
#pragma unroll
            for (int b = 0; b < 8; ++b) { const float s = __builtin_bit_cast(float, __builtin_amdgcn_readlane(__builtin_bit_cast(int, cb[b]), kk)); acc[b] += s * w; } }
    }
#pragma unroll
    for (int b = 0; b < 8; ++b) *(f32x4*)(modp + ((size_t)(kc * 2 + l) * 8 + b) * 12288 + n0) = acc[b];
}
template <bool F8, bool XB16>
DI void norm_row(const void* xrow, bf16_t* orow, unsigned char* orow8, const f32x4 (&Av)[8], const f32x4 (&Bv)[8], int lane) {
    f32x4 v[8]; float s = 0.f;
#pragma unroll
    for (int j = 0; j < 8; ++j) {
        if (XB16) { const u32x2 w = ((const u32x2*)xrow)[lane + 64 * j]; v[j] = (f32x4){__uint_as_float(w.x << 16), __uint_as_float(w.x & 0xffff0000u), __uint_as_float(w.y << 16), __uint_as_float(w.y & 0xffff0000u)}; }
        else v[j] = ((const f32x4*)xrow)[lane + 64 * j];
        s += (v[j][0] * v[j][0] + v[j][1] * v[j][1]) + (v[j][2] * v[j][2] + v[j][3] * v[j][3]); }
    const float rstd = 1.f / sqrtf(wave_sum(s) * (1.f / 2048.f) + RMS_EPS);
    u32x2* o8 = (u32x2*)orow + lane;
#pragma unroll
    for (int j = 0; j < 8; ++j) { const f32x4 h = v[j] * rstd * Av[j] + Bv[j]; u32x2 w; w.x = cvtpk(h[0], h[1]); w.y = cvtpk(h[2], h[3]); o8[64 * j] = w;
        if (F8) { int q = 0; q = __builtin_amdgcn_cvt_pk_fp8_f32(h[0], h[1], q, false); q = __builtin_amdgcn_cvt_pk_fp8_f32(h[2], h[3], q, true); ((int*)orow8)[lane + 64 * j] = q; } }
}
DI void final_row(const bf16_t* xrow, float* orow, const f32x4 (&Gv)[8], int lane) {
    f32x4* xr = (f32x4*)orow + lane;
    f32x4 v[8]; float s = 0.f;
#pragma unroll
    for (int j = 0; j < 8; ++j) { const u32x2 w = ((const u32x2*)xrow)[lane + 64 * j]; v[j] = (f32x4){__uint_as_float(w.x << 16), __uint_as_float(w.x & 0xffff0000u), __uint_as_float(w.y << 16), __uint_as_float(w.y & 0xffff0000u)};
        s += (v[j][0] * v[j][0] + v[j][1] * v[j][1]) + (v[j][2] * v[j][2] + v[j][3] * v[j][3]); }
    const float rstd = 1.f / sqrtf(wave_sum(s) * (1.f / 2048.f) + RMS_EPS);
#pragma unroll
    for (int j = 0; j < 8; ++j) xr[64 * j] = v[j] * rstd * Gv[j];
}
DI void conv_task(const bf16_t* qkv, const float* cw, bf16_t* br, int row0, int lane) {
    const int ch = lane * 8;
    float w0[8], w1[8], w2[8];
#pragma unroll
    for (int j = 0; j < 8; ++j) { w0[j] = cw[ch + j]; w1[j] = cw[512 + ch + j]; w2[j] = cw[1024 + ch + j]; }
    float up2[8], up1[8];
    const bf16_t* rp = qkv + (size_t)row0 * LDQ + ch;
    auto load_u = [&](const bf16_t* r, float (&u)[8]) {
        const bf16x8 cg = *(const bf16x8*)(r + C_CG), xi = *(const bf16x8*)(r + C_XIN);
#pragma unroll
        for (int j = 0; j < 8; ++j) u[j] = bf2f((bf16_t)cg[j]) * bf2f((bf16_t)xi[j]);
    };
    if ((row0 & (SEQ - 1)) == 0) {
#pragma unroll
        for (int j = 0; j < 8; ++j) { up2[j] = 0.f; up1[j] = 0.f; }
    } else { load_u(rp - 2 * LDQ, up2); load_u(rp - LDQ, up1); }
    bf16_t* op = br + (size_t)row0 * 2048 + 1024 + ch;
#pragma unroll
    for (int i = 0; i < 8; ++i) { float u[8]; load_u(rp, u);
        const bf16x8 bg = *(const bf16x8*)(rp + C_BG);
        rp += LDQ; asm volatile("" : "+v"(rp));
        float y[8];
#pragma unroll
        for (int j = 0; j < 8; ++j) y[j] = bf2f((bf16_t)bg[j]) * (w0[j] * up2[j] + w1[j] * up1[j] + w2[j] * u[j]);
        u32x4 o; o.x = cvtpk(y[0], y[1]); o.y = cvtpk(y[2], y[3]); o.z = cvtpk(y[4], y[5]); o.w = cvtpk(y[6], y[7]);
        *(u32x4*)op = o; op += 2048; asm volatile("" : "+v"(op));
#pragma unroll
        for (int j = 0; j < 8; ++j) { up2[j] = up1[j]; up1[j] = u[j]; } }
}
DI void fcum_task(const bf16_t* qkvb  , float bf_h, int h, float* out  , int lane) {
    const bf16_t* p = qkvb + (size_t)(32 * lane) * LDQ + C_FD + h;
    float v[32];
#pragma unroll
    for (int i = 0; i < 32; ++i) { v[i] = bf2f(*p); p += LDQ; asm volatile("" : "+v"(p)); }
    float run = 0.f;
#pragma unroll
    for (int i = 0; i < 32; ++i) { const float x = v[i] + bf_h; run -= __logf(1.f + __expf(-x)); v[i] = run; }
    float incl = run;
#pragma unroll
    for (int o = 1; o < 64; o <<= 1) { const float y = __shfl_up(incl, o); if (lane >= o) incl += y; }
    const float excl = incl - run;
    float* op = out + 32 * lane;
#pragma unroll
    for (int i = 0; i < 32; i += 4) *(f32x4*)(op + i) = (f32x4){(v[i] + excl) * LOG2E, (v[i + 1] + excl) * LOG2E, (v[i + 2] + excl) * LOG2E, (v[i + 3] + excl) * LOG2E};
}
DI int rowsum16(int x) { x += __shfl_xor(x, 8); x += __shfl_xor(x, 4); x += __shfl_xor(x, 2); x += __shfl_xor(x, 1); return x; }
DI void select_task(const bf16_t* qkvb  , const bf16_t* ikb  , unsigned long long* mrow  , int t0, LAS unsigned long long* wl, int lane_in) {
    int lane = lane_in; asm volatile("" : "+v"(lane));
    const int fr = lane & 15, fq = lane >> 4, t = t0 + fq;
    const int nch = __builtin_amdgcn_readfirstlane((t0 + 3) / 256 + 1);
    const bf16_t* ap = qkvb + (size_t)(t0 + (fr >> 2)) * LDQ + C_IQ + (fr & 3) * 64 + fq * 8;
    const bf16x8 a0 = *(const bf16x8*)ap, a1 = *(const bf16x8*)(ap + 32);
    float w[4]; { const u32x2 ww = *(const u32x2*)(qkvb + (size_t)t * LDQ + C_IW);
        w[0] = __uint_as_float(ww.x << 16) * IDX_SCALE; w[1] = __uint_as_float(ww.x & 0xffff0000u) * IDX_SCALE; w[2] = __uint_as_float(ww.y << 16) * IDX_SCALE; w[3] = __uint_as_float(ww.y & 0xffff0000u) * IDX_SCALE; }
    unsigned u[128];
    const int tf = t - fr;
    const char* kbase = (const char*)ikb;
    unsigned voff = (unsigned)lane * 16u;
#pragma unroll
    for (int c = 0; c < 8; ++c) {
        if (c < nch) {
#pragma unroll
            for (int ii = 0; ii < 16; ++ii) { const int i = c * 16 + ii;
                const bf16x8 b0 = *(const bf16x8*)(kbase + voff), b1 = *(const bf16x8*)(kbase + voff + 1024);
                voff += 16 * 64 * 2; asm volatile("" : "+v"(voff));
                f32x4 acc = (f32x4){0.f, 0.f, 0.f, 0.f};
                acc = __builtin_amdgcn_mfma_f32_16x16x32_bf16(a0, b0, acc, 0, 0, 0);
                acc = __builtin_amdgcn_mfma_f32_16x16x32_bf16(a1, b1, acc, 0, 0, 0);
                const float sc = ((w[0] * fmaxf(acc[0], 0.f) + w[1] * fmaxf(acc[1], 0.f)) + w[2] * fmaxf(acc[2], 0.f)) + w[3] * fmaxf(acc[3], 0.f);
                unsigned bits = __float_as_uint(sc); if (bits == 0x80000000u) bits = 0u;
                const unsigned key = (bits & 0x80000000u) ? ~bits : (bits | 0x80000000u);
                u[i] = (16 * i <= tf) ? key : 0u; }
        } else {
#pragma unroll
            for (int ii = 0; ii < 16; ++ii) u[c * 16 + ii] = 0u;
        }
    }
#define CNT_GE(cnt, x, c) asm("v_cmp_ge_u32 vcc, %1, %2\n\tv_addc_co_u32 %0, vcc, 0, %0, vcc" : "+v"(cnt) : "v"(x), "v"(c) : "vcc")
#define CNT_GT(cnt, x, c) asm("v_cmp_gt_u32 vcc, %1, %2\n\tv_addc_co_u32 %0, vcc, 0, %0, vcc" : "+v"(cnt) : "v"(x), "v"(c) : "vcc")
#define FOR_CHUNKS(BODY) _Pragma("unroll") for (int c_ = 0; c_ < 8; ++c_) { if (c_ < nch) { _Pragma("unroll") for (int ii_ = 0; ii_ < 16; ++ii_) { const int i = c_ * 16 + ii_; BODY; } } }
    unsigned T = 0u;
    bool done = false;
#pragma unroll 1
    for (int bit = 31; bit >= 0; --bit) { const unsigned c = T | (1u << bit); int cnt = 0;
        FOR_CHUNKS(CNT_GE(cnt, u[i], c));
        cnt = rowsum16(cnt); if (!done && cnt >= 256) T = c; done = done || (cnt == 256);
        if (__all(done)) break; }
    int cgt = 0, cge = 0;
    FOR_CHUNKS(CNT_GT(cgt, u[i], T); CNT_GE(cge, u[i], T));
    cgt = rowsum16(cgt); cge = rowsum16(cge);
    const int need = 256 - cgt; const bool tie = (cge - cgt) > need;
    int X0 = 4095;
    if (__any(tie)) { int x = 0; const unsigned notT = ~T;
#pragma unroll 1
        for (int bit = 10; bit >= 0; --bit) { const int c = x | (1 << bit); int g = 0; const int cf = c - fr;
            FOR_CHUNKS(unsigned tmp;
                asm("v_cmp_lt_i32 vcc, %6, %3\n\tv_cndmask_b32 %1, %4, %2, vcc\n\tv_cmp_eq_u32 vcc, %1, %5\n\tv_addc_co_u32 %0, vcc, 0, %0, vcc"
                    : "+v"(g), "=&v"(tmp) : "v"(u[i]), "v"(cf), "v"(notT), "v"(T), "n"(16 * i) : "vcc"));
            g = rowsum16(g); if (g < need) x = c; }
        if (tie) X0 = x; }
#undef CNT_GE
#undef CNT_GT
    const int xf = X0 - fr;
    FOR_CHUNKS(const bool sel = (u[i] > T) || (u[i] == T && 16 * i <= xf);
        const unsigned long long bal = __ballot(sel); if (lane == 0) wl[i] = bal;
        if ((i & 3) == 3) asm volatile("" ::: "memory"));
#undef FOR_CHUNKS
    LDS_WAIT(); asm volatile("" ::: "memory");
#pragma unroll
    for (int half = 0; half < 2; ++half) { const int j = fr + 16 * half; unsigned long long word = 0ull;
        if (j < nch * 4) {
#pragma unroll
            for (int i4 = 0; i4 < 4; ++i4) word |= ((wl[4 * j + i4] >> (16 * fq)) & 0xFFFFull) << (16 * i4); }
        mrow[(size_t)t * 32 + j] = word; }
    LDS_WAIT(); asm volatile("" ::: "memory");
}
DI void select_causal_task(unsigned long long* mrow, int t0, int lane) {
    const int fr = lane & 15, fq = lane >> 4, t = t0 + fq;
#pragma unroll
    for (int half = 0; half < 2; ++half) { const int j = fr + 16 * half; const int n = t - 64 * j + 1;
        const unsigned long long word = n >= 64 ? ~0ull : (n <= 0 ? 0ull : ((1ull << n) - 1ull));
        mrow[(size_t)t * 32 + j] = word; }
}
DI void select_any(const bf16_t* qkvb, const bf16_t* ikb, unsigned long long* mrow, int t0, LAS unsigned long long* wl, int lane) {
    if (t0 + 3 < 256) select_causal_task(mrow, t0, lane);
    else select_task(qkvb, ikb, mrow, t0, wl, lane);
}

constexpr size_t MiB = 1u << 20;
constexpr size_t WS_CTL = 0, CTL_ZERO_BYTES = 1 * MiB;
constexpr size_t WS_MODF = 1 * MiB;
constexpr size_t WS_IK = 2 * MiB;
constexpr size_t WS_MODP = 2 * MiB;
constexpr size_t WS_FCUM = 14 * MiB;
constexpr size_t WS_MASK = 15 * MiB;
constexpr size_t WS_STASH = 20 * MiB;
constexpr size_t WS_W = 52 * MiB;
constexpr size_t OW_IN = 0, OW_IN8 = 16 * MiB  , OW_G = 26 * MiB, OW_B = 58 * MiB, OW_O = 66 * MiB, OW_1 = 74 * MiB, OW_2 = 106 * MiB, LW_BYTES = 138 * MiB;
constexpr size_t WS_H = WS_W + 2 * LW_BYTES;
constexpr size_t WS_BR = WS_H + 64 * MiB;
constexpr size_t WS_R1 = WS_BR + 64 * MiB;
constexpr size_t WS_H8 = WS_R1 + 256 * MiB;
constexpr size_t WS_XB = WS_H8 + 32 * MiB;
constexpr size_t WS_END = WS_XB + 64 * MiB;
constexpr int CW_BAR = 4096;
constexpr int CW_QUEUE = 16384;

constexpr int RING_OFF = 0, RING_BYTES = 131072;
constexpr int LDSCTL_OFF = RING_BYTES, MISC_OFF = LDSCTL_OFF + 320;
constexpr int LDS_BYTES = 147456;
static_assert(att::LDS_END <= RING_BYTES, "attention scratch inside the ring region");


constexpr int NWAVES = 8;
constexpr int N_PHASES = 23;
struct Args { const float* in[19]; float* out; unsigned char* ws; int ph_lo, ph_hi; };

typedef __attribute__((address_space(4))) const unsigned char* kargp_t;
DI kargp_t karg_base() { kargp_t kp = (kargp_t)__builtin_amdgcn_kernarg_segment_ptr(); asm volatile("" : "+s"(kp)); return kp; }
DI unsigned long long karg_u64(int i) { return *(const __attribute__((address_space(4))) unsigned long long*)(karg_base() + 8 * i); }
DI const float* karg_in(int i) { return (const float*)(GAS const float*)karg_u64(i); }
DI float* karg_out() { return (float*)(GAS float*)karg_u64(19); }
DI unsigned char* karg_ws() { return (unsigned char*)(GAS unsigned char*)karg_u64(20); }
#define ARG_IN(i) karg_in(i)

template <int MODE>
DI void attn_queue(LAS unsigned char* lds, volatile LAS unsigned* MISC, int qidx, int l, int tid, int lane, int variant = 0) {
    unsigned char* ws = karg_ws();
    unsigned* qhead = (unsigned*)(ws + WS_CTL) + CW_QUEUE + 64 * qidx;
    bf16_t* QKV = (bf16_t*)(ws + WS_R1); bf16_t* BR = (bf16_t*)(ws + WS_BR);
    float lamv = 0.f, post = 0.f;
    if (MODE == 1) { const float* lq = ARG_IN(8) + l * 256; const float a = wave_sum(lq[lane] * lq[64 + lane]), b = wave_sum(lq[128 + lane] * lq[192 + lane]);
        const float lam_init = 0.8f - 0.6f * expf(-0.3f * (float)l); lamv = expf(a) - expf(b) + lam_init; post = 1.f - lam_init; }
    for (;;) {
        if (tid == 0) MISC[0] = __hip_atomic_fetch_add(qhead, 1u, RLX_AGENT);
        __syncthreads();
        const unsigned u = MISC[0];
        __syncthreads();
        if (u >= 256u) break;
        const int qb = 7 - (int)(u >> 5), bh = (int)(u & 31u), b = bh >> 2, h = bh & 3;
        att::UnitArgs A;
        const size_t rowb = (size_t)b * SEQ;
        const int cq = MODE == 0 ? C_QA : (MODE == 1 ? C_QB : C_QD), ck = MODE == 0 ? C_KA : (MODE == 1 ? C_KB : C_KD), cv = MODE == 0 ? C_VA : (MODE == 1 ? C_VB : C_VD);
        const int oc = MODE == 0 ? 0 : (MODE == 1 ? 512 : 1536);
        A.Qp = QKV + rowb * LDQ + cq + h * 128; A.Kp = QKV + rowb * LDQ + ck + h * 128; A.Vp = QKV + rowb * LDQ + cv + h * 128;
        A.Op = BR + rowb * 2048 + oc + h * 128; A.q0 = qb * 256;
        A.maskp = (const unsigned long long*)(ws + WS_MASK) + rowb * 32;
        A.fcum = (const float*)(ws + WS_FCUM) + (size_t)(b * 4 + h) * SEQ;
        A.relb = ARG_IN(10); A.relcol = (MODE == 1 ? 4 : 0) + h;
        A.lam = lamv; A.post = post; A.gsub = ARG_IN(9) + l * 128;
        A.stash = (float*)(ws + WS_STASH) + (size_t)blockIdx.x * 64 * 512;
        A.variant = variant; if (variant) A.Op = (bf16_t*)(ws + WS_END) + rowb * 2048 + oc + h * 128;
#ifdef ATT_V1
        att::attn_unit<MODE>((LAS char*)lds, A);
#else
        att::attn_unit_p<MODE>((LAS char*)lds, A);
#endif
    }
}

#define IN(k) (lo <= (k) && (k) < hi)
#ifdef PROBE_TIME
#ifndef PROBE_BLK
#define PROBE_BLK 0
#endif
#ifndef PROBE_SEL
#define PROBE_SEL(k) 1
#endif
#ifndef PROBE_Q
#define PROBE_Q 50.f
#endif
constexpr int CW_TIME = 20000, CW_TPREV = 20064;
#define SEAM(k) do { if (IN((k) + 1)) { unsigned* cw_ = (unsigned*)(karg_ws() + WS_CTL); const bool me_ = (blockIdx.x == PROBE_BLK && threadIdx.x == 0); \
        const unsigned ta_ = (unsigned)__builtin_amdgcn_s_memrealtime(); \
        if (me_ && PROBE_TIME == 2 && PROBE_SEL(k)) atomicAdd(cw_ + CW_TIME, ta_ - cw_[CW_TPREV]); \
        xcd_barrier(bar); \
        const unsigned te_ = (unsigned)__builtin_amdgcn_s_memrealtime(); \
        if (me_) { if (PROBE_TIME == 1) atomicAdd(cw_ + CW_TIME, te_ - ta_); cw_[CW_TPREV] = te_; } } } while (0)
#else
#define SEAM(k) do { if (IN((k) + 1)) xcd_barrier(bar); } while (0)
#endif
#define PH_PTRS int tid_p = threadIdx.x; asm volatile("" : "+v"(tid_p)); const int tid = tid_p, lane = tid & 63; (void)lane; unsigned char* ws = karg_ws(); float* xbuf = karg_out(); float* modf = (float*)(ws + WS_MODF); float* modp = (float*)(ws + WS_MODP); \
    bf16_t* Hb = (bf16_t*)(ws + WS_H); bf16_t* BR = (bf16_t*)(ws + WS_BR); bf16_t* R1 = (bf16_t*)(ws + WS_R1); \
    (void)xbuf; (void)modf; (void)modp; (void)Hb; (void)BR; (void)R1
#define PH_LAYER PH_PTRS; unsigned char* wl_ = ws + WS_W + (size_t)l * LW_BYTES; const float* modl = modf + (size_t)l * 8 * 12288; (void)wl_; (void)modl
template <int l, int LO, int HI>
DI void layer_phases(LAS unsigned char* lds, volatile LAS unsigned* MISC, const XcdBarrier& bar, int wave, int G, int bx, int gw, int NGW) {
    constexpr int lo = LO, hi = HI;
        const int pb = 2 + 10 * l;
        if (IN(pb + 0)) { PH_LAYER;
            const float* g1 = ARG_IN(4) + l * 2048; bf16_t* xb16 = (bf16_t*)(ws + WS_XB); (void)xb16;
#ifndef PROBE_REP_N1
#define PROBE_REP_N1 1
#endif
#pragma unroll 1
          for (int rep = 0; rep < PROBE_REP_N1; ++rep)
            for (int rb = gw; rb < M_TOK / 8; rb += NGW) { const int b = (rb * 8) / SEQ; f32x4 Av[8], Bv[8];
#pragma unroll
                for (int j = 0; j < 8; ++j) { const int c = 4 * lane + 256 * j; const f32x4 g = *(const f32x4*)(g1 + c), sc = *(const f32x4*)(modl + b * 12288 + 2048 + c); Av[j] = g * (sc + 1.f); Bv[j] = *(const f32x4*)(modl + b * 12288 + c); }
#pragma unroll 1
                for (int i = 0; i < 8; ++i) { const size_t ro = (size_t)(rb * 8 + i) * 2048;
                    if (l == 0) norm_row<true, false>(ARG_IN(0) + ro, Hb + ro, ws + WS_H8 + ro, Av, Bv, lane); else norm_row<true, true>(xb16 + ro, Hb + ro, ws + WS_H8 + ro, Av, Bv, lane); } }
            SEAM(pb + 0);
        }
        if (IN(pb + 1)) { PH_LAYER;
            { pg8::Gemm g{(const bf16_t*)(ws + WS_H8), (const bf16_t*)(wl_ + OW_IN8), M_TOK, N_IN8, 1024, 1024, 1024, 1 << 30, 0}; pg8::HalfOrder S; S.init(M_TOK, N_IN8, G, bx); S.nall = 1; S.extra = 3; S.hi_half = true;
              pg8::EpiBf16s E{R1 + N_IN16, LDQ, 1.f / WG8_SCALE, QSCALE128 / WG8_SCALE, 0xC3u};
              pg8::gemm_phase<pg8::EpiBf16s, pg8::HalfOrder, true, true, true>(lds + RING_OFF, g, S, E); }
            { pg8::Gemm g{Hb, (const bf16_t*)(wl_ + OW_IN), M_TOK, N_IN16, 2048, 2048, 2048, 1 << 30, 0}; pg8::HalfOrder S; S.init(M_TOK, N_IN16, G, bx); S.nall = 3; S.extra = 2; S.hi_half = false;
              pg8::EpiBf16ik E{R1, LDQ, (bf16_t*)(ws + WS_IK)};
              pg8::gemm_phase<pg8::EpiBf16ik, pg8::HalfOrder, true, true>(lds + RING_OFF, g, S, E); }
            SEAM(pb + 1);
        }
        if (IN(pb + 2)) { PH_LAYER;
            LAS unsigned long long* wlq = (LAS unsigned long long*)(lds + RING_OFF) + wave * 128;
            unsigned long long* mask = (unsigned long long*)(ws + WS_MASK);
            unsigned* qh = (unsigned*)(ws + WS_CTL) + CW_QUEUE + 64 * (12 + l);
#pragma unroll 1
            for (;;) {
                unsigned kq = 0u; if (lane == 0) kq = __hip_atomic_fetch_add(qh, 1u, RLX_AGENT);
                const int k = __builtin_amdgcn_readfirstlane((int)kq);
                if (k >= 6176) break;
                int ln = lane; asm volatile("" : "+v"(ln));
                if (k < 2048 || (k >= 2080 && k < 4128)) { const int j = k < 2048 ? k : k - 32; const int b = j & 7, t0 = (511 - (j >> 3)) * 4;
                    select_any(R1 + (size_t)b * SEQ * LDQ, (const bf16_t*)(ws + WS_IK) + (size_t)b * SEQ * 64, mask + (size_t)b * SEQ * 32, t0, wlq, ln); }
                else if (k < 2080) { const int kk = k - 2048, b = kk >> 2, h = kk & 3; fcum_task(R1 + (size_t)b * SEQ * LDQ, ARG_IN(6)[l * 4 + h], h, (float*)(ws + WS_FCUM) + (size_t)kk * SEQ, ln); }
                else conv_task(R1, ARG_IN(7) + l * 1536, BR, (k - 4128) * 8, ln);
            }
            SEAM(pb + 2);
        }
        if (IN(pb + 3)) { PH_LAYER;
#ifndef PROBE_REP_M2
#define PROBE_REP_M2 1
#endif
#ifndef PROBE_VARIANT
#define PROBE_VARIANT 0
#endif
#pragma unroll 1
          for (int rep = 0; rep < PROBE_REP_M2; ++rep) {
            if (rep) xcd_barrier(bar);
            attn_queue<1>(lds + RING_OFF, MISC, 3 * l + 0 + 6 * rep, l, tid, lane, rep ? PROBE_VARIANT : 0);
            attn_queue<0>(lds + RING_OFF, MISC, 3 * l + 1 + 6 * rep, l, tid, lane, rep ? PROBE_VARIANT : 0);
            attn_queue<2>(lds + RING_OFF, MISC, 3 * l + 2 + 6 * rep, l, tid, lane, rep ? PROBE_VARIANT : 0);
          }
            SEAM(pb + 3);
        }
        if (IN(pb + 4)) { PH_LAYER;
            pg8::Gemm g{BR, (const bf16_t*)(wl_ + OW_B), M_TOK, 8192, 512, 2048, 512, 8, 512}; pg8::StaticOrder S; S.init(M_TOK, 8192, G, bx);
            pg8::EpiPtile E{R1};

#ifndef NO_G2
#ifndef PROBE_REP_G2
#define PROBE_REP_G2 1
#endif
#pragma unroll 1
            for (int rep = 0; rep < PROBE_REP_G2; ++rep)
            pg8::gemm_phase<pg8::EpiPtile, pg8::StaticOrder, true, true>(lds + RING_OFF, g, S, E);
#endif
            SEAM(pb + 4);
        }
        if (IN(pb + 5)) { PH_LAYER;
            pg8::Gemm g{(const bf16_t*)(ws + WS_H8), (const bf16_t*)(wl_ + OW_G), M_TOK, 8192, 1024, 1024, 1024, 1 << 30, 0}; pg8::StaticOrder S; S.init(M_TOK, 8192, G, bx);
            pg8::EpiGate E{R1, ARG_IN(12) + l * 8192, BR, 1.f / WG8_SCALE};

#ifndef NO_G3
#ifndef PROBE_REP_G3
#define PROBE_REP_G3 1
#endif
#pragma unroll 1
            for (int rep = 0; rep < PROBE_REP_G3; ++rep)
            S.rev = true; pg8::gemm_phase<pg8::EpiGate, pg8::StaticOrder, true, true, true>(lds + RING_OFF, g, S, E);
#endif

            SEAM(pb + 5);
        }
        if (IN(pb + 6)) { PH_LAYER;
            pg8::Gemm g{BR, (const bf16_t*)(wl_ + OW_O), M_TOK, 2048, 2048, 2048, 2048, 1 << 30, 0}; pg8::StaticOrder S; S.init(M_TOK, 2048, G, bx);
            bf16_t* xb16 = (bf16_t*)(ws + WS_XB);
            pg8::EpiResidB<l == 0> E{(l == 0) ? (const void*)ARG_IN(0) : (const void*)xb16, xb16, modl + 4096, 12288};

#ifndef NO_G4
#ifdef PROBE_NULL_G4
            { pg8::EpiNull EN{(float*)(ws + WS_FCUM)}; pg8::gemm_phase<pg8::EpiNull, pg8::StaticOrder, true, true>(lds + RING_OFF, g, S, EN); }
#endif
            pg8::gemm_phase<pg8::EpiResidB<l == 0>, pg8::StaticOrder, true, true>(lds + RING_OFF, g, S, E);
#endif
            SEAM(pb + 6);
        }
        if (IN(pb + 7)) { PH_LAYER;
            const float* g2 = ARG_IN(15) + l * 2048;
            for (int rb = gw; rb < M_TOK / 8; rb += NGW) { const int b = (rb * 8) / SEQ; f32x4 Av[8], Bv[8];
#pragma unroll
                for (int j = 0; j < 8; ++j) { const int c = 4 * lane + 256 * j; const f32x4 g = *(const f32x4*)(g2 + c), sc = *(const f32x4*)(modl + b * 12288 + 8192 + c); Av[j] = g * (sc + 1.f); Bv[j] = *(const f32x4*)(modl + b * 12288 + 6144 + c); }
#pragma unroll 1
                for (int i = 0; i < 8; ++i) norm_row<false, true>((const bf16_t*)(ws + WS_XB) + (size_t)(rb * 8 + i) * 2048, Hb + (size_t)(rb * 8 + i) * 2048, nullptr, Av, Bv, lane); }
            SEAM(pb + 7);
        }
        if (IN(pb + 8)) { PH_LAYER;
            pg8::Gemm g{Hb, (const bf16_t*)(wl_ + OW_1), M_TOK, 8192, 2048, 2048, 2048, 1 << 30, 0}; pg8::StaticOrder S; S.init(M_TOK, 8192, G, bx);
            pg8::EpiBf16<2> E{R1, 8192};

#ifndef NO_G5
#ifdef PROBE_NULL_G5
            { pg8::EpiNull EN{(float*)(ws + WS_FCUM)}; pg8::gemm_phase<pg8::EpiNull, pg8::StaticOrder, true, true>(lds + RING_OFF, g, S, EN); }
#endif
#ifdef PROBE_SPLIT_G5
            { pg8::RangeOrder S1; S1.init(M_TOK, 8192, G, bx); S1.i0 = 0; S1.n = 4; pg8::RangeOrder S2; S2.init(M_TOK, 8192, G, bx); S2.i0 = 4; S2.n = 4;
              pg8::gemm_phase<pg8::EpiBf16<2>, pg8::RangeOrder, true, true>(lds + RING_OFF, g, S1, E);
              xcd_barrier(bar);
              pg8::gemm_phase<pg8::EpiBf16<2>, pg8::RangeOrder, true, true>(lds + RING_OFF, g, S2, E); }
#else
            pg8::gemm_phase<pg8::EpiBf16<2>, pg8::StaticOrder, true, true>(lds + RING_OFF, g, S, E);
#endif
#endif

            SEAM(pb + 8);
        }
        if (IN(pb + 9)) { PH_LAYER;
            pg8::Gemm g{R1, (const bf16_t*)(wl_ + OW_2), M_TOK, 2048, 8192, 8192, 8192, 1 << 30, 0}; pg8::StaticOrder S; S.init(M_TOK, 2048, G, bx);
            bf16_t* xb16 = (bf16_t*)(ws + WS_XB);
            pg8::EpiResidB<false> E{xb16, xb16, modl + 10240, 12288};

#ifndef NO_G6
#ifdef PROBE_DUP_G6
            { pg8::EpiResid ED{xbuf, (float*)(ws + WS_H), modl + 10240, 12288}; pg8::gemm_phase<pg8::EpiResid, pg8::StaticOrder, true, true>(lds + RING_OFF, g, S, ED); }
#endif
#ifdef PROBE_NULL_G6
            { pg8::EpiNull EN{(float*)(ws + WS_FCUM)}; pg8::gemm_phase<pg8::EpiNull, pg8::StaticOrder, true, true>(lds + RING_OFF, g, S, EN); }
#endif
            S.rev = true; pg8::gemm_phase<pg8::EpiResidB<false>, pg8::StaticOrder, true, true>(lds + RING_OFF, g, S, E);
#endif
            SEAM(pb + 9);
        }
}

template <int LO, int HI>
__global__ void __launch_bounds__(NWAVES * 64, 2) mk_fwd(Args args) {
    extern __shared__ __attribute__((aligned(16))) unsigned char lds_raw[];
    LAS unsigned char* lds = (LAS unsigned char*)lds_raw;
    volatile LAS unsigned* MISC = (volatile LAS unsigned*)(lds + MISC_OFF);
    const int tid0 = threadIdx.x, wave = __builtin_amdgcn_readfirstlane(tid0 >> 6);
    const int G = gridDim.x; const int bx = blockIdx.x; const int vcu = (G % 8 == 0) ? (bx % 8) * (G / 8) + bx / 8 : bx;
    const int gw = vcu * NWAVES + wave, NGW = G * NWAVES;
    for (int u = tid0; u < (LDS_BYTES - LDSCTL_OFF) / 4; u += NWAVES * 64) ((LAS unsigned*)(lds + LDSCTL_OFF))[u] = 0u;
    __syncthreads();
    constexpr int lo = LO, hi = HI; (void)args;
    XcdBarrier bar; bar.bar = (unsigned*)(karg_ws() + WS_CTL) + CW_BAR; bar.x = 0; bar.st = nullptr;
    if constexpr (hi - lo > 1) bar = xcd_barrier_post((unsigned*)(karg_ws() + WS_CTL) + CW_BAR, MISC + 8);

#ifdef PROBE_TIME
    if (blockIdx.x == PROBE_BLK && threadIdx.x == 0) ((unsigned*)(karg_ws() + WS_CTL))[CW_TPREV] = (unsigned)__builtin_amdgcn_s_memrealtime();
#endif
    if (IN(0)) { PH_PTRS;
        LAS float* scr = (LAS float*)(lds + RING_OFF + wave * 16384);
#ifndef PROBE_REP_P0
#define PROBE_REP_P0 1
#endif
#pragma unroll 1
        for (int rep = 0; rep < PROBE_REP_P0; ++rep) {
        constexpr int I_IN = 32 * 208, I_G = 32 * 256, I_B = 4 * 8 * 64, I_O = 32 * 64, I_1 = 32 * 256, I_2 = 128 * 64, I_L = I_IN + I_G + I_B + I_O + I_1 + I_2;
        static_assert(2 * I_L == 32 * 2048 + 1536 + 512 * 7, "prologue item split");
#pragma unroll 1
        for (int t = 0; ; ++t) { int it;
            if (NGW == 2048) { if (t < 32) it = gw + 2048 * t; else if (gw < 1536) { if (t > 32) break; it = 65536 + gw; } else { if (t >= 39) break; it = 67072 + (gw - 1536) * 7 + (t - 32); } }
            else { it = gw + NGW * t; if (it >= 2 * I_L) break; }
            const int l = it / I_L; int r = it % I_L;
            unsigned char* wl_ = ws + WS_W + (size_t)l * LW_BYTES;
            if (r < 32 * 128) { transpose_item(ARG_IN(5) + (size_t)l * 2048 * 6472, 2048, 6472, 128, (bf16_t*)(wl_ + OW_IN), MapWin(), scr, r, lane); continue; } r -= 32 * 128;
            if (r < 32 * 80) { transpose_item8(ARG_IN(5) + (size_t)l * 2048 * 6472, 2048, 6472, 80, (unsigned char*)(wl_ + OW_IN8), MapWin(), N_IN16, scr, r, lane); continue; } r -= 32 * 80;
            if (r < I_G) { transpose_item8(ARG_IN(11) + (size_t)l * 2048 * 8192, 2048, 8192, 256, (unsigned char*)(wl_ + OW_G), MapGate(), 0, scr, r, lane); continue; } r -= I_G;
            const float* W; int K, Ns, nblk; bf16_t* WT;
            if (r < I_B) { const int g = r / 512; r -= g * 512; W = ARG_IN(13) + (size_t)(l * 4 + g) * 512 * 2048; K = 512; Ns = 2048; nblk = 64; WT = (bf16_t*)(wl_ + OW_B) + (size_t)g * 2048 * 512; }
            else { r -= I_B;
                if (r < I_O) { W = ARG_IN(14) + (size_t)l * 2048 * 2048; K = 2048; Ns = 2048; nblk = 64; WT = (bf16_t*)(wl_ + OW_O); }
                else { r -= I_O;
                    if (r < I_1) { W = ARG_IN(16) + (size_t)l * 2048 * 8192; K = 2048; Ns = 8192; nblk = 256; WT = (bf16_t*)(wl_ + OW_1); }
                    else { r -= I_1; W = ARG_IN(17) + (size_t)l * 8192 * 2048; K = 8192; Ns = 2048; nblk = 64; WT = (bf16_t*)(wl_ + OW_2); } } }
            transpose_item(W, K, Ns, nblk, WT, MapPlain(), scr, r, lane);
        }
        for (int it = gw; it < 2 * 48 * 16; it += NGW) mod_partial_item(ARG_IN(1), ARG_IN(2), modp, it, lane);
        }
        SEAM(0);
    }
    if (IN(1)) { PH_PTRS;
        for (int i = bx * 512 + tid; i < 2 * 8 * 12288; i += G * 512) { const int n = i % 12288, l = i / (8 * 12288);
            float s = ARG_IN(3)[l * 12288 + n];
#pragma unroll
            for (int kc = 0; kc < 16; ++kc) s += modp[(size_t)kc * (2 * 8 * 12288) + i];
            modf[i] = s; }
        SEAM(1);
    }
    constexpr int L_LO = (LO <= 2) ? 0 : (LO - 2) / 10, L_HI = (HI >= 22) ? NLAYER : (HI - 2 + 9) / 10;
    if constexpr (L_LO <= 0 && 0 < L_HI) layer_phases<0, LO, HI>(lds, MISC, bar, wave, G, bx, gw, NGW);
    if constexpr (L_LO <= 1 && 1 < L_HI) layer_phases<1, LO, HI>(lds, MISC, bar, wave, G, bx, gw, NGW);
    if (IN(22)) { PH_PTRS;
        f32x4 Gv[8];
#pragma unroll
        for (int j = 0; j < 8; ++j) Gv[j] = *(const f32x4*)(ARG_IN(18) + 4 * lane + 256 * j);
        for (int rb = gw; rb < M_TOK / 8; rb += NGW) {
#pragma unroll 1
            for (int i = 0; i < 8; ++i) final_row((const bf16_t*)(ws + WS_XB) + (size_t)(rb * 8 + i) * 2048, xbuf + (size_t)(rb * 8 + i) * 2048, Gv, lane); }
#ifdef PROBE_TIME
        if (bx == 0 && tid == 0) { asm volatile("s_waitcnt vmcnt(0)" ::: "memory"); const unsigned* cw_ = (const unsigned*)(ws + WS_CTL); float t_us = (float)cw_[CW_TIME] * 0.01f; t_us = floorf(t_us / PROBE_Q + 0.5f) * PROBE_Q;
            xbuf[0] = sqrtf(t_us * 1e-3f * 33554432.f); }
#endif
    }
}

#if !MK_ONE_LAUNCH
template <int P> static void set_attr_from() { if constexpr (P < N_PHASES) { (void)hipFuncSetAttribute((const void*)mk_fwd<P, P + 1>, hipFuncAttributeMaxDynamicSharedMemorySize, LDS_BYTES); set_attr_from<P + 1>(); } }
template <int P> static void launch_from(int grid, hipStream_t stream, Args a) {
    if constexpr (P < N_PHASES) { a.ph_lo = P; a.ph_hi = P + 1; hipLaunchKernelGGL((mk_fwd<P, P + 1>), dim3(grid), dim3(NWAVES * 64), LDS_BYTES, stream, a); launch_from<P + 1>(grid, stream, a); } }
#endif
extern "C" void kernel_launch(void* const* d_in, const int* in_sizes, int n_in, void* d_out, int out_size, void* d_ws, size_t ws_size, hipStream_t stream) {
    static int grid = 0;
    if (grid == 0) {
        if (n_in != 19 || in_sizes[0] != M_TOK * DM || out_size != M_TOK * DM || ws_size < WS_END) {
            fprintf(stderr, "kernel_launch: shape / workspace mismatch (n_in %d, in0 %d, out %d, ws %zu, need %zu); nothing launched\n", n_in, n_in > 0 ? in_sizes[0] : -1, out_size, ws_size, (size_t)WS_END); grid = -1; return; }
        int dev = 0, cus = 0, per_cu = 0;
        if (hipGetDevice(&dev) != hipSuccess || hipDeviceGetAttribute(&cus, hipDeviceAttributeMultiprocessorCount, dev) != hipSuccess) { fprintf(stderr, "kernel_launch: device query failed\n"); grid = -1; return; }
#if MK_ONE_LAUNCH
        if (hipFuncSetAttribute((const void*)mk_fwd<0, N_PHASES>, hipFuncAttributeMaxDynamicSharedMemorySize, LDS_BYTES) != hipSuccess) { fprintf(stderr, "kernel_launch: hipFuncSetAttribute failed\n"); grid = -1; return; }
        if (hipOccupancyMaxActiveBlocksPerMultiprocessor(&per_cu, (const void*)mk_fwd<0, N_PHASES>, NWAVES * 64, LDS_BYTES) != hipSuccess || per_cu < 1) fprintf(stderr, "kernel_launch: occupancy query reports %d workgroups per CU\n", per_cu);
#else
        set_attr_from<0>();
#endif
        (void)hipGetLastError();
        grid = cus;
    }
    if (grid < 0) return;
    if (hipMemsetAsync((char*)d_ws + WS_CTL, 0, CTL_ZERO_BYTES, stream) != hipSuccess) { fprintf(stderr, "kernel_launch: memset failed\n"); return; }
    Args a{};
    for (int i = 0; i < 19; ++i) a.in[i] = (const float*)d_in[i];
    a.out = (float*)d_out; a.ws = (unsigned char*)d_ws;
#if MK_ONE_LAUNCH
    a.ph_lo = 0; a.ph_hi = N_PHASES;
    hipLaunchKernelGGL((mk_fwd<0, N_PHASES>), dim3(grid), dim3(NWAVES * 64), LDS_BYTES, stream, a);
#else
    launch_from<0>(grid, stream, a);
#endif
    const hipError_t le = hipPeekAtLastError();
    if (le != hipSuccess) fprintf(stderr, "kernel_launch: launch failed: %s\n", hipGetErrorName(le));
}
```
